# Optimizing an MI355X kernel written in HIP

```python
import jax, jax.numpy as jnp
from jax import lax
import numpy as np

D_MODEL = 2048
BATCH = 2
SEQ = 8192
DEPTH = 4

N_MIXERS = 4
Q_BLOCK = 128
EPS = 1e-6
FOX_HEADS = 16
FOX_HEAD_DIM = D_MODEL // FOX_HEADS
LRU_WIDTH = 2688
LRU_BLOCKS = 16
LRU_BLOCK_DIM = LRU_WIDTH // LRU_BLOCKS
CONV_WIDTH = 4
LRU_C = 8.0
SB_HEADS = 16
SB_HEAD_DIM = D_MODEL // SB_HEADS
MLSTM_HEADS = 4
MLSTM_QK_DIM = D_MODEL // 2 // MLSTM_HEADS
MLSTM_V_DIM = D_MODEL // MLSTM_HEADS
MLSTM_CHUNK = 64
MLSTM_M_INIT = -1e30
D_FF = 4 * D_MODEL

kernel_name = 'interleaved_fox_rglru_stickbreak_mlstm_trunk'


def _n_of(m):
    return (DEPTH - m + N_MIXERS - 1) // N_MIXERS


def rmsnorm(x, g):
    xf = x.astype(jnp.float32)
    y = xf * lax.rsqrt(jnp.mean(xf * xf, axis=-1, keepdims=True) + EPS)
    return (y * g.astype(jnp.float32)).astype(x.dtype)


def _heads(t, n_heads, d):
    b, s, _ = t.shape
    return t.reshape(b, s, n_heads, d).transpose(0, 2, 1, 3)


def _blocks_to_seq(out):
    nb, b, h, q, d = out.shape
    return out.transpose(1, 0, 3, 2, 4).reshape(b, nb * q, h * d)


def fox_attention(x, w_in, b_f, w_out):
    B, S, _ = x.shape
    H, dh = FOX_HEADS, FOX_HEAD_DIM
    proj = x @ w_in
    q, k, v, f_pre = jnp.split(proj, [D_MODEL, 2 * D_MODEL, 3 * D_MODEL], axis=-1)
    q, k, v = _heads(q, H, dh), _heads(k, H, dh), _heads(v, H, dh)
    log_f = jax.nn.log_sigmoid((f_pre + b_f).astype(jnp.float32)).transpose(0, 2, 1)
    cum = jnp.cumsum(log_f, axis=-1)
    nb = S // Q_BLOCK
    qb = q.reshape(B, H, nb, Q_BLOCK, dh).transpose(2, 0, 1, 3, 4)
    cb = cum.reshape(B, H, nb, Q_BLOCK).transpose(2, 0, 1, 3)
    pos_k = jnp.arange(S)
    scale = dh ** -0.5

    def block(args):
        i, q_i, c_i = args
        pos_q = i * Q_BLOCK + jnp.arange(Q_BLOCK)
        logits = jnp.einsum('bhqd,bhkd->bhqk', q_i, k).astype(jnp.float32) * scale
        logits = logits + c_i[..., :, None] - cum[..., None, :]
        logits = jnp.where(pos_k[None, :] <= pos_q[:, None], logits, -jnp.inf)
        p = jax.nn.softmax(logits, axis=-1)
        return jnp.einsum('bhqk,bhkd->bhqd', p.astype(v.dtype), v)

    out = lax.map(block, (jnp.arange(nb), qb, cb))
    return (_blocks_to_seq(out) @ w_out).astype(x.dtype)


def rglru_block(x, w_in, conv_w, conv_b, w_r, b_r, w_i, b_i, lam, w_out):
    B, S, _ = x.shape
    W, NB, bd = LRU_WIDTH, LRU_BLOCKS, LRU_BLOCK_DIM
    proj = x @ w_in
    gate, u = jnp.split(proj, [W], axis=-1)
    u_pad = jnp.pad(u, ((0, 0), (CONV_WIDTH - 1, 0), (0, 0)))
    u = conv_b + sum(u_pad[:, j:j + S, :] * conv_w[j] for j in range(CONV_WIDTH))
    ub = u.reshape(B, S, NB, bd)
    r = jax.nn.sigmoid((jnp.einsum('bsnd,nde->bsne', ub, w_r).reshape(B, S, W) + b_r).astype(jnp.float32))
    ig = jax.nn.sigmoid((jnp.einsum('bsnd,nde->bsne', ub, w_i).reshape(B, S, W) + b_i).astype(jnp.float32))
    log_a = LRU_C * r * jax.nn.log_sigmoid(lam.astype(jnp.float32))
    a = jnp.exp(log_a)
    bterm = jnp.sqrt(-jnp.expm1(2.0 * log_a)) * (ig * u.astype(jnp.float32))

    def combine(left, right):
        a1, b1 = left
        a2, b2 = right
        return a1 * a2, a2 * b1 + b2

    _, h = lax.associative_scan(combine, (a, bterm), axis=1)
    y = h * jax.nn.gelu(gate.astype(jnp.float32))
    return (y.astype(x.dtype) @ w_out).astype(x.dtype)


def stick_breaking_attention(x, w_in, w_out):
    B, S, _ = x.shape
    H, dh = SB_HEADS, SB_HEAD_DIM
    q, k, v = jnp.split(x @ w_in, 3, axis=-1)
    q, k, v = _heads(q, H, dh), _heads(k, H, dh), _heads(v, H, dh)
    nb = S // Q_BLOCK
    qb = q.reshape(B, H, nb, Q_BLOCK, dh).transpose(2, 0, 1, 3, 4)
    pos_k = jnp.arange(S)
    scale = dh ** -0.5

    def block(args):
        i, q_i = args
        pos_q = i * Q_BLOCK + jnp.arange(Q_BLOCK)
        strict = pos_k[None, :] < pos_q[:, None]
        z = jnp.einsum('bhqd,bhkd->bhqk', q_i, k).astype(jnp.float32) * scale
        log_beta = jax.nn.log_sigmoid(z)
        log_1mb = jnp.where(strict, jax.nn.log_sigmoid(-z), 0.0)
        after = lax.cumsum(log_1mb, axis=3, reverse=True) - log_1mb
        att = jnp.where(strict, jnp.exp(log_beta + after), 0.0)
        return jnp.einsum('bhqk,bhkd->bhqd', att.astype(v.dtype), v)

    out = lax.map(block, (jnp.arange(nb), qb))
    return (_blocks_to_seq(out) @ w_out).astype(x.dtype)


def mlstm_block(x, w_in, b_if, head_g, w_out):
    B, S, _ = x.shape
    H, dk, dv, L = MLSTM_HEADS, MLSTM_QK_DIM, MLSTM_V_DIM, MLSTM_CHUNK
    qk = H * dk
    proj = x @ w_in
    q, k, v, o_pre, g_pre = jnp.split(proj, [qk, 2 * qk, 2 * qk + D_MODEL, 2 * qk + 2 * D_MODEL], axis=-1)
    q, k, v = _heads(q, H, dk), _heads(k, H, dk) * (dk ** -0.5), _heads(v, H, dv)
    g_pre = g_pre.astype(jnp.float32).reshape(B, S, 2, H) + b_if.astype(jnp.float32)
    i_pre = g_pre[:, :, 0].transpose(0, 2, 1)
    log_f = jax.nn.log_sigmoid(g_pre[:, :, 1]).transpose(0, 2, 1)
    nc = S // L

    def chunks(t):
        return jnp.moveaxis(t.reshape(t.shape[:2] + (nc, L) + t.shape[3:]), 2, 0)

    causal = jnp.tril(jnp.ones((L, L), dtype=bool))

    def step(carry, xs):
        C, n, m = carry
        qc, kc, vc, lfc, ic = xs
        b = jnp.cumsum(lfc, axis=-1)
        g = b[..., -1]
        Dm = jnp.where(causal, b[..., :, None] - b[..., None, :] + ic[..., None, :], -jnp.inf)
        inter = b + m[..., None]
        m_t = jnp.maximum(inter, jnp.max(Dm, axis=-1))
        w_intra = jnp.exp(Dm - m_t[..., None])
        w_inter = jnp.exp(inter - m_t)
        s = jnp.einsum('bhtd,bhsd->bhts', qc, kc).astype(jnp.float32) * w_intra
        num = (w_inter[..., None] * jnp.einsum('bhtd,bhde->bhte', qc, C)
               + jnp.einsum('bhts,bhse->bhte', s, vc))
        den = w_inter * jnp.einsum('bhtd,bhd->bht', qc, n) + jnp.sum(s, axis=-1)
        h = num / jnp.maximum(jnp.abs(den), jnp.exp(-m_t))[..., None]
        wk = g[..., None] - b + ic
        m_new = jnp.maximum(g + m, jnp.max(wk, axis=-1))
        decay = jnp.exp(g + m - m_new)
        wk_e = jnp.exp(wk - m_new[..., None])
        C_new = decay[..., None, None] * C + jnp.einsum('bhs,bhsd,bhse->bhde', wk_e, kc, vc)
        n_new = decay[..., None] * n + jnp.einsum('bhs,bhsd->bhd', wk_e, kc)
        return (C_new, n_new, m_new), h

    init = (jnp.zeros((B, H, dk, dv), jnp.float32), jnp.zeros((B, H, dk), jnp.float32),
            jnp.full((B, H), MLSTM_M_INIT, jnp.float32))
    _, hs = lax.scan(step, init, (chunks(q), chunks(k), chunks(v), chunks(log_f), chunks(i_pre)))
    h = hs.transpose(1, 0, 3, 2, 4).reshape(B, S, H, dv)
    hn = rmsnorm(h, head_g.reshape(H, dv)).reshape(B, S, D_MODEL)
    y = jax.nn.sigmoid(o_pre.astype(jnp.float32)) * hn
    return (y.astype(x.dtype) @ w_out).astype(x.dtype)


def sqrelu_mlp(x, w1, w2):
    return (jnp.square(jax.nn.relu(x @ w1)) @ w2).astype(x.dtype)


def _dense(key, shape, fan_in):
    return jax.random.normal(key, shape, jnp.float32) * (fan_in ** -0.5)


def setup_inputs(seed: int = 0) -> dict:
    key = jax.random.key(seed)
    ks = jax.random.split(key, 24)
    n0, n1, n2, n3 = _n_of(0), _n_of(1), _n_of(2), _n_of(3)
    D, W, NB, bd = D_MODEL, LRU_WIDTH, LRU_BLOCKS, LRU_BLOCK_DIM
    x = jax.random.normal(ks[0], (BATCH, SEQ, D), jnp.float32)
    norm_g = 1.0 + 0.02 * jax.random.normal(ks[1], (DEPTH, 4, D), jnp.float32)
    mlp_w1 = _dense(ks[2], (DEPTH, D, D_FF), D)
    mlp_w2 = _dense(ks[3], (DEPTH, D_FF, D), D_FF)
    fox_w_in = _dense(ks[4], (n0, D, 3 * D + FOX_HEADS), D)
    fox_b_f = 3.0 + 0.1 * jax.random.normal(ks[5], (n0, FOX_HEADS), jnp.float32)
    fox_w_out = _dense(ks[6], (n0, D, D), D)
    lru_w_in = _dense(ks[7], (n1, D, 2 * W), D)
    lru_conv_w = _dense(ks[8], (n1, CONV_WIDTH, W), CONV_WIDTH)
    lru_conv_b = 0.01 * jax.random.normal(ks[9], (n1, W), jnp.float32)
    lru_w_r = _dense(ks[10], (n1, NB, bd, bd), bd)
    lru_b_r = 0.01 * jax.random.normal(ks[11], (n1, W), jnp.float32)
    lru_w_i = _dense(ks[12], (n1, NB, bd, bd), bd)
    lru_b_i = 0.01 * jax.random.normal(ks[13], (n1, W), jnp.float32)
    a_c = jax.random.uniform(ks[14], (n1, W), jnp.float32, minval=0.9, maxval=0.999)
    p = a_c ** (1.0 / LRU_C)
    lru_lambda = jnp.log(p) - jnp.log1p(-p)
    lru_w_out = _dense(ks[15], (n1, W, D), W)
    sb_w_in = _dense(ks[16], (n2, D, 3 * D), D)
    sb_w_out = _dense(ks[17], (n2, D, D), D)
    mlstm_w_in = _dense(ks[18], (n3, D, 3 * D + 2 * MLSTM_HEADS), D)
    mlstm_b_if = jnp.stack([-1.0 + 0.1 * jax.random.normal(ks[19], (n3, MLSTM_HEADS), jnp.float32),
                            3.0 + 0.1 * jax.random.normal(ks[20], (n3, MLSTM_HEADS), jnp.float32)], axis=1)
    mlstm_head_g = 1.0 + 0.02 * jax.random.normal(ks[21], (n3, D), jnp.float32)
    mlstm_w_out = _dense(ks[22], (n3, D, D), D)
    return {'x': x, 'norm_g': norm_g, 'mlp_w1': mlp_w1, 'mlp_w2': mlp_w2,
            'fox_w_in': fox_w_in, 'fox_b_f': fox_b_f, 'fox_w_out': fox_w_out,
            'lru_w_in': lru_w_in, 'lru_conv_w': lru_conv_w, 'lru_conv_b': lru_conv_b,
            'lru_w_r': lru_w_r, 'lru_b_r': lru_b_r, 'lru_w_i': lru_w_i, 'lru_b_i': lru_b_i,
            'lru_lambda': lru_lambda, 'lru_w_out': lru_w_out,
            'sb_w_in': sb_w_in, 'sb_w_out': sb_w_out,
            'mlstm_w_in': mlstm_w_in, 'mlstm_b_if': mlstm_b_if, 'mlstm_head_g': mlstm_head_g,
            'mlstm_w_out': mlstm_w_out}


def reference(x, norm_g, mlp_w1, mlp_w2, fox_w_in, fox_b_f, fox_w_out,
              lru_w_in, lru_conv_w, lru_conv_b, lru_w_r, lru_b_r, lru_w_i, lru_b_i,
              lru_lambda, lru_w_out, sb_w_in, sb_w_out,
              mlstm_w_in, mlstm_b_if, mlstm_head_g, mlstm_w_out):
    for i in range(DEPTH):
        m, j = i % N_MIXERS, i // N_MIXERS
        h = rmsnorm(x, norm_g[i, 0])
        if m == 0:
            h = fox_attention(h, fox_w_in[j], fox_b_f[j], fox_w_out[j])
        elif m == 1:
            h = rglru_block(h, lru_w_in[j], lru_conv_w[j], lru_conv_b[j], lru_w_r[j], lru_b_r[j],
                            lru_w_i[j], lru_b_i[j], lru_lambda[j], lru_w_out[j])
        elif m == 2:
            h = stick_breaking_attention(h, sb_w_in[j], sb_w_out[j])
        else:
            h = mlstm_block(h, mlstm_w_in[j], mlstm_b_if[j], mlstm_head_g[j], mlstm_w_out[j])
        x = x + rmsnorm(h, norm_g[i, 1])
        h = sqrelu_mlp(rmsnorm(x, norm_g[i, 2]), mlp_w1[i], mlp_w2[i])
        x = x + rmsnorm(h, norm_g[i, 3])
    return x
```

```cpp
#include <hip/hip_runtime.h>
#include <cstdio>
#include <cstdint>
#include <climits>
namespace pg8 {
#define PG8_LAS __attribute__((address_space(3)))
typedef unsigned short bf16_t;
typedef short bf16x8 __attribute__((ext_vector_type(8)));
typedef float f32x4 __attribute__((ext_vector_type(4)));
typedef unsigned u32x4 __attribute__((ext_vector_type(4)));
constexpr int BM = 256, BK = 64, HALF = 128, HTB = HALF * BK * 2  , STAGE_BYTES = 8 * HTB, NXCD = 8, WGM = 8;

__host__ __device__ __forceinline__ int lds_byte(int r, int c) { const int st = (r >> 4) * 2 + (c >> 5), rr = r & 15, cc = c & 31, ob = rr * 64 + cc * 2; return st * 1024 + (ob ^ (((ob >> 9) & 1) << 5)); }
__host__ __device__ __forceinline__ void stage_rc(int b, int& R, int& C) { const int st = b / 1024, sb = b % 1024, swz = sb ^ (((sb >> 9) & 1) << 5); R = (st >> 1) * 16 + swz / 64; C = (st & 1) * 32 + (swz % 64) / 2; }
__host__ __device__ __forceinline__ int perm32(int rho) { const int n = rho >> 4, i = rho & 15; return 8 * (i >> 2) + 4 * n + (i & 3); }

struct Unit { int pm, pn; };
struct Gemm { const bf16_t* A; const bf16_t* Bt; int M, N, K; };

struct StaticOrder {
    int nM, nN, nwg, G, c;
    __host__ __device__ void init(int M, int N, int G_, int c_) { nM = M / BM; nN = N / BM; nwg = nM * nN; G = G_; c = c_; }
    __host__ __device__ bool next(int i, Unit& u) const {
        const long L = (long)i * G + c; if (L >= nwg) return false;
        int wgid = (int)L; { const int q = nwg / NXCD, r = nwg % NXCD, xcd = wgid % NXCD, off = wgid / NXCD; wgid = (xcd < r ? xcd * (q + 1) : r * (q + 1) + (xcd - r) * q) + off; }
        const int nig = WGM * nN, gid = wgid / nig, fm = gid * WGM, gsz = (nM - fm) < WGM ? (nM - fm) : WGM;
        u.pm = fm + ((wgid % nig) % gsz); u.pn = (wgid % nig) / gsz; return true;
    }
    __device__ __forceinline__ void a_ready(const Unit&) const {}
    __device__ __forceinline__ void done(const Unit&) const {}
};
__device__ __forceinline__ unsigned pk_bf16(float lo, float hi) {
    typedef __bf16 bf2_t __attribute__((ext_vector_type(2))); typedef float f2_t __attribute__((ext_vector_type(2)));
    const bf2_t r = __builtin_convertvector((f2_t){lo, hi}, bf2_t); return __builtin_bit_cast(unsigned, r); }
template <int ACT  > struct EpiStore {
    static constexpr bool PERM = true, AFTER_DRAIN = false;
    bf16_t* O; int ldc; int gate_col0; float* G; int ng;
    __device__ __forceinline__ void operator()(const f32x4 (&acc)[2][2][4][2], const Unit& u, int wr, int wc, int fr, int fq) const {
        const int row0 = u.pm * BM + wr * 64 + fr; const int colt = u.pn * BM;
        if (colt >= gate_col0) {
            if (wc == 0) {
#pragma unroll
                for (int ai = 0; ai < 2; ++ai)
#pragma unroll
                    for (int m = 0; m < 4; ++m) { float* gp = G + (size_t)(row0 + ai * HALF + m * 16) * 16;
#pragma unroll
                        for (int n = 0; n < 2; ++n) { const int c = 8 * fq + 4 * n; if (c < ng) *(f32x4*)(gp + c) = acc[ai][0][m][n]; } }
            }
            return;
        }
        const int col0 = colt + wc * 32 + 8 * fq;
#pragma unroll
        for (int ai = 0; ai < 2; ++ai)
#pragma unroll
            for (int m = 0; m < 4; ++m) { bf16_t* rowp = O + (size_t)(row0 + ai * HALF + m * 16) * ldc + col0;
#pragma unroll
                for (int bj = 0; bj < 2; ++bj) { f32x4 v0 = acc[ai][bj][m][0], v1 = acc[ai][bj][m][1];
                    if (ACT == 2) {
#pragma unroll
                        for (int e = 0; e < 4; ++e) { const float a = fmaxf(v0[e], 0.f), b = fmaxf(v1[e], 0.f); v0[e] = a * a; v1[e] = b * b; } }
                    u32x4 w; w.x = pk_bf16(v0[0], v0[1]); w.y = pk_bf16(v0[2], v0[3]); w.z = pk_bf16(v1[0], v1[1]); w.w = pk_bf16(v1[2], v1[3]);
                    *(u32x4*)(rowp + bj * HALF) = w; } }
    }
};
template <class Epi, class Sched, bool ALIGN_EPI = false, bool SP2 = false>
__device__ __forceinline__ void gemm_phase(PG8_LAS unsigned char* lds, const Gemm g, const Sched& S, const Epi& E) {
    const int tid = threadIdx.x, wid = __builtin_amdgcn_readfirstlane(tid >> 6), lane = tid & 63, wr = wid >> 2, wc = wid & 3, fr = lane & 15, fq = lane >> 4;
    const int K = g.K, nt = K / BK;
    unsigned voffA[2], voffB[2];
#pragma unroll
    for (int i = 0; i < 2; ++i) { int R, C; stage_rc(tid * 16 + i * 8192, R, C); const int Rb = Epi::PERM ? ((R & ~31) + perm32(R & 31)) : R;
        voffA[i] = (unsigned)(R * K + C) * 2u; voffB[i] = (unsigned)(Rb * K + C) * 2u; }
    const size_t kstep = (size_t)(BK * 2);
    const size_t hstep = (size_t)HALF * K * 2;
    const size_t tstep = 2 * hstep;
    const unsigned ldsw = (unsigned)wid * 1024u;
    const int aoff = lds_byte(wr * 64 + fr, fq * 8), boff = lds_byte(wc * 32 + fr, fq * 8);
#define PG8_SA(b, h) (((b) * 2 + (h)) * HTB)
#define PG8_SB(b, h) ((4 + (b) * 2 + (h)) * HTB)
#define PG8_STAGE(bufoff, gbase, voff) do { _Pragma("unroll") for (int _i = 0; _i < 2; ++_i) \
        __builtin_amdgcn_global_load_lds((const unsigned*)((const char*)(gbase) + (voff)[_i]), (PG8_LAS unsigned*)(lds + (bufoff) + ldsw + _i * 8192), 16, 0, 0); } while (0)
#define PG8_LDA(dst, b, h) do { _Pragma("unroll") for (int m = 0; m < 4; ++m) _Pragma("unroll") for (int k = 0; k < 2; ++k) dst[m][k] = *(const PG8_LAS bf16x8*)(lds + PG8_SA(b, h) + aoff + m * 2048 + k * 1024); } while (0)
#define PG8_LDB(dst, b, h) do { _Pragma("unroll") for (int n = 0; n < 2; ++n) _Pragma("unroll") for (int k = 0; k < 2; ++k) dst[n][k] = *(const PG8_LAS bf16x8*)(lds + PG8_SB(b, h) + boff + n * 2048 + k * 1024); } while (0)
#define PG8_MMA(ai, bj, At, Bt) do { __builtin_amdgcn_s_setprio(1); _Pragma("unroll") for (int m = 0; m < 4; ++m) _Pragma("unroll") for (int n = 0; n < 2; ++n) _Pragma("unroll") for (int k = 0; k < 2; ++k) \
        acc[ai][bj][m][n] = __builtin_amdgcn_mfma_f32_16x16x32_bf16(Bt[n][k], At[m][k], acc[ai][bj][m][n], 0, 0, 0); __builtin_amdgcn_s_setprio(0); } while (0)
#define PG8_WAIT_V(n) asm volatile("s_waitcnt vmcnt(" #n ")" ::: "memory")
#define PG8_WAIT_L(n) asm volatile("s_waitcnt lgkmcnt(" #n ")" ::: "memory")
#define PG8_BAR __builtin_amdgcn_s_barrier()
#define PG8_SCHED __builtin_amdgcn_sched_barrier(0)
    Unit cur, nxt; int ui = 0;
    if (!S.next(0, cur)) return;
    f32x4 acc[2][2][4][2];
#pragma unroll
    for (int a = 0; a < 2; ++a)
#pragma unroll
        for (int b = 0; b < 2; ++b)
#pragma unroll
            for (int m = 0; m < 4; ++m)
#pragma unroll
                for (int n = 0; n < 2; ++n) acc[a][b][m][n] = (f32x4){0.f, 0.f, 0.f, 0.f};
    bf16x8 At[4][2], B0[2][2], B1[2][2];
    const char* cA = (const char*)g.A + (size_t)cur.pm * tstep; const char* cB = (const char*)g.Bt + (size_t)cur.pn * tstep;
    S.a_ready(cur);
    if constexpr (SP2) {
        PG8_STAGE(PG8_SB(0, 0), cB, voffB); PG8_STAGE(PG8_SB(0, 1), cB + hstep, voffB); PG8_STAGE(PG8_SA(0, 0), cA, voffA); PG8_STAGE(PG8_SA(0, 1), cA + hstep, voffA);
        if (wr == 1) PG8_BAR;
        PG8_WAIT_V(2); PG8_BAR;
        PG8_STAGE(PG8_SB(1, 0), cB + kstep, voffB); PG8_STAGE(PG8_SA(1, 0), cA + kstep, voffA); PG8_STAGE(PG8_SB(1, 1), cB + hstep + kstep, voffB);
        PG8_WAIT_V(6); PG8_BAR;
    } else {
        PG8_STAGE(PG8_SB(0, 0), cB, voffB); PG8_STAGE(PG8_SA(0, 0), cA, voffA); PG8_STAGE(PG8_SB(0, 1), cB + hstep, voffB); PG8_STAGE(PG8_SA(0, 1), cA + hstep, voffA);
        if (wr == 1) PG8_BAR;
        PG8_WAIT_V(4); PG8_BAR;
        PG8_STAGE(PG8_SB(1, 0), cB + kstep, voffB); PG8_STAGE(PG8_SA(1, 0), cA + kstep, voffA); PG8_STAGE(PG8_SB(1, 1), cB + hstep + kstep, voffB);
        PG8_WAIT_V(6); PG8_BAR;
    }
    for (;;) {
        const bool has_next = S.next(ui + 1, nxt);
        const char* nA = has_next ? (const char*)g.A + (size_t)nxt.pm * tstep : cA; const char* nB = has_next ? (const char*)g.Bt + (size_t)nxt.pn * tstep : cB;
        for (int t = 0; t < nt; t += 2) {
            const bool last = (t == nt - 2);
            const char* a1 = cA + (size_t)(t + 1) * kstep;
            const char* a2 = last ? nA : cA + (size_t)(t + 2) * kstep; const char* b2 = last ? nB : cB + (size_t)(t + 2) * kstep;
            const char* a3 = a2 + kstep; const char* b3 = b2 + kstep;
            if (last && has_next) S.a_ready(nxt);
            if constexpr (SP2) {
            PG8_LDB(B0, 0, 0); PG8_LDB(B1, 0, 1); PG8_SCHED; PG8_LDA(At, 0, 0); PG8_STAGE(PG8_SA(1, 1), a1 + hstep, voffA);
            PG8_WAIT_V(8); PG8_WAIT_L(0); PG8_BAR; PG8_MMA(0, 0, At, B0); PG8_MMA(0, 1, At, B1); PG8_BAR; PG8_SCHED;
            PG8_LDA(At, 0, 1); PG8_STAGE(PG8_SB(0, 0), b2, voffB); PG8_STAGE(PG8_SB(0, 1), b2 + hstep, voffB); PG8_STAGE(PG8_SA(0, 0), a2, voffA);
            PG8_WAIT_V(8); PG8_WAIT_L(0); PG8_BAR; PG8_MMA(1, 0, At, B0); PG8_MMA(1, 1, At, B1); PG8_BAR; PG8_SCHED;
            PG8_LDB(B0, 1, 0); PG8_LDB(B1, 1, 1); PG8_SCHED; PG8_LDA(At, 1, 0); PG8_STAGE(PG8_SA(0, 1), a2 + hstep, voffA);
            PG8_WAIT_V(8); PG8_WAIT_L(0); PG8_BAR; PG8_MMA(0, 0, At, B0); PG8_MMA(0, 1, At, B1); PG8_BAR; PG8_SCHED;
            PG8_LDA(At, 1, 1); PG8_STAGE(PG8_SB(1, 0), b3, voffB); PG8_STAGE(PG8_SB(1, 1), b3 + hstep, voffB); PG8_STAGE(PG8_SA(1, 0), a3, voffA);
            PG8_WAIT_V(8); PG8_WAIT_L(0); PG8_BAR; PG8_MMA(1, 0, At, B0); PG8_MMA(1, 1, At, B1); PG8_BAR; PG8_SCHED;
            } else {
            PG8_LDB(B0, 0, 0); PG8_SCHED; PG8_LDA(At, 0, 0); PG8_STAGE(PG8_SA(1, 1), a1 + hstep, voffA);
            PG8_WAIT_L(8); PG8_BAR; PG8_WAIT_L(0); PG8_MMA(0, 0, At, B0); PG8_BAR; PG8_SCHED;
            PG8_LDB(B1, 0, 1); PG8_STAGE(PG8_SB(0, 0), b2, voffB);
            PG8_BAR; PG8_WAIT_L(0); PG8_MMA(0, 1, At, B1); PG8_BAR;
            PG8_LDA(At, 0, 1); PG8_STAGE(PG8_SA(0, 0), a2, voffA);
            PG8_BAR; PG8_WAIT_L(0); PG8_MMA(1, 0, At, B0); PG8_BAR; PG8_SCHED;
            PG8_STAGE(PG8_SB(0, 1), b2 + hstep, voffB);
            PG8_WAIT_V(6); PG8_BAR; PG8_MMA(1, 1, At, B1); PG8_BAR;
            PG8_LDB(B0, 1, 0); PG8_SCHED; PG8_LDA(At, 1, 0); PG8_STAGE(PG8_SA(0, 1), a2 + hstep, voffA);
            PG8_WAIT_L(8); PG8_BAR; PG8_WAIT_L(0); PG8_MMA(0, 0, At, B0); PG8_BAR; PG8_SCHED;
            PG8_LDB(B1, 1, 1); PG8_STAGE(PG8_SB(1, 0), b3, voffB);
            PG8_BAR; PG8_WAIT_L(0); PG8_MMA(0, 1, At, B1); PG8_BAR;
            PG8_LDA(At, 1, 1); PG8_STAGE(PG8_SA(1, 0), a3, voffA);
            PG8_BAR; PG8_WAIT_L(0); PG8_MMA(1, 0, At, B0); PG8_BAR; PG8_SCHED;
            PG8_STAGE(PG8_SB(1, 1), b3 + hstep, voffB);
            PG8_WAIT_V(6); PG8_BAR; PG8_MMA(1, 1, At, B1); PG8_BAR;
            }
        }
        if constexpr (ALIGN_EPI) { if (wr == 0) PG8_BAR; }
        if constexpr (!Epi::AFTER_DRAIN) { E(acc, cur, wr, wc, fr, fq); S.done(cur); }
        if (!has_next) break;
#pragma unroll
        for (int a = 0; a < 2; ++a)
#pragma unroll
            for (int b = 0; b < 2; ++b)
#pragma unroll
                for (int m = 0; m < 4; ++m)
#pragma unroll
                    for (int n = 0; n < 2; ++n) acc[a][b][m][n] = (f32x4){0.f, 0.f, 0.f, 0.f};
        cur = nxt; cA = nA; cB = nB; ++ui;
        if constexpr (ALIGN_EPI) { if (wr == 1) PG8_BAR; }
    }
    PG8_WAIT_V(0);
    if constexpr (!ALIGN_EPI) { if (wr == 0) PG8_BAR; }
    PG8_BAR;
    if constexpr (Epi::AFTER_DRAIN) { E.fused(acc, cur, wr, wc, fr, fq, lds, wid, lane); S.done(cur); }
#undef PG8_SA
#undef PG8_SB
#undef PG8_STAGE
#undef PG8_LDA
#undef PG8_LDB
#undef PG8_MMA
#undef PG8_WAIT_V
#undef PG8_WAIT_L
#undef PG8_BAR
#undef PG8_SCHED
}
}
#define GAS __attribute__((address_space(1)))
#define LAS __attribute__((address_space(3)))
typedef unsigned short bf16;
typedef unsigned v4u __attribute__((ext_vector_type(4)));
typedef float f32x4 __attribute__((ext_vector_type(4)));
typedef short bf16x8 __attribute__((ext_vector_type(8)));
typedef GAS unsigned gu32;
typedef GAS unsigned long long gu64;
#define RLX_AGENT __ATOMIC_RELAXED, __HIP_MEMORY_SCOPE_AGENT
#define LDS_WAIT() asm volatile("s_waitcnt lgkmcnt(0)" ::: "memory")
#define VM_WAIT() asm volatile("s_waitcnt vmcnt(0)" ::: "memory")
__device__ __forceinline__ unsigned long long rt() { return __builtin_amdgcn_s_memrealtime(); }
__device__ __forceinline__ unsigned f2bf(float f) { unsigned u = __builtin_bit_cast(unsigned, f); return (u + 0x7fffu + ((u >> 16) & 1u)) >> 16; }
__device__ __forceinline__ unsigned pk2(float lo, float hi) { return f2bf(lo) | (f2bf(hi) << 16); }

#define XB_TMO      128
#define XB_XCNT(j)  (256  + 64 * (j))
#define XB_XSUB(j)  (1280 + 64 * (j))
#define XB_XGEN(j)  (2304 + 64 * (j))
#define XB_TOP      3328
#define XB_TOPGEN   3392
#define XCD_BAR_WORDS 3456
#define XB_SPIN_CAP (1u << 18)

__device__ __forceinline__ unsigned xb_ld(unsigned* p)              { return __hip_atomic_load(p, __ATOMIC_RELAXED, __HIP_MEMORY_SCOPE_AGENT); }
__device__ __forceinline__ unsigned xb_add(unsigned* p, unsigned v) { return __hip_atomic_fetch_add(p, v, __ATOMIC_RELAXED, __HIP_MEMORY_SCOPE_AGENT); }
__device__ __forceinline__ unsigned xb_xcc_id() { return (unsigned)__builtin_amdgcn_s_getreg((3 << 11) | 20) & 0xFu; }
#define XB_SPIN(cond, bar) do { unsigned _sp = 0; while (cond) { __builtin_amdgcn_s_sleep(1); \
    if ((++_sp & 255u) == 0u) { if (xb_ld(&(bar)[XB_TMO])) break; if (_sp > XB_SPIN_CAP) { atomicAdd(&(bar)[XB_TMO], 1u); break; } } } } while (0)

struct XcdBarrier {
    unsigned* bar; unsigned x;
    volatile LAS unsigned* st;
};

__device__ __forceinline__ XcdBarrier xcd_barrier_post(unsigned* bar, volatile LAS unsigned* st) {
    XcdBarrier b; b.bar = bar; b.x = xb_xcc_id(); b.st = st;
    if (threadIdx.x == 0) (void)xb_add(&bar[XB_XCNT(b.x)], 1u);
    return b;
}
__device__ __forceinline__ void xcd_barrier_complete(unsigned* bar, unsigned x, unsigned& nloc, unsigned& nx) {
    const unsigned G = gridDim.x * gridDim.y * gridDim.z;
    unsigned sum, cnt, mine, sp = 0u;
    for (;;) {
        sum = 0u; cnt = 0u; mine = 0u;
#pragma unroll
        for (unsigned j = 0; j < 16; ++j) { const unsigned c = xb_ld(&bar[XB_XCNT(j)]); sum += c; cnt += (c > 0u) ? 1u : 0u; mine = (j == x) ? c : mine; }
        if (sum == G) break;
        __builtin_amdgcn_s_sleep(1);
        if ((++sp & 255u) == 0u) { if (xb_ld(&bar[XB_TMO])) break; if (sp > XB_SPIN_CAP) { atomicAdd(&bar[XB_TMO], 1u); break; } }
    }
    nloc = mine > 0u ? mine : 1u; nx = cnt > 0u ? cnt : 1u;
}

__device__ __forceinline__ void xcd_barrier(const XcdBarrier& b) {
    asm volatile("s_waitcnt vmcnt(0)" ::: "memory");
    __syncthreads();
    if (threadIdx.x == 0) {
        unsigned* bar = b.bar;
        __builtin_amdgcn_s_waitcnt(0);
        unsigned nloc = b.st[0], nx = b.st[1];
        if (nloc == 0u) { xcd_barrier_complete(bar, b.x, nloc, nx); b.st[0] = nloc; b.st[1] = nx; }
        const unsigned old = xb_add(&bar[XB_XSUB(b.x)], 1u);
        const unsigned gen = old / nloc;
        if (old + 1u == (gen + 1u) * nloc) {
            __builtin_amdgcn_fence(__ATOMIC_RELEASE, "agent");
            asm volatile("s_waitcnt vmcnt(0)" ::: "memory");
            const unsigned og = xb_add(&bar[XB_TOP], 1u);
            const unsigned tg = og / nx;
            if (og + 1u == (tg + 1u) * nx) xb_add(&bar[XB_TOPGEN], 1u);
            else XB_SPIN(xb_ld(&bar[XB_TOPGEN]) == tg, bar);
            __builtin_amdgcn_fence(__ATOMIC_ACQUIRE, "agent");
            xb_add(&bar[XB_XGEN(b.x)], 1u);
            asm volatile("s_waitcnt vmcnt(0)" ::: "memory");
        } else {
            XB_SPIN(xb_ld(&bar[XB_XGEN(b.x)]) == gen, bar);
            __builtin_amdgcn_fence(__ATOMIC_ACQUIRE, "agent");
            asm volatile("s_waitcnt vmcnt(0)" ::: "memory");
        }
    }
    __syncthreads();
}

constexpr int DM = 2048, BATCH = 2, SEQ = 8192, MTOK = BATCH * SEQ, DFF = 8192, DEPTH = 4;
constexpr int LRU_W = 2688, LRU_BD = 168;
constexpr float EPS = 1e-6f;
constexpr int NWAVES = 8;
typedef unsigned short bf16;
typedef float f32x16 __attribute__((ext_vector_type(16)));
typedef unsigned u32x2 __attribute__((ext_vector_type(2)));
using pg8::pk_bf16;

constexpr size_t MiB = 1u << 20;
constexpr size_t WS_CTL = 0, CTL_ZERO_BYTES = 1 * MiB;
constexpr size_t WS_GATES = 1 * MiB;
constexpr size_t WS_CUM = 2 * MiB;
constexpr size_t WS_MLS = 3 * MiB;
constexpr size_t WS_W_FOXIN = 8 * MiB, WS_W_FOXOUT = 33 * MiB, WS_W_LRUIN = 41 * MiB, WS_W_LRUOUT = 62 * MiB, WS_W_SBIN = 73 * MiB, WS_W_SBOUT = 97 * MiB,
                 WS_W_MLIN = 105 * MiB, WS_W_MLOUT = 130 * MiB, WS_W1 = 138 * MiB, WS_W2 = 266 * MiB;
constexpr size_t WS_H = 394 * MiB;
constexpr size_t WS_HM = 458 * MiB;
constexpr size_t WS_PROJ = 522 * MiB;
constexpr size_t WS_Y = 714 * MiB;
constexpr size_t WS_HID = 522 * MiB;
constexpr size_t WS_KT = 798 * MiB;
constexpr size_t WS_END = 830 * MiB;
constexpr size_t WS_VT_OFF = 128 * MiB;

constexpr int LDS_BYTES = 163840;
constexpr int LDSCTL_OFF = 163840 - 256;

#define LAS __attribute__((address_space(3)))
typedef short bf16x8 __attribute__((ext_vector_type(8)));
typedef short s16x4 __attribute__((ext_vector_type(4)));
typedef float f32x4 __attribute__((ext_vector_type(4)));
typedef unsigned v4u __attribute__((ext_vector_type(4)));
#define MFMA32(a, b, c) __builtin_amdgcn_mfma_f32_32x32x16_bf16((a), (b), (c), 0, 0, 0)
#define MFMA16(a, b, c) __builtin_amdgcn_mfma_f32_16x16x32_bf16((a), (b), (c), 0, 0, 0)

__device__ __forceinline__ float bf2f(unsigned short b) { return __uint_as_float((unsigned)b << 16); }
__device__ __forceinline__ float bflo(unsigned w) { return __uint_as_float(w << 16); }
__device__ __forceinline__ float bfhi(unsigned w) { return __uint_as_float(w & 0xffff0000u); }
__device__ __forceinline__ unsigned short f2bf16(float f) { return (unsigned short)(pk_bf16(f, 0.f) & 0xffffu); }
__device__ __forceinline__ float wave_sum(float v) {
#pragma unroll
    for (int o = 1; o < 64; o <<= 1) v += __shfl_xor(v, o);
    return v;
}
__device__ __forceinline__ float log_sigmoid_f(float x) { return fminf(x, 0.f) - log1pf(expf(-fabsf(x))); }
__device__ __forceinline__ float sigmoid_f(float x) { return 1.f / (1.f + expf(-x)); }
__device__ __forceinline__ float gelu_tanh_f(float x) { const float u = 0.7978845608028654f * (x + 0.044715f * x * x * x); const float t = 1.f - 2.f / (1.f + expf(2.f * u)); return 0.5f * x * (1.f + t); }
__device__ __forceinline__ float ld_agent_f32(const float* p) { return __uint_as_float(__hip_atomic_load((const unsigned*)p, __ATOMIC_RELAXED, __HIP_MEMORY_SCOPE_AGENT)); }

struct TrJob { const float* src; bf16* dst; int ldw, ncols, K, item0; };
constexpr int NJOBS = 17;
__device__ __forceinline__ void tr_item(const float* W, int ldw, int ncols, int K, bf16* WT, LAS float* scr, int item, int lane) {
    const int nblk = ncols / 32, kb = item / nblk, nb = item % nblk, k0 = 64 * kb, n0 = 32 * nb;
#pragma unroll 8
    for (int i = 0; i < 32; ++i) { const int kk = 2 * i + (lane >> 5); scr[kk * 33 + (lane & 31)] = W[(size_t)(k0 + kk) * ldw + n0 + (lane & 31)]; }
    asm volatile("s_waitcnt lgkmcnt(0)" ::: "memory");
    const int c = lane & 7;
#pragma unroll
    for (int j = 0; j < 4; ++j) { const int n = (lane >> 3) + 8 * j; const LAS float* s = scr + (8 * c) * 33 + n;
        v4u o; o.x = pk_bf16(s[0 * 33], s[1 * 33]); o.y = pk_bf16(s[2 * 33], s[3 * 33]); o.z = pk_bf16(s[4 * 33], s[5 * 33]); o.w = pk_bf16(s[6 * 33], s[7 * 33]);
        *(v4u*)(WT + (size_t)(n0 + n) * K + k0 + 8 * c) = o; }
    asm volatile("s_waitcnt lgkmcnt(0)" ::: "memory");
}
__device__ __forceinline__ void gate_rows(const float* W, int ldw, int col0, int ng, bf16* dst, int gtid, int nthr) {
    for (int i = gtid; i < 256 * DM; i += nthr) { const int g = i / DM, k = i % DM; const float v = g < ng ? W[(size_t)k * ldw + col0 + g] : 0.f; dst[i] = f2bf16(v); }
}

__device__ __forceinline__ void row_pass(const float* xsrc, const bf16* hm, const float* ga, const float* gb, float* xdst, bf16* hout, int gw, int ngw, int lane) {
    for (int row = gw; row < MTOK; row += ngw) {
        const size_t ro = (size_t)row * DM + 4 * lane;
        f32x4 xv[8];
#pragma unroll
        for (int j = 0; j < 8; ++j) xv[j] = *(const f32x4*)(xsrc + ro + 256 * j);
        if (hm) {
            u32x2 hv[8]; float ss = 0.f;
#pragma unroll
            for (int j = 0; j < 8; ++j) { hv[j] = *(const u32x2*)(hm + ro + 256 * j); const float a = bflo(hv[j].x), b = bfhi(hv[j].x), c = bflo(hv[j].y), d = bfhi(hv[j].y); ss += (a * a + b * b) + (c * c + d * d); }
            const float r = rsqrtf(wave_sum(ss) * (1.f / DM) + EPS);
#pragma unroll
            for (int j = 0; j < 8; ++j) { const f32x4 g = *(const f32x4*)(ga + 256 * j + 4 * lane);
                xv[j].x += bflo(hv[j].x) * r * g.x; xv[j].y += bfhi(hv[j].x) * r * g.y; xv[j].z += bflo(hv[j].y) * r * g.z; xv[j].w += bfhi(hv[j].y) * r * g.w;
                *(f32x4*)(xdst + ro + 256 * j) = xv[j]; }
        }
        if (hout) {
            float ss = 0.f;
#pragma unroll
            for (int j = 0; j < 8; ++j) ss += (xv[j].x * xv[j].x + xv[j].y * xv[j].y) + (xv[j].z * xv[j].z + xv[j].w * xv[j].w);
            const float r = rsqrtf(wave_sum(ss) * (1.f / DM) + EPS);
#pragma unroll
            for (int j = 0; j < 8; ++j) { const f32x4 g = *(const f32x4*)(gb + 256 * j + 4 * lane); u32x2 w;
                w.x = pk_bf16(xv[j].x * r * g.x, xv[j].y * r * g.y); w.y = pk_bf16(xv[j].z * r * g.z, xv[j].w * r * g.w);
                *(u32x2*)(hout + ro + 256 * j) = w; }
        }
    }
}

__device__ __forceinline__ void fox_cumsum(LAS unsigned char* lds, const float* G, const float* bfv, float* cum, int wg, int nwg) {
    LAS float* wtot = (LAS float*)lds;
    const int tid = threadIdx.x, lane = tid & 63, wid = tid >> 6;
    for (int u = wg; u < 32; u += nwg) {
        const int b = u >> 4, h = u & 15; const float bias = bfv[h];
        float v[16]; float run = 0.f;
#pragma unroll
        for (int i = 0; i < 16; ++i) { run += log_sigmoid_f(G[((size_t)b * SEQ + tid * 16 + i) * 16 + h] + bias); v[i] = run; }
        float inc = run;
#pragma unroll
        for (int o = 1; o < 64; o <<= 1) { const float t = __shfl_up(inc, o); if (lane >= o) inc += t; }
        __syncthreads();
        if (lane == 63) wtot[wid] = inc;
        __syncthreads();
        float off = inc - run;
        for (int w = 0; w < wid; ++w) off += wtot[w];
        float* o = cum + ((size_t)(b * 16 + h)) * SEQ + tid * 16;
#pragma unroll
        for (int i = 0; i < 16; ++i) o[i] = off + v[i];
    }
}

constexpr int AT_KB = 16384, AT_VB = 128 * 136, AT_K0 = 0, AT_V0 = 2 * AT_KB, AT_CS = AT_V0 + 2 * AT_VB, AT_FLAG = AT_CS + 512;
__device__ __forceinline__ int crow(int r, int hi) { return (r & 3) + 8 * (r >> 2) + 4 * hi; }

template <int MODE>
__device__ __forceinline__ void attn_unit(LAS unsigned char* lds, const bf16* QK, const bf16* VT, const float* cum, bf16* Y, int b, int h, int qb) {
    const int tid = threadIdx.x, lane = tid & 63, wid = __builtin_amdgcn_readfirstlane(tid >> 6), r32 = lane & 31, hi = lane >> 5;
    const float scale = 0.08838834764831845f;
    const int tq = qb * 256 + wid * 32 + r32;
    const size_t rowq = (size_t)b * SEQ + tq;
    bf16x8 qf[8];
    { const bf16* qp = QK + rowq * 4096 + h * 128 + 8 * hi;
#pragma unroll
      for (int ks = 0; ks < 8; ++ks) qf[ks] = *(const bf16x8*)(qp + 16 * ks); }
    const float* cumh = cum + (size_t)(b * 16 + h) * SEQ;
    float ct = 0.f; if (MODE == 0) ct = cumh[tq];
    f32x16 o[4];
#pragma unroll
    for (int dt = 0; dt < 4; ++dt)
#pragma unroll
        for (int r = 0; r < 16; ++r) o[dt][r] = 0.f;
    float m = -1e30f, l = 0.f, R = 0.f;
    const int jmax = 4 * qb + 3, jw = 4 * qb + (wid >> 1);
    bool wdone = false;
    const bf16* kbase = QK + ((size_t)b * SEQ) * 4096 + 2048 + h * 128;
    const bf16* vbase = VT + ((size_t)h * 128) * MTOK + (size_t)b * SEQ;
    v4u kreg[2], vreg[2]; float creg = 0.f;
#define AT_STAGE_LOAD(jj) do { _Pragma("unroll") for (int i_ = 0; i_ < 2; ++i_) { const int c_ = tid + 512 * i_; const int row_ = c_ >> 4, ch_ = c_ & 15; \
            kreg[i_] = *(const v4u*)(kbase + (size_t)(64 * (jj) + row_) * 4096 + ch_ * 8); \
            const int d_ = c_ >> 3, vc_ = c_ & 7; \
            vreg[i_] = *(const v4u*)(vbase + (size_t)d_ * MTOK + 64 * (jj) + vc_ * 8); } \
        if (MODE == 0 && tid < 64) creg = cumh[64 * (jj) + tid]; } while (0)
#define AT_STAGE_WRITE(buf) do { _Pragma("unroll") for (int i_ = 0; i_ < 2; ++i_) { const int c_ = tid + 512 * i_; const int row_ = c_ >> 4, ch_ = c_ & 15; \
            *(LAS v4u*)(lds + AT_K0 + (buf) * AT_KB + row_ * 256 + ((ch_ ^ (row_ & 15)) << 4)) = kreg[i_]; \
            const int d_ = c_ >> 3, vc_ = c_ & 7; \
            LAS u32x2* vp_ = (LAS u32x2*)(lds + AT_V0 + (buf) * AT_VB + d_ * 136 + vc_ * 16); \
            vp_[0] = (u32x2){vreg[i_].x, vreg[i_].y}; vp_[1] = (u32x2){vreg[i_].z, vreg[i_].w}; } \
        if (MODE == 0 && tid < 64) ((LAS float*)(lds + AT_CS + (buf) * 256))[tid] = creg; } while (0)
    AT_STAGE_LOAD(jmax); AT_STAGE_WRITE(0);
    __syncthreads();
    for (int j = jmax; j >= 0; --j) {
        const int cur = (jmax - j) & 1;
        if (MODE == 0 && j > 0) AT_STAGE_LOAD(j - 1);
        if (j <= jw && !wdone) {
            const LAS unsigned char* kb = lds + AT_K0 + cur * AT_KB;
            const LAS unsigned char* vb = lds + AT_V0 + cur * AT_VB;
            const LAS float* csb = (const LAS float*)(lds + AT_CS + cur * 256);
            const int dsub = (wid & 1);
#pragma unroll
            for (int sub = 1; sub >= 0; --sub) {
                if (j == jw && sub > dsub) continue;
                const bool diag = (j == jw && sub == dsub);
                f32x16 s;
#pragma unroll
                for (int r = 0; r < 16; ++r) s[r] = 0.f;
#pragma unroll
                for (int ks = 0; ks < 8; ++ks) {
                    const bf16x8 kf = *(const LAS bf16x8*)(kb + (32 * sub + r32) * 256 + (((2 * ks + hi) ^ (r32 & 15)) << 4));
                    s = MFMA32(kf, qf[ks], s);
                }
                float p[16];
                if (MODE == 0) {
                    float mx = -1e30f;
#pragma unroll
                    for (int g = 0; g < 4; ++g) { const f32x4 cs = *(const LAS f32x4*)(csb + 32 * sub + 8 * g + 4 * hi);
#pragma unroll
                        for (int i = 0; i < 4; ++i) { const int r = 4 * g + i; float lg = s[r] * scale + (ct - cs[i]);
                            if (diag && (8 * g + 4 * hi + i) > r32) lg = -1e30f;
                            p[r] = lg; mx = fmaxf(mx, lg); } }
                    mx = fmaxf(mx, __shfl_xor(mx, 32));
                    const float mn = fmaxf(m, mx), alpha = __expf(m - mn);
                    float ps = 0.f;
#pragma unroll
                    for (int r = 0; r < 16; ++r) { p[r] = __expf(p[r] - mn); ps += p[r]; }
                    l = l * alpha + ps; m = mn;
#pragma unroll
                    for (int dt = 0; dt < 4; ++dt)
#pragma unroll
                        for (int r = 0; r < 16; ++r) o[dt][r] *= alpha;
                } else {
                    float L1[16], G[4], Go[4];
#pragma unroll
                    for (int g = 0; g < 4; ++g) { float gs = 0.f;
#pragma unroll
                        for (int i = 0; i < 4; ++i) { const int r = 4 * g + i; const float zz = s[r] * scale;
                            const bool valid = !diag || (8 * g + 4 * hi + i) < r32;
                            const float sp = fmaxf(zz, 0.f) + __logf(1.f + __expf(-fabsf(zz)));
                            L1[r] = valid ? -sp : 0.f; p[r] = zz - sp; gs += L1[r]; }
                        G[g] = gs; }
#pragma unroll
                    for (int g = 0; g < 4; ++g) Go[g] = __shfl_xor(G[g], 32);
                    float T = 0.f;
#pragma unroll
                    for (int g = 3; g >= 0; --g) {
                        const float base = R + T + (hi == 0 ? Go[g] : 0.f);
                        float suf = 0.f;
#pragma unroll
                        for (int i = 3; i >= 0; --i) { const int r = 4 * g + i;
                            const bool valid = !diag || (8 * g + 4 * hi + i) < r32;
                            const float a = __expf(p[r] + base + suf);
                            p[r] = valid ? a : 0.f; suf += L1[r]; }
                        T += G[g] + Go[g];
                    }
                    R += T;
                }
#pragma unroll
                for (int st = 0; st < 2; ++st) {
                    v4u pw; pw.x = pk_bf16(p[8 * st + 0], p[8 * st + 1]); pw.y = pk_bf16(p[8 * st + 2], p[8 * st + 3]); pw.z = pk_bf16(p[8 * st + 4], p[8 * st + 5]); pw.w = pk_bf16(p[8 * st + 6], p[8 * st + 7]);
                    const bf16x8 pf = __builtin_bit_cast(bf16x8, pw);
#pragma unroll
                    for (int dt = 0; dt < 4; ++dt) {
                        const LAS unsigned char* vp = vb + (32 * dt + r32) * 136 + (32 * sub + 16 * st + 4 * hi) * 2;
                        const u32x2 lo = *(const LAS u32x2*)vp, hh = *(const LAS u32x2*)(vp + 16);
                        const v4u vw = (v4u){lo.x, lo.y, hh.x, hh.y};
                        o[dt] = MFMA32(__builtin_bit_cast(bf16x8, vw), pf, o[dt]);
                    }
                }
            }
            if (MODE == 1) wdone = __all(R < -104.f);
        }
        if (MODE == 1 && lane == 0) ((LAS unsigned*)(lds + AT_FLAG))[cur * 8 + wid] = wdone ? 1u : 0u;
        if (j > 0) { if (MODE == 1) AT_STAGE_LOAD(j - 1); AT_STAGE_WRITE(cur ^ 1); }
        __syncthreads();
        if (MODE == 1) {
            const LAS unsigned* fl = (const LAS unsigned*)(lds + AT_FLAG) + cur * 8;
            unsigned all = 1u;
#pragma unroll
            for (int w = 0; w < 8; ++w) all &= fl[w];
            if (all) break;
        }
    }
    float inv = 1.f;
    if (MODE == 0) { const float lt = l + __shfl_xor(l, 32); inv = 1.f / lt; }
    bf16* yp = Y + rowq * DM + h * 128 + 4 * hi;
#pragma unroll
    for (int dt = 0; dt < 4; ++dt)
#pragma unroll
        for (int g = 0; g < 4; ++g) { u32x2 w; w.x = pk_bf16(o[dt][4 * g] * inv, o[dt][4 * g + 1] * inv); w.y = pk_bf16(o[dt][4 * g + 2] * inv, o[dt][4 * g + 3] * inv);
            *(u32x2*)(yp + 32 * dt + 8 * g) = w; }
    __syncthreads();
}

template <int MODE>
__device__ __forceinline__ void attn_phase(LAS unsigned char* lds, const bf16* QK, const bf16* VT, const float* cum, bf16* Y, int wg, int nwg) {
    if (nwg == 256) {
        const int bh = wg >> 3, j = wg & 7;
#pragma unroll 1
        for (int i = 0; i < 4; ++i) { const int qb = (i == 0) ? 31 - j : (i == 1) ? 16 + j : (i == 2) ? 15 - j : j; attn_unit<MODE>(lds, QK, VT, cum, Y, bh >> 4, bh & 15, qb); }
    } else {
#pragma unroll 1
        for (int u = wg; u < 1024; u += nwg) attn_unit<MODE>(lds, QK, VT, cum, Y, u >> 9, (u >> 5) & 15, 31 - (u & 31));
    }
}

constexpr int LR_RAW = 0, LR_U = 22528, LR_WT = LR_U + 25600, LR_PRE = LR_WT + 19200, LR_UCF = LR_PRE + 12544, LR_GT = LR_UCF + 6400, LR_YT = LR_GT + 6400, LR_CW = LR_YT + 3072, LR_CH = LR_CW + 3360, LR_END = LR_CH + 512;
static_assert(LR_END <= LDSCTL_OFF, "LRU LDS map");
__device__ __forceinline__ void lru_phase(LAS unsigned char* lds, const bf16* PROJ, const float* conv_w, const float* conv_b, const float* w_r, const float* b_r,
                                          const float* w_i, const float* b_i, const float* lam, bf16* YB, int wg, int nwg) {
    const int tid = threadIdx.x, lane = tid & 63, wid = __builtin_amdgcn_readfirstlane(tid >> 6);
    LAS float* PRE = (LAS float*)(lds + LR_PRE); LAS float* UCF = (LAS float*)(lds + LR_UCF); LAS float* GT = (LAS float*)(lds + LR_GT);
    LAS float* CW = (LAS float*)(lds + LR_CW); LAS float* CH = (LAS float*)(lds + LR_CH);
#pragma unroll 1
    for (int unit = wg; unit < 224; unit += nwg) {
        const int b = unit / 112, rem = unit % 112, n = rem / 7, sl = rem % 7;
        const int c0 = n * LRU_BD + sl * 24;
        __syncthreads();
        for (int idx = tid; idx < 48 * 200; idx += 512) { const int e = idx / 200, d = idx % 200; float v = 0.f;
            if (d < LRU_BD) { const int eo = sl * 24 + (e < 24 ? e : e - 24); v = (e < 24 ? w_r : w_i)[((size_t)n * LRU_BD + d) * LRU_BD + eo]; }
            *(LAS bf16*)(lds + LR_WT + e * 400 + d * 2) = f2bf16(v); }
        for (int idx = tid; idx < 64 * 32; idx += 512) { const int t = idx >> 5, d = 168 + (idx & 31); *(LAS bf16*)(lds + LR_U + t * 400 + d * 2) = 0; }
        for (int idx = tid; idx < 5 * LRU_BD; idx += 512) { const int j = idx / LRU_BD, d = idx % LRU_BD; CW[idx] = (j < 4) ? conv_w[(size_t)j * LRU_W + n * LRU_BD + d] : conv_b[n * LRU_BD + d]; }
        if (tid < 24) { CH[tid] = b_r[c0 + tid]; CH[24 + tid] = b_i[c0 + tid]; CH[48 + tid] = log_sigmoid_f(lam[c0 + tid]); }
        float carry[3] = {0.f, 0.f, 0.f};
        v4u rreg[3], greg;
        const bf16* ubase = PROJ + ((size_t)b * SEQ) * 5376 + LRU_W + n * LRU_BD;
        const bf16* gbase = PROJ + ((size_t)b * SEQ) * 5376 + c0;
#define LR_LOAD(t0_) do { _Pragma("unroll") for (int i_ = 0; i_ < 3; ++i_) { const int c_ = tid + 512 * i_; const int row_ = c_ / 21, ch_ = c_ % 21; const int tt_ = (t0_) - 3 + row_; \
            rreg[i_] = (v4u){0u, 0u, 0u, 0u}; if (c_ < 67 * 21 && tt_ >= 0) rreg[i_] = *(const v4u*)(ubase + (size_t)tt_ * 5376 + ch_ * 8); } \
        if (tid < 192) { const int row_ = tid / 3, ch_ = tid % 3; greg = *(const v4u*)(gbase + (size_t)((t0_) + row_) * 5376 + ch_ * 8); } } while (0)
        LR_LOAD(0);
#pragma unroll 1
        for (int st = 0; st < SEQ / 64; ++st) {
            const int t0 = st * 64;
#pragma unroll
            for (int i = 0; i < 3; ++i) { const int c = tid + 512 * i; const int row = c / 21, ch = c % 21; if (c < 67 * 21) *(LAS v4u*)(lds + LR_RAW + row * 336 + ch * 16) = rreg[i]; }
            if (tid < 192) { const int row = tid / 3, ch = tid % 3; LAS float* gp = GT + row * 25 + ch * 8;
                gp[0] = bflo(greg.x); gp[1] = bfhi(greg.x); gp[2] = bflo(greg.y); gp[3] = bfhi(greg.y); gp[4] = bflo(greg.z); gp[5] = bfhi(greg.z); gp[6] = bflo(greg.w); gp[7] = bfhi(greg.w); }
            __syncthreads();
            if (st + 1 < SEQ / 64) LR_LOAD(t0 + 64);
#pragma unroll
            for (int i = 0; i < 3; ++i) { const int it = tid + 512 * i;
                if (it < 64 * 21) { const int t = it / 21, ch = it % 21; float acc[8];
#pragma unroll
                    for (int e = 0; e < 8; ++e) acc[e] = CW[4 * LRU_BD + ch * 8 + e];
#pragma unroll
                    for (int j = 0; j < 4; ++j) { const v4u rv = *(const LAS v4u*)(lds + LR_RAW + (t + j) * 336 + ch * 16); const LAS float* cw = CW + j * LRU_BD + ch * 8;
                        acc[0] += cw[0] * bflo(rv.x); acc[1] += cw[1] * bfhi(rv.x); acc[2] += cw[2] * bflo(rv.y); acc[3] += cw[3] * bfhi(rv.y);
                        acc[4] += cw[4] * bflo(rv.z); acc[5] += cw[5] * bfhi(rv.z); acc[6] += cw[6] * bflo(rv.w); acc[7] += cw[7] * bfhi(rv.w); }
                    v4u o; o.x = pk_bf16(acc[0], acc[1]); o.y = pk_bf16(acc[2], acc[3]); o.z = pk_bf16(acc[4], acc[5]); o.w = pk_bf16(acc[6], acc[7]);
                    *(LAS v4u*)(lds + LR_U + t * 400 + ch * 16) = o;
                    const int cs = ch - 3 * sl;
                    if (cs >= 0 && cs < 3) { LAS float* up = UCF + t * 25 + cs * 8;
#pragma unroll
                        for (int e = 0; e < 8; ++e) up[e] = acc[e]; } } }
            __syncthreads();
            if (wid < 4) {
                const int fr = lane & 15, fq = lane >> 4;
                f32x4 acc[3];
#pragma unroll
                for (int nt = 0; nt < 3; ++nt) acc[nt] = (f32x4){0.f, 0.f, 0.f, 0.f};
#pragma unroll
                for (int ks = 0; ks < 6; ++ks) { const bf16x8 af = *(const LAS bf16x8*)(lds + LR_U + (16 * wid + fr) * 400 + ks * 64 + fq * 16);
#pragma unroll
                    for (int nt = 0; nt < 3; ++nt) { const bf16x8 bfr = *(const LAS bf16x8*)(lds + LR_WT + (16 * nt + fr) * 400 + ks * 64 + fq * 16); acc[nt] = MFMA16(af, bfr, acc[nt]); } }
#pragma unroll
                for (int nt = 0; nt < 3; ++nt)
#pragma unroll
                    for (int r = 0; r < 4; ++r) PRE[(16 * wid + 4 * fq + r) * 49 + 16 * nt + fr] = acc[nt][r];
            }
            __syncthreads();
#pragma unroll
            for (int cc = 0; cc < 3; ++cc) { const int c = 3 * wid + cc;
                const float rp = PRE[lane * 49 + c] + CH[c], ip = PRE[lane * 49 + 24 + c] + CH[24 + c], uu = UCF[lane * 25 + c];
                const float rg = sigmoid_f(rp), ig = sigmoid_f(ip), la = 8.f * rg * CH[48 + c];
                float A = expf(la), B = sqrtf(-expm1f(2.f * la)) * (ig * uu);
#pragma unroll
                for (int o = 1; o < 64; o <<= 1) { const float Ap = __shfl_up(A, o), Bp = __shfl_up(B, o); if (lane >= o) { B = A * Bp + B; A = A * Ap; } }
                const float hval = A * carry[cc] + B;
                carry[cc] = __shfl(hval, 63);
                const float y = hval * gelu_tanh_f(GT[lane * 25 + c]);
                *(LAS bf16*)(lds + LR_YT + lane * 48 + c * 2) = f2bf16(y); }
            __syncthreads();
            if (tid < 192) { const int row = tid / 3, ch = tid % 3; *(v4u*)(YB + ((size_t)b * SEQ + t0 + row) * LRU_W + c0 + ch * 8) = *(const LAS v4u*)(lds + LR_YT + row * 48 + ch * 16); }
        }
#undef LR_LOAD
    }
}

constexpr size_t ML_ARR = (size_t)8 * SEQ;
__device__ __forceinline__ void mlstm_pre(const float* G, const float* bif, float* MLS, int gw, int lane) {
    if (gw >= 8) return;
    const int b = gw >> 2, h = gw & 3; const float bi = bif[h], bfg = bif[4 + h];
    float* ALPHA = MLS; float* BETA = MLS + ML_ARR; float* WI = MLS + 2 * ML_ARR; float* EMv = MLS + 3 * ML_ARR; float* WK = MLS + 4 * ML_ARR; float* DEC = MLS + 5 * ML_ARR;
    float m_prev = -1e30f;
#pragma unroll 1
    for (int c = 0; c < SEQ / 64; ++c) {
        const int t = c * 64 + lane; const size_t row = (size_t)b * SEQ + t;
        const float ip = G[row * 16 + h] + bi, fp = G[row * 16 + 4 + h] + bfg;
        float bt = log_sigmoid_f(fp);
#pragma unroll
        for (int o = 1; o < 64; o <<= 1) { const float v = __shfl_up(bt, o); if (lane >= o) bt += v; }
        const float g = __shfl(bt, 63);
        const float beta = ip - bt;
        float P = beta;
#pragma unroll
        for (int o = 1; o < 64; o <<= 1) { const float v = __shfl_up(P, o); if (lane >= o) P = fmaxf(P, v); }
        const float mt = bt + fmaxf(m_prev, P);
        const float P63 = __shfl(P, 63), m_new = g + fmaxf(m_prev, P63);
        const size_t o = (size_t)gw * SEQ + t;
        ALPHA[o] = bt - mt; BETA[o] = beta; WI[o] = expf(bt + m_prev - mt); EMv[o] = expf(-mt); WK[o] = expf(g - m_new + beta) * 0.0625f;
        if (lane == 0) DEC[gw * 128 + c] = expf(g + m_prev - m_new);
        m_prev = m_new;
    }
}

constexpr int ML_QT = 0, ML_KK = 33792, ML_KT = 67584, ML_CET = ML_KT + 36864, ML_VE0 = ML_CET + 16896, ML_VEW = ML_VE0 + 4608, ML_ST = ML_VEW + 4608, ML_SC = ML_ST + 9216, ML_DEN = ML_SC + 1280, ML_END = ML_DEN + 256;
static_assert(ML_END <= LDSCTL_OFF, "mLSTM LDS map");
__device__ __forceinline__ void mlstm_core(LAS unsigned char* lds, const bf16* PROJ, const bf16* KT, const float* MLS, bf16* HB, int wg, int nwg) {
    const int tid = threadIdx.x, lane = tid & 63, wid = __builtin_amdgcn_readfirstlane(tid >> 6), fr = lane & 15, fq = lane >> 4;
    const float* ALPHA = MLS; const float* BETA = MLS + ML_ARR; const float* WI = MLS + 2 * ML_ARR; const float* EMv = MLS + 3 * ML_ARR; const float* WK = MLS + 4 * ML_ARR; const float* DEC = MLS + 5 * ML_ARR;
    LAS float* SC = (LAS float*)(lds + ML_SC); LAS float* DEN = (LAS float*)(lds + ML_DEN);
#pragma unroll 1
    for (int unit = wg; unit < 256; unit += nwg) {
        const int bh = unit >> 5, sl = unit & 31, b = bh >> 2, h = bh & 3, e0 = sl * 16;
        __syncthreads();
        for (int i = tid; i < 16896 / 4; i += 512) ((LAS unsigned*)(lds + ML_CET))[i] = 0u;
        for (int i = tid; i < 16 * 72; i += 512) { const int r = 16 + i / 72, c = i % 72; *(LAS bf16*)(lds + ML_VE0 + r * 144 + c * 2) = (r == 16) ? (bf16)0x3F80 : (bf16)0; *(LAS bf16*)(lds + ML_VEW + r * 144 + c * 2) = 0; }
        f32x4 cst[2][2];
#pragma unroll
        for (int i = 0; i < 2; ++i)
#pragma unroll
            for (int j = 0; j < 2; ++j) cst[i][j] = (f32x4){0.f, 0.f, 0.f, 0.f};
        const bf16* qbase = PROJ + ((size_t)b * SEQ) * 6144 + h * 256;
        const bf16* kbase = qbase + 1024;
        const bf16* vbase = PROJ + ((size_t)b * SEQ) * 6144 + 2048 + h * 512 + e0;
        const bf16* ktbase = KT + ((size_t)h * 256) * MTOK + (size_t)b * SEQ;
        const size_t sbase = (size_t)bh * SEQ;
        v4u qreg[4], kreg[4], ktreg[4], vreg; float screg = 0.f, wkreg = 0.f;
#define ML_LOAD(t0_) do { _Pragma("unroll") for (int i_ = 0; i_ < 4; ++i_) { const int c_ = tid + 512 * i_; const int row_ = c_ >> 5, ch_ = c_ & 31; \
            qreg[i_] = *(const v4u*)(qbase + (size_t)((t0_) + row_) * 6144 + ch_ * 8); kreg[i_] = *(const v4u*)(kbase + (size_t)((t0_) + row_) * 6144 + ch_ * 8); \
            const int d_ = c_ >> 3, kc_ = c_ & 7; ktreg[i_] = *(const v4u*)(ktbase + (size_t)d_ * MTOK + (t0_) + kc_ * 8); } \
        if (tid < 128) { const int row_ = tid >> 1, hf_ = tid & 1; vreg = *(const v4u*)(vbase + (size_t)((t0_) + row_) * 6144 + hf_ * 8); wkreg = WK[sbase + (t0_) + row_]; } \
        if (tid >= 128 && tid < 448) { const int a_ = (tid - 128) >> 6, s_ = (tid - 128) & 63; screg = MLS[(size_t)a_ * ML_ARR + sbase + (t0_) + s_]; } } while (0)
        ML_LOAD(0);
#pragma unroll 1
        for (int c = 0; c < SEQ / 64; ++c) {
            const int t0 = c * 64;
#pragma unroll
            for (int i = 0; i < 4; ++i) { const int cc = tid + 512 * i; const int row = cc >> 5, ch = cc & 31;
                *(LAS v4u*)(lds + ML_QT + row * 528 + ch * 16) = qreg[i]; *(LAS v4u*)(lds + ML_KK + row * 528 + ch * 16) = kreg[i];
                const int d = cc >> 3, kc = cc & 7; *(LAS v4u*)(lds + ML_KT + d * 144 + kc * 16) = ktreg[i]; }
            if (tid < 128) { const int row = tid >> 1, hf = tid & 1; const unsigned w4[4] = {vreg.x, vreg.y, vreg.z, vreg.w};
#pragma unroll
                for (int e = 0; e < 8; ++e) { const unsigned wv = w4[e >> 1]; const unsigned short raw = (e & 1) ? (unsigned short)(wv >> 16) : (unsigned short)(wv & 0xffffu);
                    *(LAS bf16*)(lds + ML_VE0 + (hf * 8 + e) * 144 + row * 2) = raw;
                    *(LAS bf16*)(lds + ML_VEW + (hf * 8 + e) * 144 + row * 2) = f2bf16(bf2f(raw) * wkreg); }
                if (hf == 0) *(LAS bf16*)(lds + ML_VEW + 16 * 144 + row * 2) = f2bf16(wkreg); }
            if (tid >= 128 && tid < 448) SC[tid - 128] = screg;
            const float dec = ld_agent_f32(DEC + bh * 128 + c);
            __syncthreads();
            if (c + 1 < SEQ / 64) ML_LOAD(t0 + 64);
            { const int tt = wid >> 1;
#pragma unroll
              for (int si = 0; si < 2; ++si) { const int stl = 2 * (wid & 1) + si;
                  u32x2 w = (u32x2){0u, 0u};
                  if (stl <= tt) {
                      f32x4 acc = (f32x4){0.f, 0.f, 0.f, 0.f};
#pragma unroll
                      for (int ks = 0; ks < 8; ++ks) { const bf16x8 af = *(const LAS bf16x8*)(lds + ML_KK + (16 * stl + fr) * 528 + ks * 64 + fq * 16);
                          const bf16x8 bfr = *(const LAS bf16x8*)(lds + ML_QT + (16 * tt + fr) * 528 + ks * 64 + fq * 16); acc = MFMA16(af, bfr, acc); }
                      const int t = 16 * tt + fr; const float al = SC[t]; const f32x4 be = *(const LAS f32x4*)(SC + 64 + 16 * stl + 4 * fq);
                      float sv[4];
#pragma unroll
                      for (int r = 0; r < 4; ++r) { const int s = 16 * stl + 4 * fq + r; sv[r] = (s <= t) ? acc[r] * 0.0625f * __expf(al + be[r]) : 0.f; }
                      w.x = pk_bf16(sv[0], sv[1]); w.y = pk_bf16(sv[2], sv[3]);
                  }
                  *(LAS u32x2*)(lds + ML_ST + (16 * tt + fr) * 144 + (16 * stl + 4 * fq) * 2) = w; } }
            __syncthreads();
            f32x4 num = (f32x4){0.f, 0.f, 0.f, 0.f};
            { const int tt = wid >> 1, et = wid & 1;
#pragma unroll
              for (int ks = 0; ks < 8; ++ks) { const bf16x8 af = *(const LAS bf16x8*)(lds + ML_QT + (16 * tt + fr) * 528 + ks * 64 + fq * 16);
                  const bf16x8 bfr = *(const LAS bf16x8*)(lds + ML_CET + (16 * et + fr) * 528 + ks * 64 + fq * 16); num = MFMA16(af, bfr, num); }
              const f32x4 wi = *(const LAS f32x4*)(SC + 128 + 16 * tt + 4 * fq);
#pragma unroll
              for (int r = 0; r < 4; ++r) num[r] *= wi[r];
#pragma unroll
              for (int ks = 0; ks < 2; ++ks) { const bf16x8 af = *(const LAS bf16x8*)(lds + ML_ST + (16 * tt + fr) * 144 + ks * 64 + fq * 16);
                  const bf16x8 bfr = *(const LAS bf16x8*)(lds + ML_VE0 + (16 * et + fr) * 144 + ks * 64 + fq * 16); num = MFMA16(af, bfr, num); }
              if (et == 1 && fr == 0) *(LAS f32x4*)(DEN + 16 * tt + 4 * fq) = num; }
            __syncthreads();
            { const int tt = wid >> 1, et = wid & 1;
              if (et == 0) { const f32x4 den = *(const LAS f32x4*)(DEN + 16 * tt + 4 * fq); const f32x4 em = *(const LAS f32x4*)(SC + 192 + 16 * tt + 4 * fq);
#pragma unroll
                  for (int r = 0; r < 4; ++r) { const float hv = num[r] / fmaxf(fabsf(den[r]), em[r]);
                      HB[((size_t)b * SEQ + t0 + 16 * tt + 4 * fq + r) * DM + h * 512 + e0 + fr] = f2bf16(hv); } } }
#pragma unroll
            for (int i = 0; i < 2; ++i)
#pragma unroll
                for (int j = 0; j < 2; ++j) {
#pragma unroll
                    for (int r = 0; r < 4; ++r) cst[i][j][r] *= dec;
#pragma unroll
                    for (int ks = 0; ks < 2; ++ks) { const bf16x8 af = *(const LAS bf16x8*)(lds + ML_KT + (16 * (2 * wid + i) + fr) * 144 + ks * 64 + fq * 16);
                        const bf16x8 bfr = *(const LAS bf16x8*)(lds + ML_VEW + (16 * j + fr) * 144 + ks * 64 + fq * 16); cst[i][j] = MFMA16(af, bfr, cst[i][j]); }
                    u32x2 w; w.x = pk_bf16(cst[i][j][0], cst[i][j][1]); w.y = pk_bf16(cst[i][j][2], cst[i][j][3]);
                    *(LAS u32x2*)(lds + ML_CET + (16 * j + fr) * 528 + (16 * (2 * wid + i) + 4 * fq) * 2) = w; }
            __syncthreads();
        }
#undef ML_LOAD
    }
}

__device__ __forceinline__ void mlstm_post(const bf16* HB, const bf16* PROJ, const float* head_g, bf16* YB, int gw, int ngw, int lane) {
    for (int it = gw; it < MTOK * 4; it += ngw) {
        const int row = it >> 2, hh = it & 3;
        const v4u hv = *(const v4u*)(HB + (size_t)row * DM + hh * 512 + lane * 8);
        const v4u ov = *(const v4u*)(PROJ + (size_t)row * 6144 + 4096 + hh * 512 + lane * 8);
        float hf[8] = {bflo(hv.x), bfhi(hv.x), bflo(hv.y), bfhi(hv.y), bflo(hv.z), bfhi(hv.z), bflo(hv.w), bfhi(hv.w)};
        const float of[8] = {bflo(ov.x), bfhi(ov.x), bflo(ov.y), bfhi(ov.y), bflo(ov.z), bfhi(ov.z), bflo(ov.w), bfhi(ov.w)};
        float ss = 0.f;
#pragma unroll
        for (int e = 0; e < 8; ++e) ss += hf[e] * hf[e];
        const float r = rsqrtf(wave_sum(ss) * (1.f / 512.f) + EPS);
        const f32x4 g0 = *(const f32x4*)(head_g + hh * 512 + lane * 8), g1 = *(const f32x4*)(head_g + hh * 512 + lane * 8 + 4);
        const float gg[8] = {g0.x, g0.y, g0.z, g0.w, g1.x, g1.y, g1.z, g1.w};
#pragma unroll
        for (int e = 0; e < 8; ++e) hf[e] = sigmoid_f(of[e]) * (hf[e] * r * gg[e]);
        v4u w; w.x = pk_bf16(hf[0], hf[1]); w.y = pk_bf16(hf[2], hf[3]); w.z = pk_bf16(hf[4], hf[5]); w.w = pk_bf16(hf[6], hf[7]);
        *(v4u*)(YB + (size_t)row * DM + hh * 512 + lane * 8) = w;
    }
}

struct Args { const float* in[22]; float* out; unsigned char* ws; TrJob jobs[NJOBS]; int njob_items; int ph_lo, ph_hi; int pad; };
constexpr int NPH = 32;

#define GEMM_CALL(ACT_, Aptr, Bptr, Mv, Nv, Kv, Optr, ldc_, gcol_, Gptr, ng_) do { \
        pg8::Gemm g_{(const pg8::bf16_t*)(Aptr), (const pg8::bf16_t*)(Bptr), (Mv), (Nv), (Kv)}; pg8::StaticOrder S_; S_.init((Mv), (Nv), (int)gridDim.x, (int)blockIdx.x); \
        pg8::EpiStore<ACT_> E_{(pg8::bf16_t*)(Optr), (ldc_), (gcol_), (Gptr), (ng_)}; \
        pg8::gemm_phase<pg8::EpiStore<ACT_>, pg8::StaticOrder, true, true>(lds, g_, S_, E_); } while (0)

__global__ void __launch_bounds__(NWAVES * 64, 2) fwd_kernel(Args args) {
    extern __shared__ __attribute__((aligned(16))) unsigned char lds_raw[];
    LAS unsigned char* lds = (LAS unsigned char*)lds_raw;
    volatile LAS unsigned* MISC = (volatile LAS unsigned*)(lds + LDSCTL_OFF);
    const int tid = threadIdx.x, lane = tid & 63, wave = __builtin_amdgcn_readfirstlane(tid >> 6);
    const int G = gridDim.x, wg = blockIdx.x;
    const int gw = wg * NWAVES + wave, ngw = G * NWAVES;
    unsigned char* ws = args.ws;
    for (int u = tid; u < 64; u += NWAVES * 64) MISC[u] = 0u;
    __syncthreads();
    const int lo = args.ph_lo, hi = args.ph_hi;
    const bool use_bar = (hi - lo) > 1;
    XcdBarrier bar; bar.bar = (unsigned*)(ws + WS_CTL) + 4096; bar.x = 0; bar.st = nullptr;
    if (use_bar) bar = xcd_barrier_post((unsigned*)(ws + WS_CTL) + 4096, MISC + 8);
#ifdef ONLY_PHASE
#define IN(k) ((k) == ONLY_PHASE && lo <= (k) && (k) < hi)
#else
#define IN(k) (lo <= (k) && (k) < hi)
#endif
#define SEAM(k) do { if (IN((k) + 1)) xcd_barrier(bar); } while (0)

    const float* x_in = args.in[0]; const float* norm_g = args.in[1];
    float* out = args.out;
    bf16* W_FOXIN = (bf16*)(ws + WS_W_FOXIN); bf16* W_FOXOUT = (bf16*)(ws + WS_W_FOXOUT); bf16* W_LRUIN = (bf16*)(ws + WS_W_LRUIN); bf16* W_LRUOUT = (bf16*)(ws + WS_W_LRUOUT);
    bf16* W_SBIN = (bf16*)(ws + WS_W_SBIN); bf16* W_SBOUT = (bf16*)(ws + WS_W_SBOUT); bf16* W_MLIN = (bf16*)(ws + WS_W_MLIN); bf16* W_MLOUT = (bf16*)(ws + WS_W_MLOUT);
    bf16* W1 = (bf16*)(ws + WS_W1); bf16* W2 = (bf16*)(ws + WS_W2);
    bf16* H = (bf16*)(ws + WS_H); bf16* HM = (bf16*)(ws + WS_HM); bf16* PROJ = (bf16*)(ws + WS_PROJ); bf16* VT = (bf16*)(ws + WS_PROJ + WS_VT_OFF); bf16* Y = (bf16*)(ws + WS_Y);
    bf16* HID = (bf16*)(ws + WS_HID); bf16* KT = (bf16*)(ws + WS_KT);
    float* GATES = (float*)(ws + WS_GATES); float* CUM = (float*)(ws + WS_CUM); float* MLS = (float*)(ws + WS_MLS);

    if (IN(0)) {
        LAS float* scr = (LAS float*)(lds + wave * 16384);
        for (int it = gw; it < args.njob_items; it += ngw) {
            int j = 0;
#pragma unroll 1
            for (int q = 1; q < NJOBS; ++q) if (it >= args.jobs[q].item0) j = q;
            const TrJob jb = args.jobs[j];
            tr_item(jb.src, jb.ldw, jb.ncols, jb.K, jb.dst, scr, it - jb.item0, lane);
        }
        gate_rows(args.in[4], 6160, 6144, 16, W_FOXIN + (size_t)4096 * DM, wg * 512 + tid, G * 512);
        gate_rows(args.in[18], 6152, 6144, 8, W_MLIN + (size_t)6144 * DM, wg * 512 + tid, G * 512);
        row_pass(x_in, nullptr, nullptr, norm_g, nullptr, H, gw, ngw, lane);
        SEAM(0);
    }
    if (IN(1)) {
        GEMM_CALL(0, H, W_FOXIN, MTOK, 4352, DM, PROJ, 4096, 4096, GATES, 16);
        GEMM_CALL(0, W_FOXIN + (size_t)4352 * DM, H, 2048, MTOK, DM, VT, MTOK, INT_MAX, nullptr, 0);
        SEAM(1);
    }
    if (IN(2)) { fox_cumsum(lds, GATES, args.in[5], CUM, wg, G); SEAM(2); }
    if (IN(3)) { attn_phase<0>(lds, PROJ, VT, CUM, Y, wg, G); SEAM(3); }
    if (IN(4)) { GEMM_CALL(0, Y, W_FOXOUT, MTOK, DM, DM, HM, DM, INT_MAX, nullptr, 0); SEAM(4); }
    if (IN(5)) { row_pass(x_in, HM, norm_g + 1 * DM, norm_g + 2 * DM, out, H, gw, ngw, lane); SEAM(5); }
    if (IN(6)) { GEMM_CALL(2, H, W1, MTOK, DFF, DM, HID, DFF, INT_MAX, nullptr, 0); SEAM(6); }
    if (IN(7)) { GEMM_CALL(0, HID, W2, MTOK, DM, DFF, HM, DM, INT_MAX, nullptr, 0); SEAM(7); }
    if (IN(8)) { row_pass(out, HM, norm_g + 3 * DM, norm_g + 4 * DM, out, H, gw, ngw, lane); SEAM(8); }
    if (IN(9)) { GEMM_CALL(0, H, W_LRUIN, MTOK, 5376, DM, PROJ, 5376, INT_MAX, nullptr, 0); SEAM(9); }
    if (IN(10)) { lru_phase(lds, PROJ, args.in[8], args.in[9], args.in[10], args.in[11], args.in[12], args.in[13], args.in[14], Y, wg, G); SEAM(10); }
    if (IN(11)) { GEMM_CALL(0, Y, W_LRUOUT, MTOK, DM, LRU_W, HM, DM, INT_MAX, nullptr, 0); SEAM(11); }
    if (IN(12)) { row_pass(out, HM, norm_g + 5 * DM, norm_g + 6 * DM, out, H, gw, ngw, lane); SEAM(12); }
    if (IN(13)) { GEMM_CALL(2, H, W1 + (size_t)1 * DFF * DM, MTOK, DFF, DM, HID, DFF, INT_MAX, nullptr, 0); SEAM(13); }
    if (IN(14)) { GEMM_CALL(0, HID, W2 + (size_t)1 * DFF * DM, MTOK, DM, DFF, HM, DM, INT_MAX, nullptr, 0); SEAM(14); }
    if (IN(15)) { row_pass(out, HM, norm_g + 7 * DM, norm_g + 8 * DM, out, H, gw, ngw, lane); SEAM(15); }
    if (IN(16)) {
        GEMM_CALL(0, H, W_SBIN, MTOK, 4096, DM, PROJ, 4096, INT_MAX, nullptr, 0);
        GEMM_CALL(0, W_SBIN + (size_t)4096 * DM, H, 2048, MTOK, DM, VT, MTOK, INT_MAX, nullptr, 0);
        SEAM(16);
    }
    if (IN(17)) { attn_phase<1>(lds, PROJ, VT, CUM, Y, wg, G); SEAM(17); }
    if (IN(18)) { GEMM_CALL(0, Y, W_SBOUT, MTOK, DM, DM, HM, DM, INT_MAX, nullptr, 0); SEAM(18); }
    if (IN(19)) { row_pass(out, HM, norm_g + 9 * DM, norm_g + 10 * DM, out, H, gw, ngw, lane); SEAM(19); }
    if (IN(20)) { GEMM_CALL(2, H, W1 + (size_t)2 * DFF * DM, MTOK, DFF, DM, HID, DFF, INT_MAX, nullptr, 0); SEAM(20); }
    if (IN(21)) { GEMM_CALL(0, HID, W2 + (size_t)2 * DFF * DM, MTOK, DM, DFF, HM, DM, INT_MAX, nullptr, 0); SEAM(21); }
    if (IN(22)) { row_pass(out, HM, norm_g + 11 * DM, norm_g + 12 * DM, out, H, gw, ngw, lane); SEAM(22); }
    if (IN(23)) {
        GEMM_CALL(0, H, W_MLIN, MTOK, 6400, DM, PROJ, 6144, 6144, GATES, 8);
        GEMM_CALL(0, W_MLIN + (size_t)1024 * DM, H, 1024, MTOK, DM, KT, MTOK, INT_MAX, nullptr, 0);
        SEAM(23);
    }
    if (IN(24)) { mlstm_pre(GATES, args.in[19], MLS, gw, lane); SEAM(24); }
    if (IN(25)) { mlstm_core(lds, PROJ, KT, MLS, HM, wg, G); SEAM(25); }
    if (IN(26)) { mlstm_post(HM, PROJ, args.in[20], Y, gw, ngw, lane); SEAM(26); }
    if (IN(27)) { GEMM_CALL(0, Y, W_MLOUT, MTOK, DM, DM, HM, DM, INT_MAX, nullptr, 0); SEAM(27); }
    if (IN(28)) { row_pass(out, HM, norm_g + 13 * DM, norm_g + 14 * DM, out, H, gw, ngw, lane); SEAM(28); }
    if (IN(29)) { GEMM_CALL(2, H, W1 + (size_t)3 * DFF * DM, MTOK, DFF, DM, HID, DFF, INT_MAX, nullptr, 0); SEAM(29); }
    if (IN(30)) { GEMM_CALL(0, HID, W2 + (size_t)3 * DFF * DM, MTOK, DM, DFF, HM, DM, INT_MAX, nullptr, 0); SEAM(30); }
    if (IN(31)) { row_pass(out, HM, norm_g + 15 * DM, nullptr, out, nullptr, gw, ngw, lane); }
#undef IN
#undef SEAM
}

#ifndef N_LAUNCH_SPLIT
#define N_LAUNCH_SPLIT 1
#endif
extern "C" void kernel_launch(void* const* d_in, const int* in_sizes, int n_in, void* d_out, int out_size, void* d_ws, size_t ws_size, hipStream_t stream) {
    static int grid = 0;
    if (grid == 0) {
        if (n_in != 22 || out_size != MTOK * DM || ws_size < WS_END) { fprintf(stderr, "kernel_launch: unexpected shapes (n_in %d, out %d, ws %zu)\n", n_in, out_size, ws_size); grid = -1; return; }
        int dev = 0, cus = 0, per_cu = 0;
        if (hipGetDevice(&dev) != hipSuccess || hipDeviceGetAttribute(&cus, hipDeviceAttributeMultiprocessorCount, dev) != hipSuccess) { grid = -1; return; }
        if (hipFuncSetAttribute((const void*)fwd_kernel, hipFuncAttributeMaxDynamicSharedMemorySize, LDS_BYTES) != hipSuccess) { fprintf(stderr, "kernel_launch: hipFuncSetAttribute failed\n"); grid = -1; return; }
        if (hipOccupancyMaxActiveBlocksPerMultiprocessor(&per_cu, (const void*)fwd_kernel, NWAVES * 64, LDS_BYTES) != hipSuccess || per_cu < 1) { fprintf(stderr, "kernel_launch: occupancy query says %d\n", per_cu); per_cu = 1; }
        (void)hipGetLastError();
        grid = cus;
    }
    if (grid < 0) return;
    unsigned char* ws = (unsigned char*)d_ws;
    Args a{};
    for (int i = 0; i < 22; ++i) a.in[i] = (const float*)d_in[i];
    a.out = (float*)d_out; a.ws = ws;
    {
        int nj = 0, items = 0;
        auto add = [&](const float* src, int ldw, int ncols, int K, size_t dst_off) { a.jobs[nj].src = src; a.jobs[nj].dst = (bf16*)(ws + dst_off); a.jobs[nj].ldw = ldw; a.jobs[nj].ncols = ncols; a.jobs[nj].K = K; a.jobs[nj].item0 = items; items += (K / 64) * (ncols / 32); ++nj; };
        const float* fox_in = a.in[4]; const float* ml_in = a.in[18];
        add(fox_in, 6160, 4096, DM, WS_W_FOXIN);
        add(fox_in + 4096, 6160, 2048, DM, WS_W_FOXIN + (size_t)4352 * DM * 2);
        add(a.in[6], DM, DM, DM, WS_W_FOXOUT);
        add(a.in[7], 5376, 5376, DM, WS_W_LRUIN);
        add(a.in[15], DM, DM, LRU_W, WS_W_LRUOUT);
        add(a.in[16], 6144, 6144, DM, WS_W_SBIN);
        add(a.in[17], DM, DM, DM, WS_W_SBOUT);
        add(ml_in, 6152, 6144, DM, WS_W_MLIN);
        add(a.in[21], DM, DM, DM, WS_W_MLOUT);
        for (int l = 0; l < 4; ++l) add(a.in[2] + (size_t)l * DM * DFF, DFF, DFF, DM, WS_W1 + (size_t)l * DFF * DM * 2);
        for (int l = 0; l < 4; ++l) add(a.in[3] + (size_t)l * DFF * DM, DM, DM, DFF, WS_W2 + (size_t)l * DFF * DM * 2);
        a.njob_items = items;
    }
    if (hipMemsetAsync(ws + WS_CTL, 0, CTL_ZERO_BYTES, stream) != hipSuccess) { fprintf(stderr, "kernel_launch: memset failed\n"); return; }
#if N_LAUNCH_SPLIT
    for (int p = 0; p < NPH; ++p) { a.ph_lo = p; a.ph_hi = p + 1; hipLaunchKernelGGL(fwd_kernel, dim3(grid), dim3(NWAVES * 64), LDS_BYTES, stream, a); }
#else
    a.ph_lo = 0; a.ph_hi = NPH;
    hipLaunchKernelGGL(fwd_kernel, dim3(grid), dim3(NWAVES * 64), LDS_BYTES, stream, a);
#endif
    const hipError_t le = hipPeekAtLastError();
    if (le != hipSuccess) fprintf(stderr, "kernel_launch: launch failed: %s\n", hipGetErrorName(le));
}
```

```cpp
#include <hip/hip_runtime.h>
#include <cstdio>
#include <cstdint>
#include <climits>
namespace pg8 {
#define PG8_LAS __attribute__((address_space(3)))
typedef unsigned short bf16_t;
typedef short bf16x8 __attribute__((ext_vector_type(8)));
typedef float f32x4 __attribute__((ext_vector_type(4)));
typedef unsigned u32x4 __attribute__((ext_vector_type(4)));
constexpr int BM = 256, BK = 64, HALF = 128, HTB = HALF * BK * 2  , STAGE_BYTES = 8 * HTB, NXCD = 8, WGM = 8;

__host__ __device__ __forceinline__ int lds_byte(int r, int c) { const int st = (r >> 4) * 2 + (c >> 5), rr = r & 15, cc = c & 31, ob = rr * 64 + cc * 2; return st * 1024 + (ob ^ (((ob >> 9) & 1) << 5)); }
__host__ __device__ __forceinline__ void stage_rc(int b, int& R, int& C) { const int st = b / 1024, sb = b % 1024, swz = sb ^ (((sb >> 9) & 1) << 5); R = (st >> 1) * 16 + swz / 64; C = (st & 1) * 32 + (swz % 64) / 2; }
__host__ __device__ __forceinline__ int perm32(int rho) { const int n = rho >> 4, i = rho & 15; return 8 * (i >> 2) + 4 * n + (i & 3); }

struct Unit { int pm, pn; };
struct Gemm { const bf16_t* A; const bf16_t* Bt; int M, N, K; };

struct StaticOrder {
    int nM, nN, nwg, G, c;
    __host__ __device__ void init(int M, int N, int G_, int c_) { nM = M / BM; nN = N / BM; nwg = nM * nN; G = G_; c = c_; }
    __host__ __device__ bool next(int i, Unit& u) const {
        const long L = (long)i * G + c; if (L >= nwg) return false;
        int wgid = (int)L; { const int q = nwg / NXCD, r = nwg % NXCD, xcd = wgid % NXCD, off = wgid / NXCD; wgid = (xcd < r ? xcd * (q + 1) : r * (q + 1) + (xcd - r) * q) + off; }
        const int nig = WGM * nN, gid = wgid / nig, fm = gid * WGM, gsz = (nM - fm) < WGM ? (nM - fm) : WGM;
        u.pm = fm + ((wgid % nig) % gsz); u.pn = (wgid % nig) / gsz; return true;
    }
    __device__ __forceinline__ void a_ready(const Unit&) const {}
    __device__ __forceinline__ void done(const Unit&) const {}
};
__device__ __forceinline__ unsigned pk_bf16(float lo, float hi) {
    typedef __bf16 bf2_t __attribute__((ext_vector_type(2))); typedef float f2_t __attribute__((ext_vector_type(2)));
    const bf2_t r = __builtin_convertvector((f2_t){lo, hi}, bf2_t); return __builtin_bit_cast(unsigned, r); }
template <int ACT  > struct EpiStore {
    static constexpr bool PERM = true, AFTER_DRAIN = false;
    bf16_t* O; int ldc; int gate_col0; float* G; int ng; const float* rs; const float* cs;
    __device__ __forceinline__ void operator()(const f32x4 (&acc)[2][2][4][2], const Unit& u, int wr, int wc, int fr, int fq) const {
        const int row0 = u.pm * BM + wr * 64 + fr; const int colt = u.pn * BM;
        if (colt >= gate_col0) {
            if (wc == 0) {
#pragma unroll
                for (int ai = 0; ai < 2; ++ai)
#pragma unroll
                    for (int m = 0; m < 4; ++m) { const int rr = row0 + ai * HALF + m * 16; float* gp = G + (size_t)rr * 16; const float sc = rs ? rs[rr] : 1.f;
#pragma unroll
                        for (int n = 0; n < 2; ++n) { const int c = 8 * fq + 4 * n; if (c < ng) *(f32x4*)(gp + c) = acc[ai][0][m][n] * sc; } }
            }
            return;
        }
        const int col0 = colt + wc * 32 + 8 * fq;
        f32x4 c0[2], c1[2];
#pragma unroll
        for (int bj = 0; bj < 2; ++bj) { c0[bj] = cs ? *(const f32x4*)(cs + col0 + bj * HALF) : (f32x4){1.f, 1.f, 1.f, 1.f}; c1[bj] = cs ? *(const f32x4*)(cs + col0 + bj * HALF + 4) : (f32x4){1.f, 1.f, 1.f, 1.f}; }
#pragma unroll
        for (int ai = 0; ai < 2; ++ai)
#pragma unroll
            for (int m = 0; m < 4; ++m) { const int rr = row0 + ai * HALF + m * 16; bf16_t* rowp = O + (size_t)rr * ldc + col0; const float sc = rs ? rs[rr] : 1.f;
#pragma unroll
                for (int bj = 0; bj < 2; ++bj) { f32x4 v0 = acc[ai][bj][m][0] * sc * c0[bj], v1 = acc[ai][bj][m][1] * sc * c1[bj];
                    if (ACT == 2) {
#pragma unroll
                        for (int e = 0; e < 4; ++e) { const float a = fmaxf(v0[e], 0.f), b = fmaxf(v1[e], 0.f); v0[e] = a * a; v1[e] = b * b; } }
                    u32x4 w; w.x = pk_bf16(v0[0], v0[1]); w.y = pk_bf16(v0[2], v0[3]); w.z = pk_bf16(v1[0], v1[1]); w.w = pk_bf16(v1[2], v1[3]);
                    *(u32x4*)(rowp + bj * HALF) = w; } }
    }
};
template <class Epi, class Sched, bool ALIGN_EPI = false, bool SP2 = false>
__device__ __forceinline__ void gemm_phase(PG8_LAS unsigned char* lds, const Gemm g, const Sched& S, const Epi& E) {
    const int tid = threadIdx.x, wid = __builtin_amdgcn_readfirstlane(tid >> 6), lane = tid & 63, wr = wid >> 2, wc = wid & 3, fr = lane & 15, fq = lane >> 4;
    const int K = g.K, nt = K / BK;
    unsigned voffA[2], voffB[2];
#pragma unroll
    for (int i = 0; i < 2; ++i) { int R, C; stage_rc(tid * 16 + i * 8192, R, C); const int Rb = Epi::PERM ? ((R & ~31) + perm32(R & 31)) : R;
        voffA[i] = (unsigned)(R * K + C) * 2u; voffB[i] = (unsigned)(Rb * K + C) * 2u; }
    const size_t kstep = (size_t)(BK * 2);
    const size_t hstep = (size_t)HALF * K * 2;
    const size_t tstep = 2 * hstep;
    const unsigned ldsw = (unsigned)wid * 1024u;
    const int aoff = lds_byte(wr * 64 + fr, fq * 8), boff = lds_byte(wc * 32 + fr, fq * 8);
#define PG8_SA(b, h) (((b) * 2 + (h)) * HTB)
#define PG8_SB(b, h) ((4 + (b) * 2 + (h)) * HTB)
#define PG8_STAGE(bufoff, gbase, voff) do { _Pragma("unroll") for (int _i = 0; _i < 2; ++_i) \
        __builtin_amdgcn_global_load_lds((const unsigned*)((const char*)(gbase) + (voff)[_i]), (PG8_LAS unsigned*)(lds + (bufoff) + ldsw + _i * 8192), 16, 0, 0); } while (0)
#define PG8_LDA(dst, b, h) do { _Pragma("unroll") for (int m = 0; m < 4; ++m) _Pragma("unroll") for (int k = 0; k < 2; ++k) dst[m][k] = *(const PG8_LAS bf16x8*)(lds + PG8_SA(b, h) + aoff + m * 2048 + k * 1024); } while (0)
#define PG8_LDB(dst, b, h) do { _Pragma("unroll") for (int n = 0; n < 2; ++n) _Pragma("unroll") for (int k = 0; k < 2; ++k) dst[n][k] = *(const PG8_LAS bf16x8*)(lds + PG8_SB(b, h) + boff + n * 2048 + k * 1024); } while (0)
#define PG8_MMA(ai, bj, At, Bt) do { __builtin_amdgcn_s_setprio(1); _Pragma("unroll") for (int m = 0; m < 4; ++m) _Pragma("unroll") for (int n = 0; n < 2; ++n) _Pragma("unroll") for (int k = 0; k < 2; ++k) \
        acc[ai][bj][m][n] = __builtin_amdgcn_mfma_f32_16x16x32_bf16(Bt[n][k], At[m][k], acc[ai][bj][m][n], 0, 0, 0); __builtin_amdgcn_s_setprio(0); } while (0)
#define PG8_WAIT_V(n) asm volatile("s_waitcnt vmcnt(" #n ")" ::: "memory")
#define PG8_WAIT_L(n) asm volatile("s_waitcnt lgkmcnt(" #n ")" ::: "memory")
#define PG8_BAR __builtin_amdgcn_s_barrier()
#define PG8_SCHED __builtin_amdgcn_sched_barrier(0)
    Unit cur, nxt; int ui = 0;
    if (!S.next(0, cur)) return;
    f32x4 acc[2][2][4][2];
#pragma unroll
    for (int a = 0; a < 2; ++a)
#pragma unroll
        for (int b = 0; b < 2; ++b)
#pragma unroll
            for (int m = 0; m < 4; ++m)
#pragma unroll
                for (int n = 0; n < 2; ++n) acc[a][b][m][n] = (f32x4){0.f, 0.f, 0.f, 0.f};
    bf16x8 At[4][2], B0[2][2], B1[2][2];
    const char* cA = (const char*)g.A + (size_t)cur.pm * tstep; const char* cB = (const char*)g.Bt + (size_t)cur.pn * tstep;
    S.a_ready(cur);
    if constexpr (SP2) {
        PG8_STAGE(PG8_SB(0, 0), cB, voffB); PG8_STAGE(PG8_SB(0, 1), cB + hstep, voffB); PG8_STAGE(PG8_SA(0, 0), cA, voffA); PG8_STAGE(PG8_SA(0, 1), cA + hstep, voffA);
        if (wr == 1) PG8_BAR;
        PG8_WAIT_V(2); PG8_BAR;
        PG8_STAGE(PG8_SB(1, 0), cB + kstep, voffB); PG8_STAGE(PG8_SA(1, 0), cA + kstep, voffA); PG8_STAGE(PG8_SB(1, 1), cB + hstep + kstep, voffB);
        PG8_WAIT_V(6); PG8_BAR;
    } else {
        PG8_STAGE(PG8_SB(0, 0), cB, voffB); PG8_STAGE(PG8_SA(0, 0), cA, voffA); PG8_STAGE(PG8_SB(0, 1), cB + hstep, voffB); PG8_STAGE(PG8_SA(0, 1), cA + hstep, voffA);
        if (wr == 1) PG8_BAR;
        PG8_WAIT_V(4); PG8_BAR;
        PG8_STAGE(PG8_SB(1, 0), cB + kstep, voffB); PG8_STAGE(PG8_SA(1, 0), cA + kstep, voffA); PG8_STAGE(PG8_SB(1, 1), cB + hstep + kstep, voffB);
        PG8_WAIT_V(6); PG8_BAR;
    }
    for (;;) {
        const bool has_next = S.next(ui + 1, nxt);
        const char* nA = has_next ? (const char*)g.A + (size_t)nxt.pm * tstep : cA; const char* nB = has_next ? (const char*)g.Bt + (size_t)nxt.pn * tstep : cB;
        for (int t = 0; t < nt; t += 2) {
            const bool last = (t == nt - 2);
            const char* a1 = cA + (size_t)(t + 1) * kstep;
            const char* a2 = last ? nA : cA + (size_t)(t + 2) * kstep; const char* b2 = last ? nB : cB + (size_t)(t + 2) * kstep;
            const char* a3 = a2 + kstep; const char* b3 = b2 + kstep;
            if (last && has_next) S.a_ready(nxt);
            if constexpr (SP2) {
            PG8_LDB(B0, 0, 0); PG8_LDB(B1, 0, 1); PG8_SCHED; PG8_LDA(At, 0, 0); PG8_STAGE(PG8_SA(1, 1), a1 + hstep, voffA);
            PG8_WAIT_V(8); PG8_WAIT_L(0); PG8_BAR; PG8_MMA(0, 0, At, B0); PG8_MMA(0, 1, At, B1); PG8_BAR; PG8_SCHED;
            PG8_LDA(At, 0, 1); PG8_STAGE(PG8_SB(0, 0), b2, voffB); PG8_STAGE(PG8_SB(0, 1), b2 + hstep, voffB); PG8_STAGE(PG8_SA(0, 0), a2, voffA);
            PG8_WAIT_V(8); PG8_WAIT_L(0); PG8_BAR; PG8_MMA(1, 0, At, B0); PG8_MMA(1, 1, At, B1); PG8_BAR; PG8_SCHED;
            PG8_LDB(B0, 1, 0); PG8_LDB(B1, 1, 1); PG8_SCHED; PG8_LDA(At, 1, 0); PG8_STAGE(PG8_SA(0, 1), a2 + hstep, voffA);
            PG8_WAIT_V(8); PG8_WAIT_L(0); PG8_BAR; PG8_MMA(0, 0, At, B0); PG8_MMA(0, 1, At, B1); PG8_BAR; PG8_SCHED;
            PG8_LDA(At, 1, 1); PG8_STAGE(PG8_SB(1, 0), b3, voffB); PG8_STAGE(PG8_SB(1, 1), b3 + hstep, voffB); PG8_STAGE(PG8_SA(1, 0), a3, voffA);
            PG8_WAIT_V(8); PG8_WAIT_L(0); PG8_BAR; PG8_MMA(1, 0, At, B0); PG8_MMA(1, 1, At, B1); PG8_BAR; PG8_SCHED;
            } else {
            PG8_LDB(B0, 0, 0); PG8_SCHED; PG8_LDA(At, 0, 0); PG8_STAGE(PG8_SA(1, 1), a1 + hstep, voffA);
            PG8_WAIT_L(8); PG8_BAR; PG8_WAIT_L(0); PG8_MMA(0, 0, At, B0); PG8_BAR; PG8_SCHED;
            PG8_LDB(B1, 0, 1); PG8_STAGE(PG8_SB(0, 0), b2, voffB);
            PG8_BAR; PG8_WAIT_L(0); PG8_MMA(0, 1, At, B1); PG8_BAR;
            PG8_LDA(At, 0, 1); PG8_STAGE(PG8_SA(0, 0), a2, voffA);
            PG8_BAR; PG8_WAIT_L(0); PG8_MMA(1, 0, At, B0); PG8_BAR; PG8_SCHED;
            PG8_STAGE(PG8_SB(0, 1), b2 + hstep, voffB);
            PG8_WAIT_V(6); PG8_BAR; PG8_MMA(1, 1, At, B1); PG8_BAR;
            PG8_LDB(B0, 1, 0); PG8_SCHED; PG8_LDA(At, 1, 0); PG8_STAGE(PG8_SA(0, 1), a2 + hstep, voffA);
            PG8_WAIT_L(8); PG8_BAR; PG8_WAIT_L(0); PG8_MMA(0, 0, At, B0); PG8_BAR; PG8_SCHED;
            PG8_LDB(B1, 1, 1); PG8_STAGE(PG8_SB(1, 0), b3, voffB);
            PG8_BAR; PG8_WAIT_L(0); PG8_MMA(0, 1, At, B1); PG8_BAR;
            PG8_LDA(At, 1, 1); PG8_STAGE(PG8_SA(1, 0), a3, voffA);
            PG8_BAR; PG8_WAIT_L(0); PG8_MMA(1, 0, At, B0); PG8_BAR; PG8_SCHED;
            PG8_STAGE(PG8_SB(1, 1), b3 + hstep, voffB);
            PG8_WAIT_V(6); PG8_BAR; PG8_MMA(1, 1, At, B1); PG8_BAR;
            }
        }
        if constexpr (ALIGN_EPI) { if (wr == 0) PG8_BAR; }
        if constexpr (!Epi::AFTER_DRAIN) { E(acc, cur, wr, wc, fr, fq); S.done(cur); }
        if (!has_next) break;
#pragma unroll
        for (int a = 0; a < 2; ++a)
#pragma unroll
            for (int b = 0; b < 2; ++b)
#pragma unroll
                for (int m = 0; m < 4; ++m)
#pragma unroll
                    for (int n = 0; n < 2; ++n) acc[a][b][m][n] = (f32x4){0.f, 0.f, 0.f, 0.f};
        cur = nxt; cA = nA; cB = nB; ++ui;
        if constexpr (ALIGN_EPI) { if (wr == 1) PG8_BAR; }
    }
    PG8_WAIT_V(0);
    if constexpr (!ALIGN_EPI) { if (wr == 0) PG8_BAR; }
    PG8_BAR;
    if constexpr (Epi::AFTER_DRAIN) { E.fused(acc, cur, wr, wc, fr, fq, lds, wid, lane); S.done(cur); }
#undef PG8_SA
#undef PG8_SB
#undef PG8_STAGE
#undef PG8_LDA
#undef PG8_LDB
#undef PG8_MMA
#undef PG8_WAIT_V
#undef PG8_WAIT_L
#undef PG8_BAR
#undef PG8_SCHED
}
}
#define GAS __attribute__((address_space(1)))
#define LAS __attribute__((address_space(3)))
typedef unsigned short bf16;
typedef unsigned v4u __attribute__((ext_vector_type(4)));
typedef float f32x4 __attribute__((ext_vector_type(4)));
typedef short bf16x8 __attribute__((ext_vector_type(8)));
typedef GAS unsigned gu32;
typedef GAS unsigned long long gu64;
#define RLX_AGENT __ATOMIC_RELAXED, __HIP_MEMORY_SCOPE_AGENT
#define LDS_WAIT() asm volatile("s_waitcnt lgkmcnt(0)" ::: "memory")
#define VM_WAIT() asm volatile("s_waitcnt vmcnt(0)" ::: "memory")
__device__ __forceinline__ unsigned long long rt() { return __builtin_amdgcn_s_memrealtime(); }
__device__ __forceinline__ unsigned f2bf(float f) { unsigned u = __builtin_bit_cast(unsigned, f); return (u + 0x7fffu + ((u >> 16) & 1u)) >> 16; }
__device__ __forceinline__ unsigned pk2(float lo, float hi) { return f2bf(lo) | (f2bf(hi) << 16); }

#define XB_TMO      128
#define XB_XCNT(j)  (256  + 64 * (j))
#define XB_XSUB(j)  (1280 + 64 * (j))
#define XB_XGEN(j)  (2304 + 64 * (j))
#define XB_TOP      3328
#define XB_TOPGEN   3392
#define XCD_BAR_WORDS 3456
#define XB_SPIN_CAP (1u << 18)

__device__ __forceinline__ unsigned xb_ld(unsigned* p)              { return __hip_atomic_load(p, __ATOMIC_RELAXED, __HIP_MEMORY_SCOPE_AGENT); }
__device__ __forceinline__ unsigned xb_add(unsigned* p, unsigned v) { return __hip_atomic_fetch_add(p, v, __ATOMIC_RELAXED, __HIP_MEMORY_SCOPE_AGENT); }
__device__ __forceinline__ unsigned xb_xcc_id() { return (unsigned)__builtin_amdgcn_s_getreg((3 << 11) | 20) & 0xFu; }
#define XB_SPIN(cond, bar) do { unsigned _sp = 0; while (cond) { __builtin_amdgcn_s_sleep(1); \
    if ((++_sp & 255u) == 0u) { if (xb_ld(&(bar)[XB_TMO])) break; if (_sp > XB_SPIN_CAP) { atomicAdd(&(bar)[XB_TMO], 1u); break; } } } } while (0)

struct XcdBarrier {
    unsigned* bar; unsigned x;
    volatile LAS unsigned* st;
};

__device__ __forceinline__ XcdBarrier xcd_barrier_post(unsigned* bar, volatile LAS unsigned* st) {
    XcdBarrier b; b.bar = bar; b.x = xb_xcc_id(); b.st = st;
    if (threadIdx.x == 0) (void)xb_add(&bar[XB_XCNT(b.x)], 1u);
    return b;
}
__device__ __forceinline__ void xcd_barrier_complete(unsigned* bar, unsigned x, unsigned& nloc, unsigned& nx) {
    const unsigned G = gridDim.x * gridDim.y * gridDim.z;
    unsigned sum, cnt, mine, sp = 0u;
    for (;;) {
        sum = 0u; cnt = 0u; mine = 0u;
#pragma unroll
        for (unsigned j = 0; j < 16; ++j) { const unsigned c = xb_ld(&bar[XB_XCNT(j)]); sum += c; cnt += (c > 0u) ? 1u : 0u; mine = (j == x) ? c : mine; }
        if (sum == G) break;
        __builtin_amdgcn_s_sleep(1);
        if ((++sp & 255u) == 0u) { if (xb_ld(&bar[XB_TMO])) break; if (sp > XB_SPIN_CAP) { atomicAdd(&bar[XB_TMO], 1u); break; } }
    }
    nloc = mine > 0u ? mine : 1u; nx = cnt > 0u ? cnt : 1u;
}

__device__ __forceinline__ void xcd_barrier(const XcdBarrier& b) {
    asm volatile("s_waitcnt vmcnt(0)" ::: "memory");
    __syncthreads();
    if (threadIdx.x == 0) {
        unsigned* bar = b.bar;
        __builtin_amdgcn_s_waitcnt(0);
        unsigned nloc = b.st[0], nx = b.st[1];
        if (nloc == 0u) { xcd_barrier_complete(bar, b.x, nloc, nx); b.st[0] = nloc; b.st[1] = nx; }
        const unsigned old = xb_add(&bar[XB_XSUB(b.x)], 1u);
        const unsigned gen = old / nloc;
        if (old + 1u == (gen + 1u) * nloc) {
            __builtin_amdgcn_fence(__ATOMIC_RELEASE, "agent");
            asm volatile("s_waitcnt vmcnt(0)" ::: "memory");
            const unsigned og = xb_add(&bar[XB_TOP], 1u);
            const unsigned tg = og / nx;
            if (og + 1u == (tg + 1u) * nx) xb_add(&bar[XB_TOPGEN], 1u);
            else XB_SPIN(xb_ld(&bar[XB_TOPGEN]) == tg, bar);
            __builtin_amdgcn_fence(__ATOMIC_ACQUIRE, "agent");
            xb_add(&bar[XB_XGEN(b.x)], 1u);
            asm volatile("s_waitcnt vmcnt(0)" ::: "memory");
        } else {
            XB_SPIN(xb_ld(&bar[XB_XGEN(b.x)]) == gen, bar);
            __builtin_amdgcn_fence(__ATOMIC_ACQUIRE, "agent");
            asm volatile("s_waitcnt vmcnt(0)" ::: "memory");
        }
    }
    __syncthreads();
}

constexpr int DM = 2048, BATCH = 2, SEQ = 8192, MTOK = BATCH * SEQ, DFF = 8192, DEPTH = 4;
constexpr int LRU_W = 2688, LRU_BD = 168;
constexpr float EPS = 1e-6f;
constexpr int NWAVES = 8;
typedef unsigned short bf16;
typedef float f32x16 __attribute__((ext_vector_type(16)));
typedef unsigned u32x2 __attribute__((ext_vector_type(2)));
using pg8::pk_bf16;

constexpr size_t MiB = 1u << 20;
constexpr size_t WS_CTL = 0, CTL_ZERO_BYTES = 1 * MiB;
constexpr size_t WS_GATES = 1 * MiB;
constexpr size_t WS_CUM = 2 * MiB;
constexpr size_t WS_MLS = 3 * MiB;
constexpr size_t WS_R2 = 4 * MiB + 768 * 1024;
constexpr size_t WS_KN = 4 * MiB + 512 * 1024;
constexpr size_t WS_LRU_SEG = 5 * MiB, WS_LRU_WGT = 6 * MiB;
constexpr size_t WS_W_FOXIN = 8 * MiB, WS_W_FOXOUT = 33 * MiB, WS_W_LRUIN = 41 * MiB, WS_W_LRUOUT = 62 * MiB, WS_W_SBIN = 73 * MiB, WS_W_SBOUT = 97 * MiB,
                 WS_W_MLIN = 105 * MiB, WS_W_MLOUT = 130 * MiB, WS_W1 = 138 * MiB, WS_W2 = 266 * MiB;
constexpr size_t WS_H = 394 * MiB;
constexpr size_t WS_HM = 458 * MiB;
constexpr size_t WS_PROJ = 522 * MiB;
constexpr size_t WS_Y = 714 * MiB;
constexpr size_t WS_HID = 522 * MiB;
constexpr size_t WS_KT = 798 * MiB;
constexpr size_t WS_MLST = 830 * MiB;
constexpr size_t WS_END = 1024 * MiB;
constexpr size_t WS_VT_OFF = 128 * MiB;

constexpr int LDS_BYTES = 163840;
constexpr int LDSCTL_OFF = 163840 - 256;

#define LAS __attribute__((address_space(3)))
typedef short bf16x8 __attribute__((ext_vector_type(8)));
typedef short s16x4 __attribute__((ext_vector_type(4)));
typedef float f32x4 __attribute__((ext_vector_type(4)));
typedef unsigned v4u __attribute__((ext_vector_type(4)));
#define MFMA32(a, b, c) __builtin_amdgcn_mfma_f32_32x32x16_bf16((a), (b), (c), 0, 0, 0)
#define MFMA16(a, b, c) __builtin_amdgcn_mfma_f32_16x16x32_bf16((a), (b), (c), 0, 0, 0)

__device__ __forceinline__ float bf2f(unsigned short b) { return __uint_as_float((unsigned)b << 16); }
__device__ __forceinline__ float bflo(unsigned w) { return __uint_as_float(w << 16); }
__device__ __forceinline__ float bfhi(unsigned w) { return __uint_as_float(w & 0xffff0000u); }
__device__ __forceinline__ unsigned short f2bf16(float f) { return (unsigned short)(pk_bf16(f, 0.f) & 0xffffu); }
__device__ __forceinline__ float wave_sum(float v) {
#pragma unroll
    for (int o = 1; o < 64; o <<= 1) v += __shfl_xor(v, o);
    return v;
}
__device__ __forceinline__ float log_sigmoid_f(float x) { return fminf(x, 0.f) - log1pf(expf(-fabsf(x))); }
__device__ __forceinline__ float sigmoid_f(float x) { return 1.f / (1.f + expf(-x)); }
__device__ __forceinline__ float gelu_tanh_f(float x) { const float u = 0.7978845608028654f * (x + 0.044715f * x * x * x); const float t = 1.f - 2.f / (1.f + expf(2.f * u)); return 0.5f * x * (1.f + t); }
__device__ __forceinline__ float ld_agent_f32(const float* p) { return __uint_as_float(__hip_atomic_load((const unsigned*)p, __ATOMIC_RELAXED, __HIP_MEMORY_SCOPE_AGENT)); }

struct TrJob { const float* src; bf16* dst; const float* gk; int ldw, ncols, K, item0; };
constexpr int NJOBS = 19;
__device__ __forceinline__ void tr_item(const float* W, const float* gk, int ldw, int ncols, int K, bf16* WT, LAS float* scr, int item, int lane) {
    const int nblk = ncols / 32, kb = item / nblk, nb = item % nblk, k0 = 64 * kb, n0 = 32 * nb;
#pragma unroll 8
    for (int i = 0; i < 32; ++i) { const int kk = 2 * i + (lane >> 5); scr[kk * 33 + (lane & 31)] = W[(size_t)(k0 + kk) * ldw + n0 + (lane & 31)]; }
    asm volatile("s_waitcnt lgkmcnt(0)" ::: "memory");
    const int c = lane & 7;
    f32x4 g0 = (f32x4){1.f, 1.f, 1.f, 1.f}, g1 = g0;
    if (gk) { g0 = *(const f32x4*)(gk + k0 + 8 * c); g1 = *(const f32x4*)(gk + k0 + 8 * c + 4); }
#pragma unroll
    for (int j = 0; j < 4; ++j) { const int n = (lane >> 3) + 8 * j; const LAS float* s = scr + (8 * c) * 33 + n;
        v4u o; o.x = pk_bf16(s[0 * 33] * g0[0], s[1 * 33] * g0[1]); o.y = pk_bf16(s[2 * 33] * g0[2], s[3 * 33] * g0[3]); o.z = pk_bf16(s[4 * 33] * g1[0], s[5 * 33] * g1[1]); o.w = pk_bf16(s[6 * 33] * g1[2], s[7 * 33] * g1[3]);
        *(v4u*)(WT + (size_t)(n0 + n) * K + k0 + 8 * c) = o; }
    asm volatile("s_waitcnt lgkmcnt(0)" ::: "memory");
}
__device__ __forceinline__ void gate_rows(const float* W, const float* gk, int ldw, int col0, int ng, bf16* dst, int gtid, int nthr) {
    for (int i = gtid; i < 256 * DM; i += nthr) { const int g = i / DM, k = i % DM; const float v = g < ng ? W[(size_t)k * ldw + col0 + g] * gk[k] : 0.f; dst[i] = f2bf16(v); }
}

__device__ __forceinline__ void row_first(const float* xsrc, bf16* XB, float* R2, int gw, int ngw, int lane) {
    for (int row = gw; row < MTOK; row += ngw) {
        const size_t ro = (size_t)row * DM + 4 * lane; float ss = 0.f;
#pragma unroll
        for (int j = 0; j < 8; ++j) { const f32x4 v = *(const f32x4*)(xsrc + ro + 256 * j); ss += (v.x * v.x + v.y * v.y) + (v.z * v.z + v.w * v.w);
            u32x2 w; w.x = pk_bf16(v.x, v.y); w.y = pk_bf16(v.z, v.w); *(u32x2*)(XB + ro + 256 * j) = w; }
        const float r = rsqrtf(wave_sum(ss) * (1.f / DM) + EPS);
        if (lane == 0) R2[row] = r;
    }
}
template <bool FINAL>
__device__ __forceinline__ void row_upd(bf16* XB, const bf16* hm, const float* ga, float* R2, float* outp, int gw, int ngw, int lane) {
    for (int row = gw; row < MTOK; row += ngw) {
        const size_t ro = (size_t)row * DM + 4 * lane;
        u32x2 xv[8], hv[8]; float ss = 0.f;
#pragma unroll
        for (int j = 0; j < 8; ++j) { xv[j] = *(const u32x2*)(XB + ro + 256 * j); hv[j] = *(const u32x2*)(hm + ro + 256 * j);
            const float a = bflo(hv[j].x), b = bfhi(hv[j].x), c = bflo(hv[j].y), d = bfhi(hv[j].y); ss += (a * a + b * b) + (c * c + d * d); }
        const float r = rsqrtf(wave_sum(ss) * (1.f / DM) + EPS);
        float s2 = 0.f;
#pragma unroll
        for (int j = 0; j < 8; ++j) { const f32x4 g = *(const f32x4*)(ga + 256 * j + 4 * lane); f32x4 v;
            v.x = bflo(xv[j].x) + bflo(hv[j].x) * r * g.x; v.y = bfhi(xv[j].x) + bfhi(hv[j].x) * r * g.y; v.z = bflo(xv[j].y) + bflo(hv[j].y) * r * g.z; v.w = bfhi(xv[j].y) + bfhi(hv[j].y) * r * g.w;
            if (FINAL) { *(f32x4*)(outp + ro + 256 * j) = v; }
            else { s2 += (v.x * v.x + v.y * v.y) + (v.z * v.z + v.w * v.w); u32x2 w; w.x = pk_bf16(v.x, v.y); w.y = pk_bf16(v.z, v.w); *(u32x2*)(XB + ro + 256 * j) = w; } }
        if (!FINAL) { const float r2 = rsqrtf(wave_sum(s2) * (1.f / DM) + EPS); if (lane == 0) R2[row] = r2; }
    }
}

__device__ __forceinline__ void fox_cumsum(LAS unsigned char* lds, const float* G, const float* bfv, float* cum, int wg, int nwg) {
    LAS float* wtot = (LAS float*)lds;
    const int tid = threadIdx.x, lane = tid & 63, wid = tid >> 6;
    for (int u = wg; u < 32; u += nwg) {
        const int b = u >> 4, h = u & 15; const float bias = bfv[h];
        float v[16]; float run = 0.f;
#pragma unroll
        for (int i = 0; i < 16; ++i) { run += log_sigmoid_f(G[((size_t)b * SEQ + tid * 16 + i) * 16 + h] + bias); v[i] = run; }
        float inc = run;
#pragma unroll
        for (int o = 1; o < 64; o <<= 1) { const float t = __shfl_up(inc, o); if (lane >= o) inc += t; }
        __syncthreads();
        if (lane == 63) wtot[wid] = inc;
        __syncthreads();
        float off = inc - run;
        for (int w = 0; w < wid; ++w) off += wtot[w];
        float* o = cum + ((size_t)(b * 16 + h)) * SEQ + tid * 16;
#pragma unroll
        for (int i = 0; i < 16; ++i) o[i] = (off + v[i]) * 1.4426950408889634f;
    }
}


__device__ __forceinline__ void fox_knorm(const bf16* QK, float* KN, int gw, int ngw, int lane) {
    for (int it = gw; it < 2 * 16 * 128; it += ngw) { const int tile = it & 127, h = (it >> 7) & 15, b = it >> 11;
        const bf16* kp = QK + ((size_t)b * SEQ + tile * 64 + lane) * 4096 + 2048 + h * 128; float ss = 0.f;
#pragma unroll
        for (int c = 0; c < 16; ++c) { const v4u v = *(const v4u*)(kp + 8 * c);
            ss += bflo(v.x) * bflo(v.x) + bfhi(v.x) * bfhi(v.x) + bflo(v.y) * bflo(v.y) + bfhi(v.y) * bfhi(v.y) + bflo(v.z) * bflo(v.z) + bfhi(v.z) * bfhi(v.z) + bflo(v.w) * bflo(v.w) + bfhi(v.w) * bfhi(v.w); }
#pragma unroll
        for (int o = 1; o < 64; o <<= 1) ss = fmaxf(ss, __shfl_xor(ss, o));
        if (lane == 0) KN[it] = ss * 1.0001f; }
}

constexpr int AT_KB = 16384, AT_VB = 16384, AT_K0 = 0, AT_V0 = 2 * AT_KB, AT_CS = AT_V0 + 2 * AT_VB, AT_FLAG = AT_CS + 512, AT_PM = AT_FLAG + 64;
__device__ __forceinline__ int crow(int r, int hi) { return (r & 3) + 8 * (r >> 2) + 4 * hi; }

template <int MODE>
__device__ __forceinline__ void attn_unit(LAS unsigned char* lds, const bf16* QK, const bf16* VT, const float* cum, const float* KN, bf16* Y, int b, int h, int qb) {
    const int tid = threadIdx.x, lane = tid & 63, wid = __builtin_amdgcn_readfirstlane(tid >> 6), r32 = lane & 31, hi = lane >> 5;
    const float scale = 0.08838834764831845f;
    const int tq = qb * 256 + wid * 32 + r32;
    const size_t rowq = (size_t)b * SEQ + tq;
    bf16x8 qf[8];
    { const bf16* qp = QK + rowq * 4096 + h * 128 + 8 * hi;
#pragma unroll
      for (int ks = 0; ks < 8; ++ks) qf[ks] = *(const bf16x8*)(qp + 16 * ks); }
    const float* cumh = cum + (size_t)(b * 16 + h) * SEQ;
    float ct = 0.f; if (MODE == 0) ct = cumh[tq];
    f32x16 o[4];
#pragma unroll
    for (int dt = 0; dt < 4; ++dt)
#pragma unroll
        for (int r = 0; r < 16; ++r) o[dt][r] = 0.f;
    float m = 0.f, l = 0.f, R = 0.f;
    const int jmax = 4 * qb + 3, jw = 4 * qb + (wid >> 1);
    bool wdone = false;
    const bf16* kbase = QK + ((size_t)b * SEQ) * 4096 + 2048 + h * 128;
    const bf16* vbase = VT + ((size_t)h * 128) * MTOK + (size_t)b * SEQ;
#define AT_DMA(jj, buf) do { _Pragma("unroll") for (int i_ = 0; i_ < 2; ++i_) { const int pc_ = wid + 8 * i_; \
            const int row_ = 4 * pc_ + (lane >> 4), p_ = lane & 15; \
            __builtin_amdgcn_global_load_lds((const unsigned*)(kbase + (size_t)(64 * (jj) + row_) * 4096 + ((p_ ^ (row_ & 15)) << 3)), (LAS unsigned*)(lds + AT_K0 + (buf) * AT_KB + pc_ * 1024), 16, 0, 0); \
            const int d_ = 8 * pc_ + (lane >> 3), pv_ = lane & 7; \
            __builtin_amdgcn_global_load_lds((const unsigned*)(vbase + (size_t)d_ * MTOK + 64 * (jj) + ((pv_ ^ ((d_ >> 1) & 7)) << 3)), (LAS unsigned*)(lds + AT_V0 + (buf) * AT_VB + pc_ * 1024), 16, 0, 0); } \
        if (MODE == 0 && wid == 0) __builtin_amdgcn_global_load_lds((const unsigned*)(cumh + 64 * (jj) + lane), (LAS unsigned*)(lds + AT_CS + (buf) * 256), 4, 0, 0); } while (0)
    float qn = 0.f;
    if (MODE == 0) {
#pragma unroll
        for (int ks = 0; ks < 8; ++ks)
#pragma unroll
            for (int e = 0; e < 8; ++e) { const float v = bf2f((unsigned short)qf[ks][e]); qn += v * v; }
        qn += __shfl_xor(qn, 32); qn = __builtin_amdgcn_sqrtf(qn) * (scale * 1.4426950408889634f);
        if (wid == 0) { const float* kn = KN + (size_t)(b * 16 + h) * 128; float a0 = kn[lane], a1 = kn[64 + lane];
#pragma unroll
            for (int o_ = 1; o_ < 64; o_ <<= 1) { const float t0 = __shfl_up(a0, o_), t1 = __shfl_up(a1, o_); if (lane >= o_) { a0 = fmaxf(a0, t0); a1 = fmaxf(a1, t1); } }
            a1 = fmaxf(a1, __shfl(a0, 63));
            ((LAS float*)(lds + AT_PM))[lane] = __builtin_amdgcn_sqrtf(a0); ((LAS float*)(lds + AT_PM))[64 + lane] = __builtin_amdgcn_sqrtf(a1); }
    }
    AT_DMA(jmax, 0);
    asm volatile("s_waitcnt vmcnt(0)" ::: "memory");
    __syncthreads();
    for (int j = jmax; j >= 0; --j) {
        const int cur = (jmax - j) & 1;
        if (j > 0) AT_DMA(j - 1, cur ^ 1);
        if (j <= jw && !wdone) {
            const LAS unsigned char* kb = lds + AT_K0 + cur * AT_KB;
            const LAS unsigned char* vb = lds + AT_V0 + cur * AT_VB;
            const LAS float* csb = (const LAS float*)(lds + AT_CS + cur * 256);
            const int dsub = (wid & 1);
#pragma unroll
            for (int sub = 1; sub >= 0; --sub) {
                if (j == jw && sub > dsub) continue;
                const bool diag = (j == jw && sub == dsub);
                f32x16 s;
#pragma unroll
                for (int r = 0; r < 16; ++r) s[r] = 0.f;
                __builtin_amdgcn_s_setprio(1);
#pragma unroll
                for (int ks = 0; ks < 8; ++ks) {
                    const bf16x8 kf = *(const LAS bf16x8*)(kb + (32 * sub + r32) * 256 + (((2 * ks + hi) ^ (r32 & 15)) << 4));
                    s = MFMA32(kf, qf[ks], s);
                }
                __builtin_amdgcn_s_setprio(0);
                float p[16];
                if (MODE == 0) {
                    const float cm = ct - m; float mx = -1e30f;
#pragma unroll
                    for (int g = 0; g < 4; ++g) { const f32x4 cs = *(const LAS f32x4*)(csb + 32 * sub + 8 * g + 4 * hi);
#pragma unroll
                        for (int i = 0; i < 4; ++i) { const int r = 4 * g + i; float lg = s[r] * (scale * 1.4426950408889634f) + (cm - cs[i]);
                            if (diag && (8 * g + 4 * hi + i) > r32) lg = -1e30f;
                            p[r] = lg; mx = fmaxf(mx, lg); } }
                    mx = fmaxf(mx, __shfl_xor(mx, 32));
                    if (__any(mx > 0.f)) {
                        const float d = fmaxf(mx, 0.f), alpha = __builtin_amdgcn_exp2f(-d);
                        l *= alpha; m += d;
#pragma unroll
                        for (int r = 0; r < 16; ++r) p[r] -= d;
#pragma unroll
                        for (int dt = 0; dt < 4; ++dt)
#pragma unroll
                            for (int r = 0; r < 16; ++r) o[dt][r] *= alpha;
                    }
                    float ps = 0.f;
#pragma unroll
                    for (int r = 0; r < 16; ++r) { p[r] = __builtin_amdgcn_exp2f(p[r]); ps += p[r]; }
                    l += ps;
                } else {
                    float L1[16], G[4], Go[4];
#pragma unroll
                    for (int g = 0; g < 4; ++g) { float gs = 0.f;
#pragma unroll
                        for (int i = 0; i < 4; ++i) { const int r = 4 * g + i; const float zz = s[r] * scale;
                            const bool valid = !diag || (8 * g + 4 * hi + i) < r32;
                            const float sp = fmaxf(zz, 0.f) + __logf(1.f + __expf(-fabsf(zz)));
                            L1[r] = valid ? -sp : 0.f; p[r] = zz - sp; gs += L1[r]; }
                        G[g] = gs; }
#pragma unroll
                    for (int g = 0; g < 4; ++g) Go[g] = __shfl_xor(G[g], 32);
                    float T = 0.f;
#pragma unroll
                    for (int g = 3; g >= 0; --g) {
                        const float base = R + T + (hi == 0 ? Go[g] : 0.f);
                        float suf = 0.f;
#pragma unroll
                        for (int i = 3; i >= 0; --i) { const int r = 4 * g + i;
                            const bool valid = !diag || (8 * g + 4 * hi + i) < r32;
                            const float a = __expf(p[r] + base + suf);
                            p[r] = valid ? a : 0.f; suf += L1[r]; }
                        T += G[g] + Go[g];
                    }
                    R += T;
                }
#pragma unroll
                for (int st = 0; st < 2; ++st) {
                    v4u pw; pw.x = pk_bf16(p[8 * st + 0], p[8 * st + 1]); pw.y = pk_bf16(p[8 * st + 2], p[8 * st + 3]); pw.z = pk_bf16(p[8 * st + 4], p[8 * st + 5]); pw.w = pk_bf16(p[8 * st + 6], p[8 * st + 7]);
                    const bf16x8 pf = __builtin_bit_cast(bf16x8, pw);
#pragma unroll
                    for (int dt = 0; dt < 4; ++dt) {
                        const int dv_ = 32 * dt + r32, sw_ = (dv_ >> 1) & 7, c0_ = 4 * sub + 2 * st;
                        const LAS unsigned char* vrow = vb + dv_ * 128 + 8 * hi;
                        const u32x2 lo = *(const LAS u32x2*)(vrow + ((c0_ ^ sw_) << 4)), hh = *(const LAS u32x2*)(vrow + (((c0_ + 1) ^ sw_) << 4));
                        const v4u vw = (v4u){lo.x, lo.y, hh.x, hh.y};
                        o[dt] = MFMA32(__builtin_bit_cast(bf16x8, vw), pf, o[dt]);
                    }
                }
            }
            if (MODE == 1) wdone = __all(R < -104.f);
            if (MODE == 0 && j > 0) { const float bound = qn * ((const LAS float*)(lds + AT_PM))[j - 1] + (ct - csb[0]) - m; wdone = __all(bound < -150.1f); }
        }
        if (lane == 0) ((LAS unsigned*)(lds + AT_FLAG))[cur * 8 + wid] = wdone ? 1u : 0u;
        asm volatile("s_waitcnt vmcnt(0)" ::: "memory");
        __syncthreads();
        {
            const LAS unsigned* fl = (const LAS unsigned*)(lds + AT_FLAG) + cur * 8;
            unsigned all = 1u;
#pragma unroll
            for (int w = 0; w < 8; ++w) all &= fl[w];
            if (all) break;
        }
    }
    float inv = 1.f;
    if (MODE == 0) { const float lt = l + __shfl_xor(l, 32); inv = 1.f / lt; }
    bf16* yp = Y + rowq * DM + h * 128 + 4 * hi;
#pragma unroll
    for (int dt = 0; dt < 4; ++dt)
#pragma unroll
        for (int g = 0; g < 4; ++g) { u32x2 w; w.x = pk_bf16(o[dt][4 * g] * inv, o[dt][4 * g + 1] * inv); w.y = pk_bf16(o[dt][4 * g + 2] * inv, o[dt][4 * g + 3] * inv);
            *(u32x2*)(yp + 32 * dt + 8 * g) = w; }
    __syncthreads();
}

template <int MODE>
__device__ __forceinline__ void attn_phase(LAS unsigned char* lds, const bf16* QK, const bf16* VT, const float* cum, const float* KN, bf16* Y, unsigned* counter) {
    LAS unsigned* slot = (LAS unsigned*)(lds + AT_PM + 512);
#pragma unroll 1
    for (;;) {
        if (threadIdx.x == 0) *slot = __hip_atomic_fetch_add(counter, 1u, __ATOMIC_RELAXED, __HIP_MEMORY_SCOPE_AGENT);
        __syncthreads();
        const unsigned u = *slot;
        __syncthreads();
        if (u >= 1024u) break;
        const int bh = u & 31, qb = 31 - (int)(u >> 5);
        attn_unit<MODE>(lds, QK, VT, cum, KN, Y, bh >> 4, bh & 15, qb);
    }
}

constexpr int L2_WT = 0, L2_U = 118272, L2_XCH = L2_U + 21504, L2_CAR = L2_XCH + 5632, L2_CW = L2_CAR + 2816, L2_CH = L2_CW + 3360, L2_END = L2_CH + 2112;
static_assert(L2_END <= LDSCTL_OFF, "LRU v2 LDS map");
constexpr size_t LRU_SEG = (size_t)2 * 8 * LRU_W;

__device__ __forceinline__ void lru_wgt_prep(const float* w_r, const float* w_i, bf16* WGT, int gtid, int nthr) {
    for (int i = gtid; i < 16 * 352 * LRU_BD; i += nthr) { const int d = i % LRU_BD, e = (i / LRU_BD) % 352, n = i / (LRU_BD * 352); float v = 0.f;
        if (e < 168) v = w_r[((size_t)n * LRU_BD + d) * LRU_BD + e]; else if (e >= 176 && e < 344) v = w_i[((size_t)n * LRU_BD + d) * LRU_BD + (e - 176)];
        WGT[i] = f2bf16(v); }
}
__device__ __forceinline__ void lru_carry(float* SEG, int gtid, int nthr) {
    for (int i = gtid; i < 2 * LRU_W; i += nthr) { const int b = i / LRU_W, ch = i % LRU_W; float carry = 0.f;
#pragma unroll
        for (int sg = 0; sg < 8; ++sg) { const size_t o = ((size_t)b * 8 + sg) * LRU_W + ch; SEG[2 * LRU_SEG + o] = carry; carry = SEG[o] * carry + SEG[LRU_SEG + o]; } }
}
__device__ __forceinline__ float expm1_neg(float x) { const float p = x * (1.f + x * (0.5f + x * (1.f / 6.f))), e = __expf(x) - 1.f; return (x > -0.02f) ? p : e; }
__device__ __forceinline__ float fast_rcp(float x) { return __builtin_amdgcn_rcpf(x); }
__device__ __forceinline__ float fast_gelu_tanh(float x) { const float u2 = (-2.f * 0.7978845608028654f * 1.4426950408889634f) * x * (1.f + 0.044715f * x * x); return x * fast_rcp(1.f + __builtin_amdgcn_exp2f(u2)); }

template <int PASS>
__device__ __forceinline__ void lru2_pass(LAS unsigned char* lds, const bf16* PROJ, const bf16* WGT, const float* conv_w, const float* conv_b, const float* b_r, const float* b_i,
                                          const float* lam, float* SEG, bf16* YB, v4u* AB, int wg, int nwg) {
    const int tid = threadIdx.x, lane = tid & 63, wid = __builtin_amdgcn_readfirstlane(tid >> 6), fr = lane & 15, fq = lane >> 4, rt = wid & 3, half = wid >> 2;
    LAS float* XCH = (LAS float*)(lds + L2_XCH);
    LAS float* CAR = (LAS float*)(lds + L2_CAR);
#pragma unroll 1
    for (int unit = wg; unit < 256; unit += nwg) {
        const int n = unit & 15, b = (unit >> 4) >> 3, seg = (unit >> 4) & 7;
        __syncthreads();
        { const v4u* src = (const v4u*)(WGT + (size_t)n * 352 * LRU_BD);
          for (int i = tid; i < 118272 / 16; i += 512) *(LAS v4u*)(lds + L2_WT + i * 16) = src[i]; }
        const int ch8 = tid % 21, rg = tid / 21;
        LAS float* CWL = (LAS float*)(lds + L2_CW);
        LAS float* CHL = (LAS float*)(lds + L2_CH);
        for (int i = tid; i < 5 * LRU_BD; i += 512) { const int j = i / LRU_BD, d = i % LRU_BD; CWL[i] = (j < 4) ? conv_w[(size_t)j * LRU_W + n * LRU_BD + d] : conv_b[n * LRU_BD + d]; }
        if (tid < 176) { const bool ok = tid < LRU_BD; const int gi = n * LRU_BD + (ok ? tid : 0); CHL[tid] = b_r[gi]; CHL[176 + tid] = b_i[gi]; CHL[352 + tid] = 8.f * 1.4426950408889634f * log_sigmoid_f(lam[gi]); }
        if (tid < 176) { float cin = 0.f;
            if (PASS == 3 && tid < LRU_BD) { for (int sg = 0; sg < seg; ++sg) { const size_t o = ((size_t)b * 8 + sg) * LRU_W + n * LRU_BD + tid; cin = SEG[o] * cin + SEG[LRU_SEG + o]; } }
            CAR[tid] = 1.f; CAR[176 + tid] = cin; }
        const bf16* ubase = PROJ + ((size_t)b * SEQ) * 5376 + LRU_W + n * LRU_BD + ch8 * 8;
        const bf16* gbase = PROJ + ((size_t)b * SEQ) * 5376 + n * LRU_BD;
        v4u raw[7];
#define L2_LOAD(t0_) do { _Pragma("unroll") for (int j_ = 0; j_ < 7; ++j_) { const int tt_ = (t0_) + 4 * rg - 3 + j_; \
            raw[j_] = (v4u){0u, 0u, 0u, 0u}; if (tid < 336 && tt_ >= 0) raw[j_] = *(const v4u*)(ubase + (size_t)tt_ * 5376); } } while (0)
        L2_LOAD(seg * 1024);
        __syncthreads();
#pragma unroll 1
        for (int st = 0; st < 16; ++st) {
            const int t0 = seg * 1024 + st * 64, par = st & 1;
            if (tid < 336) {
                f32x4 cwv[5][2];
#pragma unroll
                for (int j = 0; j < 5; ++j) { cwv[j][0] = *(const LAS f32x4*)(CWL + j * LRU_BD + ch8 * 8); cwv[j][1] = *(const LAS f32x4*)(CWL + j * LRU_BD + ch8 * 8 + 4); }
#pragma unroll
                for (int it = 0; it < 4; ++it) { float acc[8];
#pragma unroll
                    for (int e = 0; e < 8; ++e) acc[e] = cwv[4][e >> 2][e & 3];
#pragma unroll
                    for (int j = 0; j < 4; ++j) { const v4u rv = raw[it + j];
                        acc[0] += cwv[j][0][0] * bflo(rv.x); acc[1] += cwv[j][0][1] * bfhi(rv.x); acc[2] += cwv[j][0][2] * bflo(rv.y); acc[3] += cwv[j][0][3] * bfhi(rv.y);
                        acc[4] += cwv[j][1][0] * bflo(rv.z); acc[5] += cwv[j][1][1] * bfhi(rv.z); acc[6] += cwv[j][1][2] * bflo(rv.w); acc[7] += cwv[j][1][3] * bfhi(rv.w); }
                    v4u o; o.x = pk_bf16(acc[0], acc[1]); o.y = pk_bf16(acc[2], acc[3]); o.z = pk_bf16(acc[4], acc[5]); o.w = pk_bf16(acc[6], acc[7]);
                    *(LAS v4u*)(lds + L2_U + (4 * rg + it) * 336 + ch8 * 16) = o; } }
            if (st + 1 < 16) L2_LOAD(t0 + 64);
            __syncthreads();
            bf16x8 af[6];
#pragma unroll
            for (int ks = 0; ks < 6; ++ks) { v4u w = *(const LAS v4u*)(lds + L2_U + (16 * rt + fr) * 336 + ks * 64 + (ks < 5 ? fq * 16 : 0));
                if (ks == 5 && fq != 0) w = (v4u){0u, 0u, 0u, 0u}; af[ks] = __builtin_bit_cast(bf16x8, w); }
            float av[6][4], bv[6][4], Aex[6], Bex[6];
#pragma unroll
            for (int k = 0; k < 6; ++k) {
                const int ct = 6 * half + k; const int ch = 16 * ct + fr;
                f32x4 racc = (f32x4){0.f, 0.f, 0.f, 0.f}, iacc = (f32x4){0.f, 0.f, 0.f, 0.f};
                if (ct < 11) {
#pragma unroll
                    for (int ks = 0; ks < 6; ++ks) {
                        v4u wr = *(const LAS v4u*)(lds + L2_WT + (16 * ct + fr) * 336 + ks * 64 + (ks < 5 ? fq * 16 : 0));
                        v4u wi = *(const LAS v4u*)(lds + L2_WT + (176 + 16 * ct + fr) * 336 + ks * 64 + (ks < 5 ? fq * 16 : 0));
                        if (ks == 5 && fq != 0) { wr = (v4u){0u, 0u, 0u, 0u}; wi = (v4u){0u, 0u, 0u, 0u}; }
                        racc = MFMA16(af[ks], __builtin_bit_cast(bf16x8, wr), racc); iacc = MFMA16(af[ks], __builtin_bit_cast(bf16x8, wi), iacc); }
                }
                const int chs = (ch < LRU_BD) ? ch : 0; const int chc = (ch < 176) ? ch : 0; const float cbr = CHL[chc], cbi = CHL[176 + chc], cls = CHL[352 + chc];
                float A4 = 1.f, B4 = 0.f; float la2[4], bq[4];
#pragma unroll
                for (int r = 0; r < 4; ++r) { const float uu = bf2f(*(const LAS bf16*)(lds + L2_U + (16 * rt + 4 * fq + r) * 336 + chs * 2));
                    const float rgt = fast_rcp(1.f + __builtin_amdgcn_exp2f(-1.4426950408889634f * (racc[r] + cbr))), ig = fast_rcp(1.f + __builtin_amdgcn_exp2f(-1.4426950408889634f * (iacc[r] + cbi)));
                    la2[r] = rgt * cls; bq[r] = ig * uu; }
                v4u pkd; pkd.x = pk_bf16(la2[0], la2[1]); pkd.y = pk_bf16(la2[2], la2[3]);
                const float lr[4] = {bflo(pkd.x), bfhi(pkd.x), bflo(pkd.y), bfhi(pkd.y)}; float bbv[4];
#pragma unroll
                for (int r = 0; r < 4; ++r) { const float a = __builtin_amdgcn_exp2f(lr[r]); av[k][r] = a; bbv[r] = __builtin_amdgcn_sqrtf(fmaxf(1.f - a * a, 0.f)) * bq[r]; }
                pkd.z = pk_bf16(bbv[0], bbv[1]); pkd.w = pk_bf16(bbv[2], bbv[3]);
                const float br[4] = {bflo(pkd.z), bfhi(pkd.z), bflo(pkd.w), bfhi(pkd.w)};
#pragma unroll
                for (int r = 0; r < 4; ++r) { bv[k][r] = br[r]; B4 = av[k][r] * B4 + br[r]; A4 = av[k][r] * A4; }
                if (PASS == 1 && ct < 11) AB[((((size_t)unit * 16 + st) * 8 + wid) * 6 + k) * 64 + lane] = pkd;
#pragma unroll
                for (int off = 16; off < 64; off <<= 1) { const float Ap = __shfl_up(A4, off), Bp = __shfl_up(B4, off); if (lane >= off) { B4 = A4 * Bp + B4; A4 = A4 * Ap; } }
                float ae = __shfl_up(A4, 16), be = __shfl_up(B4, 16); if (fq == 0) { ae = 1.f; be = 0.f; }
                Aex[k] = ae; Bex[k] = be;
                if (fq == 3 && ct < 11) { XCH[(rt * 176 + ch) * 2] = A4; XCH[(rt * 176 + ch) * 2 + 1] = B4; }
            }
            __syncthreads();
            v4u greg[3];
            if (PASS == 3) {
#pragma unroll
                for (int k = 0; k < 3; ++k) { const int c3 = tid + 512 * k; greg[k] = (v4u){0u, 0u, 0u, 0u}; if (c3 < 64 * 21) greg[k] = *(const v4u*)(gbase + (size_t)(t0 + c3 / 21) * 5376 + (c3 % 21) * 8); } }
#pragma unroll
            for (int k = 0; k < 6; ++k) {
                const int ct = 6 * half + k; const int ch = 16 * ct + fr;
                if (ct < 11) {
                    float hin = CAR[par * 352 + 176 + ch], ain = CAR[par * 352 + ch];
#pragma unroll
                    for (int q = 0; q < 3; ++q) if (q < rt) { const float a2 = XCH[(q * 176 + ch) * 2], b2 = XCH[(q * 176 + ch) * 2 + 1]; hin = a2 * hin + b2; ain *= a2; }
                    if (PASS == 3) {
                        float hh = Aex[k] * hin + Bex[k];
#pragma unroll
                        for (int r = 0; r < 4; ++r) { hh = av[k][r] * hh + bv[k][r]; if (ch < LRU_BD) *(LAS bf16*)(lds + L2_U + (16 * rt + 4 * fq + r) * 336 + ch * 2) = f2bf16(hh); }
                        if (rt == 3 && fq == 3) CAR[(par ^ 1) * 352 + 176 + ch] = hh;
                    } else {
                        if (rt == 3 && fq == 3) { const float a3 = XCH[(3 * 176 + ch) * 2], b3 = XCH[(3 * 176 + ch) * 2 + 1];
                            CAR[(par ^ 1) * 352 + 176 + ch] = a3 * hin + b3; CAR[(par ^ 1) * 352 + ch] = ain * a3; }
                    }
                }
            }
            __syncthreads();
            if (PASS == 3) {
#pragma unroll
                for (int k = 0; k < 3; ++k) { const int c3 = tid + 512 * k;
                    if (c3 < 64 * 21) { const int t = c3 / 21, cc = c3 % 21; const v4u hv = *(const LAS v4u*)(lds + L2_U + t * 336 + cc * 16); const v4u gv = greg[k];
                        v4u o; o.x = pk_bf16(bflo(hv.x) * fast_gelu_tanh(bflo(gv.x)), bfhi(hv.x) * fast_gelu_tanh(bfhi(gv.x))); o.y = pk_bf16(bflo(hv.y) * fast_gelu_tanh(bflo(gv.y)), bfhi(hv.y) * fast_gelu_tanh(bfhi(gv.y)));
                        o.z = pk_bf16(bflo(hv.z) * fast_gelu_tanh(bflo(gv.z)), bfhi(hv.z) * fast_gelu_tanh(bfhi(gv.z))); o.w = pk_bf16(bflo(hv.w) * fast_gelu_tanh(bflo(gv.w)), bfhi(hv.w) * fast_gelu_tanh(bfhi(gv.w)));
                        *(v4u*)(YB + ((size_t)b * SEQ + t0 + t) * LRU_W + n * LRU_BD + cc * 8) = o; } }
                __syncthreads();
            }
        }
#undef L2_LOAD
        if (PASS == 1 && tid < LRU_BD) { const size_t o = ((size_t)b * 8 + seg) * LRU_W + n * LRU_BD + tid; SEG[o] = CAR[tid]; SEG[LRU_SEG + o] = CAR[176 + tid]; }
    }
}

__device__ __forceinline__ void lru3_pass(LAS unsigned char* lds, const bf16* PROJ, const float* SEG, bf16* YB, const v4u* AB, int wg, int nwg) {
    const int tid = threadIdx.x, lane = tid & 63, wid = __builtin_amdgcn_readfirstlane(tid >> 6), fr = lane & 15, fq = lane >> 4, rt = wid & 3, half = wid >> 2;
    LAS float* XCH = (LAS float*)(lds + L2_XCH);
    LAS float* CAR = (LAS float*)(lds + L2_CAR);
#pragma unroll 1
    for (int unit = wg; unit < 256; unit += nwg) {
        const int n = unit & 15, b = (unit >> 4) >> 3, seg = (unit >> 4) & 7;
        __syncthreads();
        if (tid < 176) { float cin = 0.f;
            if (tid < LRU_BD) { for (int sg = 0; sg < seg; ++sg) { const size_t o = ((size_t)b * 8 + sg) * LRU_W + n * LRU_BD + tid; cin = SEG[o] * cin + SEG[LRU_SEG + o]; } }
            CAR[tid] = cin; }
        const bf16* gbase = PROJ + ((size_t)b * SEQ) * 5376 + n * LRU_BD;
        const v4u* abase = AB + (((size_t)unit * 16) * 8 + wid) * 6 * 64 + lane;
        v4u abr[6];
#pragma unroll
        for (int k = 0; k < 6; ++k) abr[k] = (6 * half + k < 11) ? abase[k * 64] : (v4u){0u, 0u, 0u, 0u};
        __syncthreads();
#pragma unroll 1
        for (int st = 0; st < 16; ++st) {
            const int t0 = seg * 1024 + st * 64, par = st & 1;
            v4u greg[3];
#pragma unroll
            for (int k = 0; k < 3; ++k) { const int c3 = tid + 512 * k; greg[k] = (v4u){0u, 0u, 0u, 0u}; if (c3 < 64 * 21) greg[k] = *(const v4u*)(gbase + (size_t)(t0 + c3 / 21) * 5376 + (c3 % 21) * 8); }
            float av[6][4], bv[6][4], Aex[6], Bex[6];
#pragma unroll
            for (int k = 0; k < 6; ++k) { const int ct = 6 * half + k; const int ch = 16 * ct + fr; const v4u w = abr[k];
                const float lr[4] = {bflo(w.x), bfhi(w.x), bflo(w.y), bfhi(w.y)}, br[4] = {bflo(w.z), bfhi(w.z), bflo(w.w), bfhi(w.w)};
                float A4 = 1.f, B4 = 0.f;
#pragma unroll
                for (int r = 0; r < 4; ++r) { const float a = __builtin_amdgcn_exp2f(lr[r]); av[k][r] = a; bv[k][r] = br[r]; B4 = a * B4 + br[r]; A4 = a * A4; }
#pragma unroll
                for (int off = 16; off < 64; off <<= 1) { const float Ap = __shfl_up(A4, off), Bp = __shfl_up(B4, off); if (lane >= off) { B4 = A4 * Bp + B4; A4 = A4 * Ap; } }
                float ae = __shfl_up(A4, 16), be = __shfl_up(B4, 16); if (fq == 0) { ae = 1.f; be = 0.f; }
                Aex[k] = ae; Bex[k] = be;
                if (fq == 3 && ct < 11) { XCH[(rt * 176 + ch) * 2] = A4; XCH[(rt * 176 + ch) * 2 + 1] = B4; } }
            if (st + 1 < 16) {
#pragma unroll
                for (int k = 0; k < 6; ++k) abr[k] = (6 * half + k < 11) ? abase[(size_t)(st + 1) * 8 * 6 * 64 + k * 64] : (v4u){0u, 0u, 0u, 0u}; }
            __syncthreads();
#pragma unroll
            for (int k = 0; k < 6; ++k) { const int ct = 6 * half + k; const int ch = 16 * ct + fr;
                if (ct < 11) {
                    float hin = CAR[par * 176 + ch];
#pragma unroll
                    for (int q = 0; q < 3; ++q) if (q < rt) { const float a2 = XCH[(q * 176 + ch) * 2], b2 = XCH[(q * 176 + ch) * 2 + 1]; hin = a2 * hin + b2; }
                    float hh = Aex[k] * hin + Bex[k];
#pragma unroll
                    for (int r = 0; r < 4; ++r) { hh = av[k][r] * hh + bv[k][r]; if (ch < LRU_BD) *(LAS bf16*)(lds + L2_U + (16 * rt + 4 * fq + r) * 336 + ch * 2) = f2bf16(hh); }
                    if (rt == 3 && fq == 3) CAR[(par ^ 1) * 176 + ch] = hh;
                } }
            __syncthreads();
#pragma unroll
            for (int k = 0; k < 3; ++k) { const int c3 = tid + 512 * k;
                if (c3 < 64 * 21) { const int t = c3 / 21, cc = c3 % 21; const v4u hv = *(const LAS v4u*)(lds + L2_U + t * 336 + cc * 16); const v4u gv = greg[k];
                    v4u o; o.x = pk_bf16(bflo(hv.x) * fast_gelu_tanh(bflo(gv.x)), bfhi(hv.x) * fast_gelu_tanh(bfhi(gv.x))); o.y = pk_bf16(bflo(hv.y) * fast_gelu_tanh(bflo(gv.y)), bfhi(hv.y) * fast_gelu_tanh(bfhi(gv.y)));
                    o.z = pk_bf16(bflo(hv.z) * fast_gelu_tanh(bflo(gv.z)), bfhi(hv.z) * fast_gelu_tanh(bfhi(gv.z))); o.w = pk_bf16(bflo(hv.w) * fast_gelu_tanh(bflo(gv.w)), bfhi(hv.w) * fast_gelu_tanh(bfhi(gv.w)));
                    *(v4u*)(YB + ((size_t)b * SEQ + t0 + t) * LRU_W + n * LRU_BD + cc * 8) = o; } }
        }
    }
}

constexpr size_t ML_ARR = (size_t)8 * SEQ;
__device__ __forceinline__ void mlstm_pre(LAS unsigned char* lds, const float* G, const float* bif, float* MLS, int wg, int nwg) {
    const int tid = threadIdx.x, lane = tid & 63, wid = tid >> 6;
    LAS float* GG = (LAS float*)lds; LAS float* PP = GG + 128; LAS float* MP = PP + 128;
    float* ALPHA = MLS; float* BETA = MLS + ML_ARR; float* WI = MLS + 2 * ML_ARR; float* EMv = MLS + 3 * ML_ARR; float* WK = MLS + 4 * ML_ARR; float* DEC = MLS + 5 * ML_ARR;
    for (int u = wg; u < 8; u += nwg) {
        const int b = u >> 2, h = u & 3; const float bi = bif[h], bfg = bif[4 + h];
        float btv[16], bev[16], Pv[16];
#pragma unroll
        for (int i = 0; i < 16; ++i) { const size_t row = (size_t)b * SEQ + (wid * 16 + i) * 64 + lane; bev[i] = G[row * 16 + h] + bi; btv[i] = G[row * 16 + 4 + h] + bfg; }
        __syncthreads();
#pragma unroll
        for (int i = 0; i < 16; ++i) {
            float bt = log_sigmoid_f(btv[i]);
#pragma unroll
            for (int o = 1; o < 64; o <<= 1) { const float v = __shfl_up(bt, o); if (lane >= o) bt += v; }
            const float beta = bev[i] - bt; float P = beta;
#pragma unroll
            for (int o = 1; o < 64; o <<= 1) { const float v = __shfl_up(P, o); if (lane >= o) P = fmaxf(P, v); }
            btv[i] = bt; bev[i] = beta; Pv[i] = P;
            if (lane == 63) { GG[wid * 16 + i] = bt; PP[wid * 16 + i] = P; }
        }
        __syncthreads();
        if (tid == 0) { float m = -1e30f; for (int c = 0; c < 128; ++c) { MP[c] = m; m = GG[c] + fmaxf(m, PP[c]); } }
        __syncthreads();
#pragma unroll
        for (int i = 0; i < 16; ++i) { const int c = wid * 16 + i; const float m_prev = MP[c], g = GG[c], P63 = PP[c];
            const float bt = btv[i], beta = bev[i], mt = bt + fmaxf(m_prev, Pv[i]), m_new = g + fmaxf(m_prev, P63);
            const size_t o = (size_t)u * SEQ + c * 64 + lane;
            ALPHA[o] = bt - mt; BETA[o] = beta; WI[o] = expf(bt + m_prev - mt); EMv[o] = expf(-mt); { const float wkv = expf(g - m_new + beta) * 0.0625f; WK[o] = wkv; ((bf16*)(MLS + 6 * ML_ARR))[o] = f2bf16(wkv); }
            if (lane == 0) DEC[u * 128 + c] = expf(g + m_prev - m_new); }
    }
}

__device__ __forceinline__ void mlstm_post(const bf16* HB, const bf16* PROJ, const float* head_g, bf16* YB, int gw, int ngw, int lane) {
    for (int it = gw; it < MTOK * 4; it += ngw) {
        const int row = it >> 2, hh = it & 3;
        const v4u hv = *(const v4u*)(HB + (size_t)row * DM + hh * 512 + lane * 8);
        const v4u ov = *(const v4u*)(PROJ + (size_t)row * 4096 + 2048 + hh * 512 + lane * 8);
        float hf[8] = {bflo(hv.x), bfhi(hv.x), bflo(hv.y), bfhi(hv.y), bflo(hv.z), bfhi(hv.z), bflo(hv.w), bfhi(hv.w)};
        const float of[8] = {bflo(ov.x), bfhi(ov.x), bflo(ov.y), bfhi(ov.y), bflo(ov.z), bfhi(ov.z), bflo(ov.w), bfhi(ov.w)};
        float ss = 0.f;
#pragma unroll
        for (int e = 0; e < 8; ++e) ss += hf[e] * hf[e];
        const float r = rsqrtf(wave_sum(ss) * (1.f / 512.f) + EPS);
        const f32x4 g0 = *(const f32x4*)(head_g + hh * 512 + lane * 8), g1 = *(const f32x4*)(head_g + hh * 512 + lane * 8 + 4);
        const float gg[8] = {g0.x, g0.y, g0.z, g0.w, g1.x, g1.y, g1.z, g1.w};
#pragma unroll
        for (int e = 0; e < 8; ++e) hf[e] = sigmoid_f(of[e]) * (hf[e] * r * gg[e]);
        v4u w; w.x = pk_bf16(hf[0], hf[1]); w.y = pk_bf16(hf[2], hf[3]); w.z = pk_bf16(hf[4], hf[5]); w.w = pk_bf16(hf[6], hf[7]);
        *(v4u*)(YB + (size_t)row * DM + hh * 512 + lane * 8) = w;
    }
}

constexpr int MI_QT = 0, MI_KK = 33792, MI_VT = 67584, MI_ST = MI_VT + 528 * 144, MI_SC = MI_ST + 9216, MI_END = MI_SC + 512;
static_assert(MI_END <= LDSCTL_OFF, "mLSTM intra LDS map");
__device__ __forceinline__ void mlstm_intra(LAS unsigned char* lds, const bf16* PROJ, const bf16* VTM, const float* MLS, bf16* NUMI, bf16* KT, int wg, int nwg) {
    const int tid = threadIdx.x, lane = tid & 63, wid = __builtin_amdgcn_readfirstlane(tid >> 6), fr = lane & 15, fq = lane >> 4;
    LAS float* SC = (LAS float*)(lds + MI_SC);
    __syncthreads();
    for (int i = tid; i < 16 * 72; i += 512) { const int r = 512 + i / 72, c = i % 72; *(LAS bf16*)(lds + MI_VT + r * 144 + c * 2) = (r == 512) ? (bf16)0x3F80 : (bf16)0; }
#pragma unroll 1
    for (int u = wg; u < 1024; u += nwg) {
        const int bh = u >> 7, c = u & 127, b = bh >> 2, h = bh & 3, t0 = c * 64;
        const bf16* qbase = PROJ + ((size_t)b * SEQ + t0) * 4096 + h * 256;
        const bf16* vbase = VTM + ((size_t)h * 512) * MTOK + (size_t)b * SEQ + t0;
#pragma unroll
        for (int i = 0; i < 4; ++i) { const int cc = tid + 512 * i; const int row = cc >> 5, ch = cc & 31;
            const v4u qv = *(const v4u*)(qbase + (size_t)row * 4096 + ch * 8), kv = *(const v4u*)(qbase + 1024 + (size_t)row * 4096 + ch * 8);
            *(LAS v4u*)(lds + MI_QT + row * 528 + ch * 16) = qv; *(LAS v4u*)(lds + MI_KK + row * 528 + ch * 16) = kv; }
#pragma unroll
        for (int i = 0; i < 8; ++i) { const int cc = tid + 512 * i; const int e = cc >> 3, ch = cc & 7;
            *(LAS v4u*)(lds + MI_VT + e * 144 + ch * 16) = *(const v4u*)(vbase + (size_t)e * MTOK + ch * 8); }
        if (tid < 128) SC[tid] = MLS[(size_t)(tid >> 6) * ML_ARR + (size_t)bh * SEQ + t0 + (tid & 63)];
        __syncthreads();
#pragma unroll
        for (int i = 0; i < 4; ++i) { const int item = tid + 512 * i; const int sg = item & 7, d = item >> 3; unsigned short e[8];
#pragma unroll
            for (int q = 0; q < 8; ++q) e[q] = *(const LAS bf16*)(lds + MI_KK + (8 * sg + q) * 528 + d * 2);
            v4u o; o.x = (unsigned)e[0] | ((unsigned)e[1] << 16); o.y = (unsigned)e[2] | ((unsigned)e[3] << 16); o.z = (unsigned)e[4] | ((unsigned)e[5] << 16); o.w = (unsigned)e[6] | ((unsigned)e[7] << 16);
            *(v4u*)(KT + ((size_t)h * 256 + d) * MTOK + (size_t)b * SEQ + t0 + 8 * sg) = o; }
        { const int tt = wid >> 1;
#pragma unroll
          for (int si = 0; si < 2; ++si) { const int stl = 2 * (wid & 1) + si;
              u32x2 w = (u32x2){0u, 0u};
              if (stl <= tt) {
                  f32x4 acc = (f32x4){0.f, 0.f, 0.f, 0.f};
#pragma unroll
                  for (int ks = 0; ks < 8; ++ks) { const bf16x8 af = *(const LAS bf16x8*)(lds + MI_KK + (16 * stl + fr) * 528 + ks * 64 + fq * 16);
                      const bf16x8 bfr = *(const LAS bf16x8*)(lds + MI_QT + (16 * tt + fr) * 528 + ks * 64 + fq * 16); acc = MFMA16(af, bfr, acc); }
                  const int t = 16 * tt + fr; const float al = SC[t]; const f32x4 be = *(const LAS f32x4*)(SC + 64 + 16 * stl + 4 * fq);
                  float sv[4];
#pragma unroll
                  for (int r = 0; r < 4; ++r) { const int s = 16 * stl + 4 * fq + r; sv[r] = (s <= t) ? acc[r] * 0.0625f * __expf(al + be[r]) : 0.f; }
                  w.x = pk_bf16(sv[0], sv[1]); w.y = pk_bf16(sv[2], sv[3]);
              }
              *(LAS u32x2*)(lds + MI_ST + (16 * tt + fr) * 144 + (16 * stl + 4 * fq) * 2) = w; } }
        __syncthreads();
        { const int tt = wid >> 1;
          const bf16x8 b0 = *(const LAS bf16x8*)(lds + MI_ST + (16 * tt + fr) * 144 + fq * 16), b1 = *(const LAS bf16x8*)(lds + MI_ST + (16 * tt + fr) * 144 + 64 + fq * 16);
          bf16* op = NUMI + (((size_t)b * SEQ + t0 + 16 * tt + fr) * 4 + h) * 528 + 4 * fq;
#pragma unroll 3
          for (int et = (wid & 1); et < 33; et += 2) {
              const bf16x8 a0 = *(const LAS bf16x8*)(lds + MI_VT + (16 * et + fr) * 144 + fq * 16), a1 = *(const LAS bf16x8*)(lds + MI_VT + (16 * et + fr) * 144 + 64 + fq * 16);
              f32x4 acc = (f32x4){0.f, 0.f, 0.f, 0.f};
              acc = MFMA16(a0, b0, acc); acc = MFMA16(a1, b1, acc);
              u32x2 w; w.x = pk_bf16(acc[0], acc[1]); w.y = pk_bf16(acc[2], acc[3]);
              *(u32x2*)(op + 16 * et) = w; } }
        __syncthreads();
    }
}

constexpr int M2_QT = 0, M2_KT = 33792, M2_CET = M2_KT + 36864, M2_VEW = M2_CET + 2 * 33792, M2_NST = M2_VEW + 9216, M2_SC = M2_NST + 2048, M2_END = M2_SC + 1024;
static_assert(M2_END <= LDSCTL_OFF, "mLSTM inter LDS map");
constexpr size_t ML_CS_FLOATS = (size_t)8 * 4 * 256 * 512, ML_NS_FLOATS = (size_t)8 * 4 * 256;
template <int PASS>
__device__ __forceinline__ void mlstm_walk(LAS unsigned char* lds, const bf16* PROJ, const bf16* KT, const bf16* VTM, const float* MLS, const bf16* NUMI, float* CLOC, float* CSt, float* NLOC, float* NSt, bf16* HB, int wg, int nwg) {
    const int tid = threadIdx.x, lane = tid & 63, wid = __builtin_amdgcn_readfirstlane(tid >> 6), fr = lane & 15, fq = lane >> 4;
    const float* DEC = MLS + 5 * ML_ARR;
    LAS float* SC = (LAS float*)(lds + M2_SC);
#pragma unroll 1
    for (int unit = wg; unit < 256; unit += nwg) {
        const int bh = unit >> 5, sl = (unit >> 2) & 7, seg = unit & 3, b = bh >> 2, h = bh & 3, e0 = sl * 64, c_lo = seg * 32;
        __syncthreads();
        f32x4 cst[2][4];
        const size_t csoff = (((size_t)bh * 4 + seg) * 256) * 512;
        if (PASS == 3) {
            float dsg[3];
#pragma unroll
            for (int sg = 0; sg < 3; ++sg) { float p = 1.f;
#pragma unroll 1
                for (int c = 0; c < 32; ++c) p *= ld_agent_f32(DEC + bh * 128 + sg * 32 + c);
                dsg[sg] = p; }
#pragma unroll
            for (int i = 0; i < 2; ++i)
#pragma unroll
                for (int j = 0; j < 4; ++j)
#pragma unroll
                    for (int r = 0; r < 4; ++r) { float st = 0.f;
#pragma unroll
                        for (int sg = 0; sg < 3; ++sg) if (sg < seg) st = st * dsg[sg] + CLOC[(((size_t)bh * 4 + sg) * 256 + 16 * (2 * wid + i) + 4 * fq + r) * 512 + e0 + 16 * j + fr];
                        cst[i][j][r] = st; }
            if (tid < 256) { float st = 0.f;
#pragma unroll
                for (int sg = 0; sg < 3; ++sg) if (sg < seg) st = st * dsg[sg] + NLOC[((size_t)bh * 4 + sg) * 256 + tid];
                ((LAS float*)(lds + M2_NST))[tid] = st; }
#pragma unroll
            for (int i = 0; i < 2; ++i)
#pragma unroll
                for (int j = 0; j < 4; ++j) { u32x2 w; w.x = pk_bf16(cst[i][j][0], cst[i][j][1]); w.y = pk_bf16(cst[i][j][2], cst[i][j][3]);
                    *(LAS u32x2*)(lds + M2_CET + (16 * j + fr) * 528 + (16 * (2 * wid + i) + 4 * fq) * 2) = w; }
        } else {
#pragma unroll
            for (int i = 0; i < 2; ++i)
#pragma unroll
                for (int j = 0; j < 4; ++j) cst[i][j] = (f32x4){0.f, 0.f, 0.f, 0.f};
            if (tid < 256) ((LAS float*)(lds + M2_NST))[tid] = 0.f;
        }
        const bf16* qbase = PROJ + ((size_t)b * SEQ) * 4096 + h * 256;
        const bf16* ktbase = KT + ((size_t)h * 256) * MTOK + (size_t)b * SEQ;
        const bf16* vbase = VTM + ((size_t)h * 512 + e0) * MTOK + (size_t)b * SEQ;
        const size_t sbase = (size_t)bh * SEQ;
        const int tt = wid >> 1, eh = wid & 1;
        const bf16* nbase = NUMI + (((size_t)b * SEQ + 16 * tt + fr) * 4 + h) * 528;
        v4u qreg[4], ktreg[4], vreg, wkb; float screg = 0.f; u32x2 nreg[2]; unsigned short dreg = 0;
#define M2_LOAD(t0_) do { _Pragma("unroll") for (int i_ = 0; i_ < 4; ++i_) { const int c_ = tid + 512 * i_; const int row_ = c_ >> 5, ch_ = c_ & 31; \
            if (PASS == 3) qreg[i_] = *(const v4u*)(qbase + (size_t)((t0_) + row_) * 4096 + ch_ * 8); \
            const int d_ = c_ >> 3, kc_ = c_ & 7; ktreg[i_] = *(const v4u*)(ktbase + (size_t)d_ * MTOK + (t0_) + kc_ * 8); } \
        { const int e_ = tid >> 3, ch_ = tid & 7; vreg = *(const v4u*)(vbase + (size_t)e_ * MTOK + (t0_) + ch_ * 8); \
            wkb = *(const v4u*)((const bf16*)(MLS + 6 * ML_ARR) + sbase + (t0_) + ch_ * 8); } \
        if (tid < 192) { const int a_ = 2 + (tid >> 6), s_ = tid & 63; screg = MLS[(size_t)a_ * ML_ARR + sbase + (t0_) + s_]; } \
        if (PASS == 3) { _Pragma("unroll") for (int jj_ = 0; jj_ < 2; ++jj_) nreg[jj_] = *(const u32x2*)(nbase + (size_t)(t0_) * 4 * 528 + e0 + 16 * (2 * eh + jj_) + 4 * fq); dreg = nbase[(size_t)(t0_) * 4 * 528 + 512]; } } while (0)
        M2_LOAD(c_lo * 64);
#pragma unroll 1
        for (int c = c_lo; c < c_lo + 32; ++c) {
            const int t0 = c * 64, par = c & 1;
            const LAS unsigned char* cet_rd = lds + M2_CET + par * 33792; LAS unsigned char* cet_wr = lds + M2_CET + (par ^ 1) * 33792;
            const LAS float* nst_rd = (const LAS float*)(lds + M2_NST) + par * 256; LAS float* nst_wr = (LAS float*)(lds + M2_NST) + (par ^ 1) * 256;
#pragma unroll
            for (int i = 0; i < 4; ++i) { const int cc = tid + 512 * i; const int row = cc >> 5, ch = cc & 31;
                if (PASS == 3) *(LAS v4u*)(lds + M2_QT + row * 528 + ch * 16) = qreg[i];
                const int d = cc >> 3, kc = cc & 7; *(LAS v4u*)(lds + M2_KT + d * 144 + kc * 16) = ktreg[i]; }
            { const int e = tid >> 3, ch = tid & 7; v4u o;
                o.x = pk_bf16(bflo(vreg.x) * bflo(wkb.x), bfhi(vreg.x) * bfhi(wkb.x)); o.y = pk_bf16(bflo(vreg.y) * bflo(wkb.y), bfhi(vreg.y) * bfhi(wkb.y));
                o.z = pk_bf16(bflo(vreg.z) * bflo(wkb.z), bfhi(vreg.z) * bfhi(wkb.z)); o.w = pk_bf16(bflo(vreg.w) * bflo(wkb.w), bfhi(vreg.w) * bfhi(wkb.w));
                *(LAS v4u*)(lds + M2_VEW + e * 144 + ch * 16) = o; }
            if (tid < 192) SC[tid] = screg;
            const u32x2 numi0 = nreg[0], numi1 = nreg[1]; const float deni = bf2f(dreg);
            const float dec = ld_agent_f32(DEC + bh * 128 + c);
            __syncthreads();
            if (c + 1 < c_lo + 32) M2_LOAD(t0 + 64);
            if (PASS == 3) {
                float dot = 0.f;
#pragma unroll
                for (int i = 0; i < 8; ++i) { const v4u qv = *(const LAS v4u*)(lds + M2_QT + (16 * tt + fr) * 528 + fq * 128 + i * 16); const LAS float* np = nst_rd + fq * 64 + i * 8;
                    const f32x4 n0 = *(const LAS f32x4*)np, n1 = *(const LAS f32x4*)(np + 4);
                    dot += bflo(qv.x) * n0[0] + bfhi(qv.x) * n0[1] + bflo(qv.y) * n0[2] + bfhi(qv.y) * n0[3] + bflo(qv.z) * n1[0] + bfhi(qv.z) * n1[1] + bflo(qv.w) * n1[2] + bfhi(qv.w) * n1[3]; }
                dot += __shfl_xor(dot, 16); dot += __shfl_xor(dot, 32);
                f32x4 acc0 = (f32x4){0.f, 0.f, 0.f, 0.f}, acc1 = acc0;
#pragma unroll
                for (int ks = 0; ks < 8; ++ks) { const bf16x8 bfr = *(const LAS bf16x8*)(lds + M2_QT + (16 * tt + fr) * 528 + ks * 64 + fq * 16);
                    const bf16x8 a0 = *(const LAS bf16x8*)(cet_rd + (16 * (2 * eh) + fr) * 528 + ks * 64 + fq * 16), a1 = *(const LAS bf16x8*)(cet_rd + (16 * (2 * eh + 1) + fr) * 528 + ks * 64 + fq * 16);
                    acc0 = MFMA16(a0, bfr, acc0); acc1 = MFMA16(a1, bfr, acc1); }
                const int t = 16 * tt + fr; const float wi = SC[t], em = SC[64 + t], den = wi * dot + deni; const float inv = __builtin_amdgcn_rcpf(fmaxf(fabsf(den), em));
                bf16* hp = HB + ((size_t)b * SEQ + t0 + t) * DM + h * 512 + e0 + 32 * eh + 4 * fq;
                { u32x2 w; w.x = pk_bf16((acc0[0] * wi + bflo(numi0.x)) * inv, (acc0[1] * wi + bfhi(numi0.x)) * inv); w.y = pk_bf16((acc0[2] * wi + bflo(numi0.y)) * inv, (acc0[3] * wi + bfhi(numi0.y)) * inv); *(u32x2*)hp = w; }
                { u32x2 w; w.x = pk_bf16((acc1[0] * wi + bflo(numi1.x)) * inv, (acc1[1] * wi + bfhi(numi1.x)) * inv); w.y = pk_bf16((acc1[2] * wi + bflo(numi1.y)) * inv, (acc1[3] * wi + bfhi(numi1.y)) * inv); *(u32x2*)(hp + 16) = w; }
            }
#pragma unroll
            for (int i = 0; i < 2; ++i) {
                const bf16x8 af0 = *(const LAS bf16x8*)(lds + M2_KT + (16 * (2 * wid + i) + fr) * 144 + fq * 16), af1 = *(const LAS bf16x8*)(lds + M2_KT + (16 * (2 * wid + i) + fr) * 144 + 64 + fq * 16);
#pragma unroll
                for (int j = 0; j < 4; ++j) {
#pragma unroll
                    for (int r = 0; r < 4; ++r) cst[i][j][r] *= dec;
                    const bf16x8 b0 = *(const LAS bf16x8*)(lds + M2_VEW + (16 * j + fr) * 144 + fq * 16), b1 = *(const LAS bf16x8*)(lds + M2_VEW + (16 * j + fr) * 144 + 64 + fq * 16);
                    cst[i][j] = MFMA16(af0, b0, cst[i][j]); cst[i][j] = MFMA16(af1, b1, cst[i][j]);
                    if (PASS == 3) { u32x2 w; w.x = pk_bf16(cst[i][j][0], cst[i][j][1]); w.y = pk_bf16(cst[i][j][2], cst[i][j][3]);
                        *(LAS u32x2*)(cet_wr + (16 * j + fr) * 528 + (16 * (2 * wid + i) + 4 * fq) * 2) = w; } } }
            if (tid < 256) { float a = nst_rd[tid] * dec;
#pragma unroll
                for (int i = 0; i < 8; ++i) { const v4u kv = *(const LAS v4u*)(lds + M2_KT + tid * 144 + i * 16); const f32x4 w0 = *(const LAS f32x4*)(SC + 128 + 8 * i), w1 = *(const LAS f32x4*)(SC + 128 + 8 * i + 4);
                    a += bflo(kv.x) * w0[0] + bfhi(kv.x) * w0[1] + bflo(kv.y) * w0[2] + bfhi(kv.y) * w0[3] + bflo(kv.z) * w1[0] + bfhi(kv.z) * w1[1] + bflo(kv.w) * w1[2] + bfhi(kv.w) * w1[3]; }
                nst_wr[tid] = a; }
            __syncthreads();
        }
#undef M2_LOAD
        if (PASS == 1) {
#pragma unroll
            for (int i = 0; i < 2; ++i)
#pragma unroll
                for (int j = 0; j < 4; ++j)
#pragma unroll
                    for (int r = 0; r < 4; ++r) CLOC[csoff + (size_t)(16 * (2 * wid + i) + 4 * fq + r) * 512 + e0 + 16 * j + fr] = cst[i][j][r];
            if (sl == 0 && tid < 256) NLOC[((size_t)bh * 4 + seg) * 256 + tid] = ((const LAS float*)(lds + M2_NST))[tid];
        }
    }
}

struct Args { const float* in[22]; float* out; unsigned char* ws; TrJob jobs[NJOBS]; int grp_job_lo[5]; int grp_items[4]; int ph_lo, ph_hi; int pad; };
enum PhaseId { PH_P0, PH_FOX_IN, PH_FOX_CUM, PH_FOX_ATT, PH_FOX_OUT, PH_L0_MID, PH_L0_UP, PH_L0_DOWN, PH_L0_UPB, PH_L0_DOWNB, PH_L0_END, PH_LRU_IN, PH_LRU_P1, PH_LRU_P3, PH_LRU_OUT, PH_L1_MID, PH_L1_UP, PH_L1_DOWN, PH_L1_UPB, PH_L1_DOWNB, PH_L1_END, PH_SB_IN, PH_SB_ATT, PH_SB_OUT, PH_L2_MID, PH_L2_UP, PH_L2_DOWN, PH_L2_UPB, PH_L2_DOWNB, PH_L2_END, PH_ML_IN, PH_ML_PRE, PH_ML_INTRA, PH_ML_W1, PH_ML_W3, PH_ML_POST, PH_ML_OUT, PH_L3_MID, PH_L3_UP, PH_L3_DOWN, PH_L3_UPB, PH_L3_DOWNB, PH_L3_END, NPH };

#define GEMM_CALL(ACT_, Aptr, Bptr, Mv, Nv, Kv, Optr, ldc_, gcol_, Gptr, ng_, rs_, cs_) do { \
        pg8::Gemm g_{(const pg8::bf16_t*)(Aptr), (const pg8::bf16_t*)(Bptr), (Mv), (Nv), (Kv)}; pg8::StaticOrder S_; S_.init((Mv), (Nv), (int)gridDim.x, (int)blockIdx.x); \
        pg8::EpiStore<ACT_> E_{(pg8::bf16_t*)(Optr), (ldc_), (gcol_), (Gptr), (ng_), (rs_), (cs_)}; \
        pg8::gemm_phase<pg8::EpiStore<ACT_>, pg8::StaticOrder, true, true>(lds, g_, S_, E_); } while (0)

#define CONVERT_GROUP(g_, first_wg_) do { if (wg >= (first_wg_)) { LAS float* scr_ = (LAS float*)(lds + wave * 8704); const int jlo_ = args.grp_job_lo[g_], jhi_ = args.grp_job_lo[(g_) + 1]; \
        for (int it_ = (wg - (first_wg_)) * NWAVES + wave; it_ < args.grp_items[g_]; it_ += (G - (first_wg_)) * NWAVES) { int j_ = jlo_; \
            _Pragma("unroll 1") for (int q_ = jlo_ + 1; q_ < jhi_; ++q_) if (it_ >= args.jobs[q_].item0) j_ = q_; \
            const TrJob jb_ = args.jobs[j_]; tr_item(jb_.src, jb_.gk, jb_.ldw, jb_.ncols, jb_.K, jb_.dst, scr_, it_ - jb_.item0, lane); } } } while (0)

__global__ void __launch_bounds__(NWAVES * 64, 2) fwd_kernel(Args args) {
    extern __shared__ __attribute__((aligned(16))) unsigned char lds_raw[];
    LAS unsigned char* lds = (LAS unsigned char*)lds_raw;
    volatile LAS unsigned* MISC = (volatile LAS unsigned*)(lds + LDSCTL_OFF);
    const int tid = threadIdx.x, lane = tid & 63, wave = __builtin_amdgcn_readfirstlane(tid >> 6);
    const int G = gridDim.x, wg = blockIdx.x;
    const int gw = wg * NWAVES + wave, ngw = G * NWAVES;
    for (int u = tid; u < 64; u += NWAVES * 64) MISC[u] = 0u;
    __syncthreads();
    const int lo = args.ph_lo, hi = args.ph_hi;
    const bool use_bar = (hi - lo) > 1;
    XcdBarrier bar; bar.bar = (unsigned*)(args.ws + WS_CTL) + 4096; bar.x = 0; bar.st = nullptr;
    if (use_bar) bar = xcd_barrier_post((unsigned*)(args.ws + WS_CTL) + 4096, MISC + 8);
#ifdef ONLY_PHASE
#define IN(k) ((k) == ONLY_PHASE && lo <= (k) && (k) < hi)
#else
#define IN(k) (lo <= (k) && (k) < hi)
#endif
#define SEAM(k) do { if (IN((k) + 1)) xcd_barrier(bar); } while (0)
#ifndef PROBE_MASK
#define PROBE_MASK 0ull
#endif
#define NREP(k) ((((unsigned long long)(PROBE_MASK) >> (k)) & 1ull) ? 2 : 1)
#define PHASE(k, ...) if (IN(k)) { _Pragma("unroll 1") for (int rep_ = 0; rep_ < NREP(k); ++rep_) { __VA_ARGS__; if (rep_ + 1 < NREP(k)) xcd_barrier(bar); } SEAM(k); }

#define x_in (args.in[0])
#define norm_g (args.in[1])
#define out (args.out)
#define WSP(T, off) ((T*)(args.ws + (off)))
#define W_FOXIN WSP(bf16, WS_W_FOXIN)
#define W_FOXOUT WSP(bf16, WS_W_FOXOUT)
#define W_LRUIN WSP(bf16, WS_W_LRUIN)
#define W_LRUOUT WSP(bf16, WS_W_LRUOUT)
#define W_SBIN WSP(bf16, WS_W_SBIN)
#define W_SBOUT WSP(bf16, WS_W_SBOUT)
#define W_MLIN WSP(bf16, WS_W_MLIN)
#define W_MLOUT WSP(bf16, WS_W_MLOUT)
#define W1 WSP(bf16, WS_W1)
#define W2 WSP(bf16, WS_W2)
#define H WSP(bf16, WS_H)
#define HM WSP(bf16, WS_HM)
#define PROJ WSP(bf16, WS_PROJ)
#define VT WSP(bf16, WS_PROJ + WS_VT_OFF)
#define Y WSP(bf16, WS_Y)
#define HID WSP(bf16, WS_HID)
#define KT WSP(bf16, WS_KT)
#define GATES WSP(float, WS_GATES)
#define CUM WSP(float, WS_CUM)
#define MLS WSP(float, WS_MLS)
#define KNORM WSP(float, WS_KN)
#define R2V WSP(float, WS_R2)
#define ML_NUMI WSP(bf16, WS_Y)
#define ML_CLOC WSP(float, WS_MLST)
#define ML_CS WSP(float, WS_MLST + 16 * MiB)
#define ML_NLOC WSP(float, WS_MLST + 32 * MiB)
#define ML_NS WSP(float, WS_MLST + 32 * MiB + 65536)
#define LRU_SEGS WSP(float, WS_LRU_SEG)
#define LRU_WGT WSP(bf16, WS_LRU_WGT)
#define LRU_AB WSP(v4u, WS_MLST)

    PHASE(PH_P0,
        CONVERT_GROUP(0, 0);
        gate_rows(args.in[4], norm_g, 6160, 6144, 16, W_FOXIN + (size_t)4096 * DM, wg * 512 + tid, G * 512);
        gate_rows(args.in[18], norm_g + 12 * DM, 6152, 6144, 8, W_MLIN + (size_t)4096 * DM, wg * 512 + tid, G * 512);
        lru_wgt_prep(args.in[10], args.in[12], LRU_WGT, wg * 512 + tid, G * 512);
        row_first(x_in, H, R2V, gw, ngw, lane))
    PHASE(PH_FOX_IN, GEMM_CALL(0, H, W_FOXIN, MTOK, 4352, DM, PROJ, 4096, 4096, GATES, 16, R2V, nullptr);
             GEMM_CALL(0, W_FOXIN + (size_t)4352 * DM, H, 2048, MTOK, DM, VT, MTOK, INT_MAX, nullptr, 0, nullptr, R2V); CONVERT_GROUP(1, 64))
    PHASE(PH_FOX_CUM, fox_cumsum(lds, GATES, args.in[5], CUM, wg, G); fox_knorm(PROJ, KNORM, gw, ngw, lane))
    PHASE(PH_FOX_ATT, attn_phase<0>(lds, PROJ, VT, CUM, KNORM, Y, (unsigned*)(args.ws + WS_CTL) + 1024))
    PHASE(PH_FOX_OUT, GEMM_CALL(0, Y, W_FOXOUT, MTOK, DM, DM, HM, DM, INT_MAX, nullptr, 0, nullptr, nullptr))
    PHASE(PH_L0_MID, row_upd<false>(H, HM, norm_g + 1 * DM, R2V, nullptr, gw, ngw, lane))
    PHASE(PH_L0_UP, GEMM_CALL(2, H, W1, MTOK / 2, DFF, DM, HID, DFF, INT_MAX, nullptr, 0, R2V, nullptr))
    PHASE(PH_L0_DOWN, GEMM_CALL(0, HID, W2, MTOK / 2, DM, DFF, HM, DM, INT_MAX, nullptr, 0, nullptr, nullptr))
    PHASE(PH_L0_UPB, GEMM_CALL(2, H + (size_t)(MTOK / 2) * DM, W1, MTOK / 2, DFF, DM, HID, DFF, INT_MAX, nullptr, 0, R2V + MTOK / 2, nullptr))
    PHASE(PH_L0_DOWNB, GEMM_CALL(0, HID, W2, MTOK / 2, DM, DFF, HM + (size_t)(MTOK / 2) * DM, DM, INT_MAX, nullptr, 0, nullptr, nullptr))
    PHASE(PH_L0_END, row_upd<false>(H, HM, norm_g + 3 * DM, R2V, nullptr, gw, ngw, lane))
    PHASE(PH_LRU_IN, GEMM_CALL(0, H, W_LRUIN, MTOK, 5376, DM, PROJ, 5376, INT_MAX, nullptr, 0, R2V, nullptr); CONVERT_GROUP(2, 64))
    PHASE(PH_LRU_P1, lru2_pass<1>(lds, PROJ, LRU_WGT, args.in[8], args.in[9], args.in[11], args.in[13], args.in[14], LRU_SEGS, Y, LRU_AB, wg, G))
    PHASE(PH_LRU_P3, lru3_pass(lds, PROJ, LRU_SEGS, Y, LRU_AB, wg, G))
    PHASE(PH_LRU_OUT, GEMM_CALL(0, Y, W_LRUOUT, MTOK, DM, LRU_W, HM, DM, INT_MAX, nullptr, 0, nullptr, nullptr))
    PHASE(PH_L1_MID, row_upd<false>(H, HM, norm_g + 5 * DM, R2V, nullptr, gw, ngw, lane))
    PHASE(PH_L1_UP, GEMM_CALL(2, H, W1 + (size_t)1 * DFF * DM, MTOK / 2, DFF, DM, HID, DFF, INT_MAX, nullptr, 0, R2V, nullptr))
    PHASE(PH_L1_DOWN, GEMM_CALL(0, HID, W2 + (size_t)1 * DFF * DM, MTOK / 2, DM, DFF, HM, DM, INT_MAX, nullptr, 0, nullptr, nullptr))
    PHASE(PH_L1_UPB, GEMM_CALL(2, H + (size_t)(MTOK / 2) * DM, W1 + (size_t)1 * DFF * DM, MTOK / 2, DFF, DM, HID, DFF, INT_MAX, nullptr, 0, R2V + MTOK / 2, nullptr))
    PHASE(PH_L1_DOWNB, GEMM_CALL(0, HID, W2 + (size_t)1 * DFF * DM, MTOK / 2, DM, DFF, HM + (size_t)(MTOK / 2) * DM, DM, INT_MAX, nullptr, 0, nullptr, nullptr))
    PHASE(PH_L1_END, row_upd<false>(H, HM, norm_g + 7 * DM, R2V, nullptr, gw, ngw, lane))
    PHASE(PH_SB_IN, GEMM_CALL(0, H, W_SBIN, MTOK, 4096, DM, PROJ, 4096, INT_MAX, nullptr, 0, R2V, nullptr);
              GEMM_CALL(0, W_SBIN + (size_t)4096 * DM, H, 2048, MTOK, DM, VT, MTOK, INT_MAX, nullptr, 0, nullptr, R2V))
    PHASE(PH_SB_ATT, attn_phase<1>(lds, PROJ, VT, CUM, KNORM, Y, (unsigned*)(args.ws + WS_CTL) + 1088))
    PHASE(PH_SB_OUT, GEMM_CALL(0, Y, W_SBOUT, MTOK, DM, DM, HM, DM, INT_MAX, nullptr, 0, nullptr, nullptr))
    PHASE(PH_L2_MID, row_upd<false>(H, HM, norm_g + 9 * DM, R2V, nullptr, gw, ngw, lane))
    PHASE(PH_L2_UP, GEMM_CALL(2, H, W1 + (size_t)2 * DFF * DM, MTOK / 2, DFF, DM, HID, DFF, INT_MAX, nullptr, 0, R2V, nullptr))
    PHASE(PH_L2_DOWN, GEMM_CALL(0, HID, W2 + (size_t)2 * DFF * DM, MTOK / 2, DM, DFF, HM, DM, INT_MAX, nullptr, 0, nullptr, nullptr))
    PHASE(PH_L2_UPB, GEMM_CALL(2, H + (size_t)(MTOK / 2) * DM, W1 + (size_t)2 * DFF * DM, MTOK / 2, DFF, DM, HID, DFF, INT_MAX, nullptr, 0, R2V + MTOK / 2, nullptr))
    PHASE(PH_L2_DOWNB, GEMM_CALL(0, HID, W2 + (size_t)2 * DFF * DM, MTOK / 2, DM, DFF, HM + (size_t)(MTOK / 2) * DM, DM, INT_MAX, nullptr, 0, nullptr, nullptr))
    PHASE(PH_L2_END, row_upd<false>(H, HM, norm_g + 11 * DM, R2V, nullptr, gw, ngw, lane))
    PHASE(PH_ML_IN, GEMM_CALL(0, H, W_MLIN, MTOK, 4352, DM, PROJ, 4096, 4096, GATES, 8, R2V, nullptr);
              GEMM_CALL(0, W_MLIN + (size_t)4352 * DM, H, 2048, MTOK, DM, VT, MTOK, INT_MAX, nullptr, 0, nullptr, R2V); CONVERT_GROUP(3, 64))
    PHASE(PH_ML_PRE, mlstm_pre(lds, GATES, args.in[19], MLS, wg, G))
    PHASE(PH_ML_INTRA, mlstm_intra(lds, PROJ, VT, MLS, ML_NUMI, KT, wg, G))
    PHASE(PH_ML_W1, mlstm_walk<1>(lds, PROJ, KT, VT, MLS, ML_NUMI, ML_CLOC, ML_CS, ML_NLOC, ML_NS, HM, wg, G))
    PHASE(PH_ML_W3, mlstm_walk<3>(lds, PROJ, KT, VT, MLS, ML_NUMI, ML_CLOC, ML_CS, ML_NLOC, ML_NS, HM, wg, G))
    PHASE(PH_ML_POST, mlstm_post(HM, PROJ, args.in[20], Y, gw, ngw, lane))
    PHASE(PH_ML_OUT, GEMM_CALL(0, Y, W_MLOUT, MTOK, DM, DM, HM, DM, INT_MAX, nullptr, 0, nullptr, nullptr))
    PHASE(PH_L3_MID, row_upd<false>(H, HM, norm_g + 13 * DM, R2V, nullptr, gw, ngw, lane))
    PHASE(PH_L3_UP, GEMM_CALL(2, H, W1 + (size_t)3 * DFF * DM, MTOK / 2, DFF, DM, HID, DFF, INT_MAX, nullptr, 0, R2V, nullptr))
    PHASE(PH_L3_DOWN, GEMM_CALL(0, HID, W2 + (size_t)3 * DFF * DM, MTOK / 2, DM, DFF, HM, DM, INT_MAX, nullptr, 0, nullptr, nullptr))
    PHASE(PH_L3_UPB, GEMM_CALL(2, H + (size_t)(MTOK / 2) * DM, W1 + (size_t)3 * DFF * DM, MTOK / 2, DFF, DM, HID, DFF, INT_MAX, nullptr, 0, R2V + MTOK / 2, nullptr))
    PHASE(PH_L3_DOWNB, GEMM_CALL(0, HID, W2 + (size_t)3 * DFF * DM, MTOK / 2, DM, DFF, HM + (size_t)(MTOK / 2) * DM, DM, INT_MAX, nullptr, 0, nullptr, nullptr))
    if (IN(PH_L3_END)) { row_upd<true>(H, HM, norm_g + 15 * DM, nullptr, out, gw, ngw, lane); }
#undef IN
#undef SEAM
}
#undef x_in
#undef norm_g
#undef out
#undef WSP
#undef W_FOXIN
#undef W_FOXOUT
#undef W_LRUIN
#undef W_LRUOUT
#undef W_SBIN
#undef W_SBOUT
#undef W_MLIN
#undef W_MLOUT
#undef W1
#undef W2
#undef H
#undef HM
#undef PROJ
#undef VT
#undef Y
#undef HID
#undef KT
#undef GATES
#undef CUM
#undef MLS
#undef KNORM
#undef R2V
#undef ML_NUMI
#undef ML_CLOC
#undef ML_CS
#undef ML_NLOC
#undef ML_NS
#undef LRU_SEGS
#undef LRU_WGT
#undef LRU_AB

#ifndef N_LAUNCH_SPLIT
#define N_LAUNCH_SPLIT 0
#endif
extern "C" void kernel_launch(void* const* d_in, const int* in_sizes, int n_in, void* d_out, int out_size, void* d_ws, size_t ws_size, hipStream_t stream) {
    static int grid = 0;
    if (grid == 0) {
        if (n_in != 22 || out_size != MTOK * DM || ws_size < WS_END) { fprintf(stderr, "kernel_launch: unexpected shapes (n_in %d, out %d, ws %zu)\n", n_in, out_size, ws_size); grid = -1; return; }
        int dev = 0, cus = 0, per_cu = 0;
        if (hipGetDevice(&dev) != hipSuccess || hipDeviceGetAttribute(&cus, hipDeviceAttributeMultiprocessorCount, dev) != hipSuccess) { grid = -1; return; }
        if (hipFuncSetAttribute((const void*)fwd_kernel, hipFuncAttributeMaxDynamicSharedMemorySize, LDS_BYTES) != hipSuccess) { fprintf(stderr, "kernel_launch: hipFuncSetAttribute failed\n"); grid = -1; return; }
        if (hipOccupancyMaxActiveBlocksPerMultiprocessor(&per_cu, (const void*)fwd_kernel, NWAVES * 64, LDS_BYTES) != hipSuccess || per_cu < 1) { fprintf(stderr, "kernel_launch: occupancy query says %d\n", per_cu); per_cu = 1; }
        (void)hipGetLastError();
        grid = cus;
    }
    if (grid < 0) return;
    unsigned char* ws = (unsigned char*)d_ws;
    Args a{};
    for (int i = 0; i < 22; ++i) a.in[i] = (const float*)d_in[i];
    a.out = (float*)d_out; a.ws = ws;
    {
        int nj = 0, items = 0;
        auto add = [&](const float* src, int ldw, int ncols, int K, size_t dst_off, const float* gk) { a.jobs[nj].src = src; a.jobs[nj].gk = gk; a.jobs[nj].dst = (bf16*)(ws + dst_off); a.jobs[nj].ldw = ldw; a.jobs[nj].ncols = ncols; a.jobs[nj].K = K; a.jobs[nj].item0 = items; items += (K / 64) * (ncols / 32); ++nj; };
        const float* fox_in = a.in[4]; const float* ml_in = a.in[18]; const float* ng0 = a.in[1];
        auto w1 = [&](int l) { add(a.in[2] + (size_t)l * DM * DFF, DFF, DFF, DM, WS_W1 + (size_t)l * DFF * DM * 2, ng0 + (size_t)(4 * l + 2) * DM); };
        auto w2 = [&](int l) { add(a.in[3] + (size_t)l * DFF * DM, DM, DM, DFF, WS_W2 + (size_t)l * DFF * DM * 2, nullptr); };
        a.grp_job_lo[0] = nj; items = 0;
        add(fox_in, 6160, 4096, DM, WS_W_FOXIN, ng0);
        add(fox_in + 4096, 6160, 2048, DM, WS_W_FOXIN + (size_t)4352 * DM * 2, ng0);
        add(a.in[7], 5376, 5376, DM, WS_W_LRUIN, ng0 + 4 * DM);
        add(a.in[16], 6144, 6144, DM, WS_W_SBIN, ng0 + 8 * DM);
        add(a.in[17], DM, DM, DM, WS_W_SBOUT, nullptr);
        add(ml_in, 6152, 2048, DM, WS_W_MLIN, ng0 + 12 * DM);
        add(ml_in + 4096, 6152, 2048, DM, WS_W_MLIN + (size_t)2048 * DM * 2, ng0 + 12 * DM);
        add(ml_in + 2048, 6152, 2048, DM, WS_W_MLIN + (size_t)4352 * DM * 2, ng0 + 12 * DM);
        w1(2); w2(2);
        a.grp_items[0] = items;
        a.grp_job_lo[1] = nj; items = 0;
        add(a.in[6], DM, DM, DM, WS_W_FOXOUT, nullptr); w1(0); w2(0);
        a.grp_items[1] = items;
        a.grp_job_lo[2] = nj; items = 0;
        add(a.in[15], DM, DM, LRU_W, WS_W_LRUOUT, nullptr); w1(1); w2(1);
        a.grp_items[2] = items;
        a.grp_job_lo[3] = nj; items = 0;
        add(a.in[21], DM, DM, DM, WS_W_MLOUT, nullptr); w1(3); w2(3);
        a.grp_items[3] = items;
        a.grp_job_lo[4] = nj;
    }
    if (hipMemsetAsync(ws + WS_CTL, 0, CTL_ZERO_BYTES, stream) != hipSuccess) { fprintf(stderr, "kernel_launch: memset failed\n"); return; }
#if N_LAUNCH_SPLIT
    for (int p = 0; p < NPH; ++p) { a.ph_lo = p; a.ph_hi = p + 1; hipLaunchKernelGGL(fwd_kernel, dim3(grid), dim3(NWAVES * 64), LDS_BYTES, stream, a); }
#else
    a.ph_lo = 0; a.ph_hi = NPH;
    hipLaunchKernelGGL(fwd_kernel, dim3(grid), dim3(NWAVES * 64), LDS_BYTES, stream, a);
#endif
    const hipError_t le = hipPeekAtLastError();
    if (le != hipSuccess) fprintf(stderr, "kernel_launch: launch failed: %s\n", hipGetErrorName(le));
}
```

```cpp
#include <hip/hip_runtime.h>
#include <cstdio>
#include <cstdint>
#include <climits>
namespace pg8 {
#define PG8_LAS __attribute__((address_space(3)))
typedef unsigned short bf16_t;
typedef short bf16x8 __attribute__((ext_vector_type(8)));
typedef float f32x4 __attribute__((ext_vector_type(4)));
typedef unsigned u32x4 __attribute__((ext_vector_type(4)));
constexpr int BM = 256, BK = 64, HALF = 128, HTB = HALF * BK * 2  , STAGE_BYTES = 8 * HTB, NXCD = 8, WGM = 8;

__host__ __device__ __forceinline__ int lds_byte(int r, int c) { const int st = (r >> 4) * 2 + (c >> 5), rr = r & 15, cc = c & 31, ob = rr * 64 + cc * 2; return st * 1024 + (ob ^ (((ob >> 9) & 1) << 5)); }
__host__ __device__ __forceinline__ void stage_rc(int b, int& R, int& C) { const int st = b / 1024, sb = b % 1024, swz = sb ^ (((sb >> 9) & 1) << 5); R = (st >> 1) * 16 + swz / 64; C = (st & 1) * 32 + (swz % 64) / 2; }
__host__ __device__ __forceinline__ int perm32(int rho) { const int n = rho >> 4, i = rho & 15; return 8 * (i >> 2) + 4 * n + (i & 3); }

struct Unit { int pm, pn; };
struct Gemm { const bf16_t* A; const bf16_t* Bt; int M, N, K; };

struct StaticOrder {
    int nM, nN, nwg, G, c;
    __host__ __device__ void init(int M, int N, int G_, int c_) { nM = M / BM; nN = N / BM; nwg = nM * nN; G = G_; c = c_; }
    __host__ __device__ bool next(int i, Unit& u) const {
        const long L = (long)i * G + c; if (L >= nwg) return false;
        int wgid = (int)L; { const int q = nwg / NXCD, r = nwg % NXCD, xcd = wgid % NXCD, off = wgid / NXCD; wgid = (xcd < r ? xcd * (q + 1) : r * (q + 1) + (xcd - r) * q) + off; }
        const int nig = WGM * nN, gid = wgid / nig, fm = gid * WGM, gsz = (nM - fm) < WGM ? (nM - fm) : WGM;
        u.pm = fm + ((wgid % nig) % gsz); u.pn = (wgid % nig) / gsz; return true;
    }
    __device__ __forceinline__ void a_ready(const Unit&) const {}
    __device__ __forceinline__ void done(const Unit&) const {}
};
__device__ __forceinline__ unsigned pk_bf16(float lo, float hi) {
    typedef __bf16 bf2_t __attribute__((ext_vector_type(2))); typedef float f2_t __attribute__((ext_vector_type(2)));
    const bf2_t r = __builtin_convertvector((f2_t){lo, hi}, bf2_t); return __builtin_bit_cast(unsigned, r); }
template <int ACT  > struct EpiStore {
    static constexpr bool PERM = true, AFTER_DRAIN = false;
    bf16_t* O; int ldc; int gate_col0; float* G; int ng; const float* rs; const float* cs;
    __device__ __forceinline__ void operator()(const f32x4 (&acc)[2][2][4][2], const Unit& u, int wr, int wc, int fr, int fq) const {
        const int row0 = u.pm * BM + wr * 64 + fr; const int colt = u.pn * BM;
        if (colt >= gate_col0) {
            if (wc == 0) {
#pragma unroll
                for (int ai = 0; ai < 2; ++ai)
#pragma unroll
                    for (int m = 0; m < 4; ++m) { const int rr = row0 + ai * HALF + m * 16; float* gp = G + (size_t)rr * 16; const float sc = rs ? rs[rr] : 1.f;
#pragma unroll
                        for (int n = 0; n < 2; ++n) { const int c = 8 * fq + 4 * n; if (c < ng) *(f32x4*)(gp + c) = acc[ai][0][m][n] * sc; } }
            }
            return;
        }
        const int col0 = colt + wc * 32 + 8 * fq;
        f32x4 c0[2], c1[2];
#pragma unroll
        for (int bj = 0; bj < 2; ++bj) { c0[bj] = cs ? *(const f32x4*)(cs + col0 + bj * HALF) : (f32x4){1.f, 1.f, 1.f, 1.f}; c1[bj] = cs ? *(const f32x4*)(cs + col0 + bj * HALF + 4) : (f32x4){1.f, 1.f, 1.f, 1.f}; }
#pragma unroll
        for (int ai = 0; ai < 2; ++ai)
#pragma unroll
            for (int m = 0; m < 4; ++m) { const int rr = row0 + ai * HALF + m * 16; bf16_t* rowp = O + (size_t)rr * ldc + col0; const float sc = rs ? rs[rr] : 1.f;
#pragma unroll
                for (int bj = 0; bj < 2; ++bj) { f32x4 v0 = acc[ai][bj][m][0] * sc * c0[bj], v1 = acc[ai][bj][m][1] * sc * c1[bj];
                    if (ACT == 2) {
#pragma unroll
                        for (int e = 0; e < 4; ++e) { const float a = fmaxf(v0[e], 0.f), b = fmaxf(v1[e], 0.f); v0[e] = a * a; v1[e] = b * b; } }
                    u32x4 w; w.x = pk_bf16(v0[0], v0[1]); w.y = pk_bf16(v0[2], v0[3]); w.z = pk_bf16(v1[0], v1[1]); w.w = pk_bf16(v1[2], v1[3]);
                    *(u32x4*)(rowp + bj * HALF) = w; } }
    }
};
template <class Epi, class Sched, bool ALIGN_EPI = false, bool SP2 = false>
__device__ __forceinline__ void gemm_phase(PG8_LAS unsigned char* lds, const Gemm g, const Sched& S, const Epi& E) {
    const int tid = threadIdx.x, wid = __builtin_amdgcn_readfirstlane(tid >> 6), lane = tid & 63, wr = wid >> 2, wc = wid & 3, fr = lane & 15, fq = lane >> 4;
    const int K = g.K, nt = K / BK;
    unsigned voffA[2], voffB[2];
#pragma unroll
    for (int i = 0; i < 2; ++i) { int R, C; stage_rc(tid * 16 + i * 8192, R, C); const int Rb = Epi::PERM ? ((R & ~31) + perm32(R & 31)) : R;
        voffA[i] = (unsigned)(R * K + C) * 2u; voffB[i] = (unsigned)(Rb * K + C) * 2u; }
    const size_t kstep = (size_t)(BK * 2);
    const size_t hstep = (size_t)HALF * K * 2;
    const size_t tstep = 2 * hstep;
    const unsigned ldsw = (unsigned)wid * 1024u;
    const int aoff = lds_byte(wr * 64 + fr, fq * 8), boff = lds_byte(wc * 32 + fr, fq * 8);
#define PG8_SA(b, h) (((b) * 2 + (h)) * HTB)
#define PG8_SB(b, h) ((4 + (b) * 2 + (h)) * HTB)
#define PG8_STAGE(bufoff, gbase, voff) do { _Pragma("unroll") for (int _i = 0; _i < 2; ++_i) \
        __builtin_amdgcn_global_load_lds((const unsigned*)((const char*)(gbase) + (voff)[_i]), (PG8_LAS unsigned*)(lds + (bufoff) + ldsw + _i * 8192), 16, 0, 0); } while (0)
#define PG8_LDA(dst, b, h) do { _Pragma("unroll") for (int m = 0; m < 4; ++m) _Pragma("unroll") for (int k = 0; k < 2; ++k) dst[m][k] = *(const PG8_LAS bf16x8*)(lds + PG8_SA(b, h) + aoff + m * 2048 + k * 1024); } while (0)
#define PG8_LDB(dst, b, h) do { _Pragma("unroll") for (int n = 0; n < 2; ++n) _Pragma("unroll") for (int k = 0; k < 2; ++k) dst[n][k] = *(const PG8_LAS bf16x8*)(lds + PG8_SB(b, h) + boff + n * 2048 + k * 1024); } while (0)
#define PG8_MMA(ai, bj, At, Bt) do { __builtin_amdgcn_s_setprio(1); _Pragma("unroll") for (int m = 0; m < 4; ++m) _Pragma("unroll") for (int n = 0; n < 2; ++n) _Pragma("unroll") for (int k = 0; k < 2; ++k) \
        acc[ai][bj][m][n] = __builtin_amdgcn_mfma_f32_16x16x32_bf16(Bt[n][k], At[m][k], acc[ai][bj][m][n], 0, 0, 0); __builtin_amdgcn_s_setprio(0); } while (0)
#define PG8_WAIT_V(n) asm volatile("s_waitcnt vmcnt(" #n ")" ::: "memory")
#define PG8_WAIT_L(n) asm volatile("s_waitcnt lgkmcnt(" #n ")" ::: "memory")
#define PG8_BAR __builtin_amdgcn_s_barrier()
#define PG8_SCHED __builtin_amdgcn_sched_barrier(0)
    Unit cur, nxt; int ui = 0;
    if (!S.next(0, cur)) return;
    f32x4 acc[2][2][4][2];
#pragma unroll
    for (int a = 0; a < 2; ++a)
#pragma unroll
        for (int b = 0; b < 2; ++b)
#pragma unroll
            for (int m = 0; m < 4; ++m)
#pragma unroll
                for (int n = 0; n < 2; ++n) acc[a][b][m][n] = (f32x4){0.f, 0.f, 0.f, 0.f};
    bf16x8 At[4][2], B0[2][2], B1[2][2];
    const char* cA = (const char*)g.A + (size_t)cur.pm * tstep; const char* cB = (const char*)g.Bt + (size_t)cur.pn * tstep;
    S.a_ready(cur);
    if constexpr (SP2) {
        PG8_STAGE(PG8_SB(0, 0), cB, voffB); PG8_STAGE(PG8_SB(0, 1), cB + hstep, voffB); PG8_STAGE(PG8_SA(0, 0), cA, voffA); PG8_STAGE(PG8_SA(0, 1), cA + hstep, voffA);
        if (wr == 1) PG8_BAR;
        PG8_WAIT_V(2); PG8_BAR;
        PG8_STAGE(PG8_SB(1, 0), cB + kstep, voffB); PG8_STAGE(PG8_SA(1, 0), cA + kstep, voffA); PG8_STAGE(PG8_SB(1, 1), cB + hstep + kstep, voffB);
        PG8_WAIT_V(6); PG8_BAR;
    } else {
        PG8_STAGE(PG8_SB(0, 0), cB, voffB); PG8_STAGE(PG8_SA(0, 0), cA, voffA); PG8_STAGE(PG8_SB(0, 1), cB + hstep, voffB); PG8_STAGE(PG8_SA(0, 1), cA + hstep, voffA);
        if (wr == 1) PG8_BAR;
        PG8_WAIT_V(4); PG8_BAR;
        PG8_STAGE(PG8_SB(1, 0), cB + kstep, voffB); PG8_STAGE(PG8_SA(1, 0), cA + kstep, voffA); PG8_STAGE(PG8_SB(1, 1), cB + hstep + kstep, voffB);
        PG8_WAIT_V(6); PG8_BAR;
    }
    for (;;) {
        const bool has_next = S.next(ui + 1, nxt);
        const char* nA = has_next ? (const char*)g.A + (size_t)nxt.pm * tstep : cA; const char* nB = has_next ? (const char*)g.Bt + (size_t)nxt.pn * tstep : cB;
        for (int t = 0; t < nt; t += 2) {
            const bool last = (t == nt - 2);
            const char* a1 = cA + (size_t)(t + 1) * kstep;
            const char* a2 = last ? nA : cA + (size_t)(t + 2) * kstep; const char* b2 = last ? nB : cB + (size_t)(t + 2) * kstep;
            const char* a3 = a2 + kstep; const char* b3 = b2 + kstep;
            if (last && has_next) S.a_ready(nxt);
            if constexpr (SP2) {
            PG8_LDB(B0, 0, 0); PG8_LDB(B1, 0, 1); PG8_SCHED; PG8_LDA(At, 0, 0); PG8_STAGE(PG8_SA(1, 1), a1 + hstep, voffA);
            PG8_WAIT_V(8); PG8_WAIT_L(0); PG8_BAR; PG8_MMA(0, 0, At, B0); PG8_MMA(0, 1, At, B1); PG8_BAR; PG8_SCHED;
            PG8_LDA(At, 0, 1); PG8_STAGE(PG8_SB(0, 0), b2, voffB); PG8_STAGE(PG8_SB(0, 1), b2 + hstep, voffB); PG8_STAGE(PG8_SA(0, 0), a2, voffA);
            PG8_WAIT_V(8); PG8_WAIT_L(0); PG8_BAR; PG8_MMA(1, 0, At, B0); PG8_MMA(1, 1, At, B1); PG8_BAR; PG8_SCHED;
            PG8_LDB(B0, 1, 0); PG8_LDB(B1, 1, 1); PG8_SCHED; PG8_LDA(At, 1, 0); PG8_STAGE(PG8_SA(0, 1), a2 + hstep, voffA);
            PG8_WAIT_V(8); PG8_WAIT_L(0); PG8_BAR; PG8_MMA(0, 0, At, B0); PG8_MMA(0, 1, At, B1); PG8_BAR; PG8_SCHED;
            PG8_LDA(At, 1, 1); PG8_STAGE(PG8_SB(1, 0), b3, voffB); PG8_STAGE(PG8_SB(1, 1), b3 + hstep, voffB); PG8_STAGE(PG8_SA(1, 0), a3, voffA);
            PG8_WAIT_V(8); PG8_WAIT_L(0); PG8_BAR; PG8_MMA(1, 0, At, B0); PG8_MMA(1, 1, At, B1); PG8_BAR; PG8_SCHED;
            } else {
            PG8_LDB(B0, 0, 0); PG8_SCHED; PG8_LDA(At, 0, 0); PG8_STAGE(PG8_SA(1, 1), a1 + hstep, voffA);
            PG8_WAIT_L(8); PG8_BAR; PG8_WAIT_L(0); PG8_MMA(0, 0, At, B0); PG8_BAR; PG8_SCHED;
            PG8_LDB(B1, 0, 1); PG8_STAGE(PG8_SB(0, 0), b2, voffB);
            PG8_BAR; PG8_WAIT_L(0); PG8_MMA(0, 1, At, B1); PG8_BAR;
            PG8_LDA(At, 0, 1); PG8_STAGE(PG8_SA(0, 0), a2, voffA);
            PG8_BAR; PG8_WAIT_L(0); PG8_MMA(1, 0, At, B0); PG8_BAR; PG8_SCHED;
            PG8_STAGE(PG8_SB(0, 1), b2 + hstep, voffB);
            PG8_WAIT_V(6); PG8_BAR; PG8_MMA(1, 1, At, B1); PG8_BAR;
            PG8_LDB(B0, 1, 0); PG8_SCHED; PG8_LDA(At, 1, 0); PG8_STAGE(PG8_SA(0, 1), a2 + hstep, voffA);
            PG8_WAIT_L(8); PG8_BAR; PG8_WAIT_L(0); PG8_MMA(0, 0, At, B0); PG8_BAR; PG8_SCHED;
            PG8_LDB(B1, 1, 1); PG8_STAGE(PG8_SB(1, 0), b3, voffB);
            PG8_BAR; PG8_WAIT_L(0); PG8_MMA(0, 1, At, B1); PG8_BAR;
            PG8_LDA(At, 1, 1); PG8_STAGE(PG8_SA(1, 0), a3, voffA);
            PG8_BAR; PG8_WAIT_L(0); PG8_MMA(1, 0, At, B0); PG8_BAR; PG8_SCHED;
            PG8_STAGE(PG8_SB(1, 1), b3 + hstep, voffB);
            PG8_WAIT_V(6); PG8_BAR; PG8_MMA(1, 1, At, B1); PG8_BAR;
            }
        }
        if constexpr (ALIGN_EPI) { if (wr == 0) PG8_BAR; }
        if constexpr (!Epi::AFTER_DRAIN) { E(acc, cur, wr, wc, fr, fq); S.done(cur); }
        if (!has_next) break;
#pragma unroll
        for (int a = 0; a < 2; ++a)
#pragma unroll
            for (int b = 0; b < 2; ++b)
#pragma unroll
                for (int m = 0; m < 4; ++m)
#pragma unroll
                    for (int n = 0; n < 2; ++n) acc[a][b][m][n] = (f32x4){0.f, 0.f, 0.f, 0.f};
        cur = nxt; cA = nA; cB = nB; ++ui;
        if constexpr (ALIGN_EPI) { if (wr == 1) PG8_BAR; }
    }
    PG8_WAIT_V(0);
    if constexpr (!ALIGN_EPI) { if (wr == 0) PG8_BAR; }
    PG8_BAR;
    if constexpr (Epi::AFTER_DRAIN) { E.fused(acc, cur, wr, wc, fr, fq, lds, wid, lane); S.done(cur); }
#undef PG8_SA
#undef PG8_SB
#undef PG8_STAGE
#undef PG8_LDA
#undef PG8_LDB
#undef PG8_MMA
#undef PG8_WAIT_V
#undef PG8_WAIT_L
#undef PG8_BAR
#undef PG8_SCHED
}
}
#define GAS __attribute__((address_space(1)))
#define LAS __attribute__((address_space(3)))
typedef unsigned short bf16;
typedef unsigned v4u __attribute__((ext_vector_type(4)));
typedef float f32x4 __attribute__((ext_vector_type(4)));
typedef short bf16x8 __attribute__((ext_vector_type(8)));
typedef GAS unsigned gu32;
typedef GAS unsigned long long gu64;
#define RLX_AGENT __ATOMIC_RELAXED, __HIP_MEMORY_SCOPE_AGENT
#define LDS_WAIT() asm volatile("s_waitcnt lgkmcnt(0)" ::: "memory")
#define VM_WAIT() asm volatile("s_waitcnt vmcnt(0)" ::: "memory")
__device__ __forceinline__ unsigned long long rt() { return __builtin_amdgcn_s_memrealtime(); }
__device__ __forceinline__ unsigned f2bf(float f) { unsigned u = __builtin_bit_cast(unsigned, f); return (u + 0x7fffu + ((u >> 16) & 1u)) >> 16; }
__device__ __forceinline__ unsigned pk2(float lo, float hi) { return f2bf(lo) | (f2bf(hi) << 16); }

#define XB_TMO      128
#define XB_XCNT(j)  (256  + 64 * (j))
#define XB_XSUB(j)  (1280 + 64 * (j))
#define XB_XGEN(j)  (2304 + 64 * (j))
#define XB_TOP      3328
#define XB_TOPGEN   3392
#define XCD_BAR_WORDS 3456
#define XB_SPIN_CAP (1u << 18)

__device__ __forceinline__ unsigned xb_ld(unsigned* p)              { return __hip_atomic_load(p, __ATOMIC_RELAXED, __HIP_MEMORY_SCOPE_AGENT); }
__device__ __forceinline__ unsigned xb_add(unsigned* p, unsigned v) { return __hip_atomic_fetch_add(p, v, __ATOMIC_RELAXED, __HIP_MEMORY_SCOPE_AGENT); }
__device__ __forceinline__ unsigned xb_xcc_id() { return (unsigned)__builtin_amdgcn_s_getreg((3 << 11) | 20) & 0xFu; }
#define XB_SPIN(cond, bar) do { unsigned _sp = 0; while (cond) { __builtin_amdgcn_s_sleep(1); \
    if ((++_sp & 255u) == 0u) { if (xb_ld(&(bar)[XB_TMO])) break; if (_sp > XB_SPIN_CAP) { atomicAdd(&(bar)[XB_TMO], 1u); break; } } } } while (0)

struct XcdBarrier {
    unsigned* bar; unsigned x;
    volatile LAS unsigned* st;
};

__device__ __forceinline__ XcdBarrier xcd_barrier_post(unsigned* bar, volatile LAS unsigned* st) {
    XcdBarrier b; b.bar = bar; b.x = xb_xcc_id(); b.st = st;
    if (threadIdx.x == 0) (void)xb_add(&bar[XB_XCNT(b.x)], 1u);
    return b;
}
__device__ __forceinline__ void xcd_barrier_complete(unsigned* bar, unsigned x, unsigned& nloc, unsigned& nx) {
    const unsigned G = gridDim.x * gridDim.y * gridDim.z;
    unsigned sum, cnt, mine, sp = 0u;
    for (;;) {
        sum = 0u; cnt = 0u; mine = 0u;
#pragma unroll
        for (unsigned j = 0; j < 16; ++j) { const unsigned c = xb_ld(&bar[XB_XCNT(j)]); sum += c; cnt += (c > 0u) ? 1u : 0u; mine = (j == x) ? c : mine; }
        if (sum == G) break;
        __builtin_amdgcn_s_sleep(1);
        if ((++sp & 255u) == 0u) { if (xb_ld(&bar[XB_TMO])) break; if (sp > XB_SPIN_CAP) { atomicAdd(&bar[XB_TMO], 1u); break; } }
    }
    nloc = mine > 0u ? mine : 1u; nx = cnt > 0u ? cnt : 1u;
}

__device__ __forceinline__ void xcd_barrier(const XcdBarrier& b) {
    asm volatile("s_waitcnt vmcnt(0)" ::: "memory");
    __syncthreads();
    if (threadIdx.x == 0) {
        unsigned* bar = b.bar;
        __builtin_amdgcn_s_waitcnt(0);
        unsigned nloc = b.st[0], nx = b.st[1];
        if (nloc == 0u) { xcd_barrier_complete(bar, b.x, nloc, nx); b.st[0] = nloc; b.st[1] = nx; }
        const unsigned old = xb_add(&bar[XB_XSUB(b.x)], 1u);
        const unsigned gen = old / nloc;
        if (old + 1u == (gen + 1u) * nloc) {
            __builtin_amdgcn_fence(__ATOMIC_RELEASE, "agent");
            asm volatile("s_waitcnt vmcnt(0)" ::: "memory");
            const unsigned og = xb_add(&bar[XB_TOP], 1u);
            const unsigned tg = og / nx;
            if (og + 1u == (tg + 1u) * nx) xb_add(&bar[XB_TOPGEN], 1u);
            else XB_SPIN(xb_ld(&bar[XB_TOPGEN]) == tg, bar);
            __builtin_amdgcn_fence(__ATOMIC_ACQUIRE, "agent");
            xb_add(&bar[XB_XGEN(b.x)], 1u);
            asm volatile("s_waitcnt vmcnt(0)" ::: "memory");
        } else {
            XB_SPIN(xb_ld(&bar[XB_XGEN(b.x)]) == gen, bar);
            __builtin_amdgcn_fence(__ATOMIC_ACQUIRE, "agent");
            asm volatile("s_waitcnt vmcnt(0)" ::: "memory");
        }
    }
    __syncthreads();
}

constexpr int DM = 2048, BATCH = 2, SEQ = 8192, MTOK = BATCH * SEQ, DFF = 8192, DEPTH = 4;
constexpr int LRU_W = 2688, LRU_BD = 168;
constexpr float EPS = 1e-6f;
constexpr int NWAVES = 8;
typedef unsigned short bf16;
typedef float f32x16 __attribute__((ext_vector_type(16)));
typedef unsigned u32x2 __attribute__((ext_vector_type(2)));
using pg8::pk_bf16;

constexpr size_t MiB = 1u << 20;
constexpr size_t WS_CTL = 0, CTL_ZERO_BYTES = 1 * MiB;
constexpr size_t WS_GATES = 1 * MiB;
constexpr size_t WS_CUM = 2 * MiB;
constexpr size_t WS_MLS = 3 * MiB;
constexpr size_t WS_R2 = 4 * MiB + 768 * 1024;
constexpr size_t WS_KN = 4 * MiB + 512 * 1024;
constexpr size_t WS_LRU_SEG = 5 * MiB, WS_LRU_WGT = 6 * MiB;
constexpr size_t WS_W_FOXIN = 8 * MiB, WS_W_FOXOUT = 33 * MiB, WS_W_LRUIN = 41 * MiB, WS_W_LRUOUT = 62 * MiB, WS_W_SBIN = 73 * MiB, WS_W_SBOUT = 97 * MiB,
                 WS_W_MLIN = 105 * MiB, WS_W_MLOUT = 130 * MiB, WS_W1 = 138 * MiB, WS_W2 = 266 * MiB;
constexpr size_t WS_H = 394 * MiB;
constexpr size_t WS_HM = 458 * MiB;
constexpr size_t WS_PROJ = 522 * MiB;
constexpr size_t WS_Y = 714 * MiB;
constexpr size_t WS_HID = 522 * MiB;
constexpr size_t WS_KT = 798 * MiB;
constexpr size_t WS_MLST = 830 * MiB;
constexpr size_t WS_END = 1024 * MiB;
constexpr size_t WS_VT_OFF = 128 * MiB;

constexpr int LDS_BYTES = 163840;
constexpr int LDSCTL_OFF = 163840 - 256;

#define LAS __attribute__((address_space(3)))
typedef short bf16x8 __attribute__((ext_vector_type(8)));
typedef short s16x4 __attribute__((ext_vector_type(4)));
typedef float f32x4 __attribute__((ext_vector_type(4)));
typedef unsigned v4u __attribute__((ext_vector_type(4)));
#define MFMA32(a, b, c) __builtin_amdgcn_mfma_f32_32x32x16_bf16((a), (b), (c), 0, 0, 0)
#define MFMA16(a, b, c) __builtin_amdgcn_mfma_f32_16x16x32_bf16((a), (b), (c), 0, 0, 0)

__device__ __forceinline__ float bf2f(unsigned short b) { return __uint_as_float((unsigned)b << 16); }
__device__ __forceinline__ float bflo(unsigned w) { return __uint_as_float(w << 16); }
__device__ __forceinline__ float bfhi(unsigned w) { return __uint_as_float(w & 0xffff0000u); }
__device__ __forceinline__ unsigned short f2bf16(float f) { return (unsigned short)(pk_bf16(f, 0.f) & 0xffffu); }
__device__ __forceinline__ float wave_sum(float v) {
#pragma unroll
    for (int o = 1; o < 64; o <<= 1) v += __shfl_xor(v, o);
    return v;
}
__device__ __forceinline__ float log_sigmoid_f(float x) { return fminf(x, 0.f) - log1pf(expf(-fabsf(x))); }
__device__ __forceinline__ float sigmoid_f(float x) { return 1.f / (1.f + expf(-x)); }
__device__ __forceinline__ float gelu_tanh_f(float x) { const float u = 0.7978845608028654f * (x + 0.044715f * x * x * x); const float t = 1.f - 2.f / (1.f + expf(2.f * u)); return 0.5f * x * (1.f + t); }
__device__ __forceinline__ float ld_agent_f32(const float* p) { return __uint_as_float(__hip_atomic_load((const unsigned*)p, __ATOMIC_RELAXED, __HIP_MEMORY_SCOPE_AGENT)); }

struct TrJob { const float* src; bf16* dst; const float* gk; int ldw, ncols, K, item0; };
constexpr int NJOBS = 19;
__device__ __forceinline__ void tr_item(const float* W, const float* gk, int ldw, int ncols, int K, bf16* WT, LAS float* scr, int item, int lane) {
    const int nblk = ncols / 32, kb = item / nblk, nb = item % nblk, k0 = 64 * kb, n0 = 32 * nb;
#pragma unroll 8
    for (int i = 0; i < 32; ++i) { const int kk = 2 * i + (lane >> 5); scr[kk * 33 + (lane & 31)] = W[(size_t)(k0 + kk) * ldw + n0 + (lane & 31)]; }
    asm volatile("s_waitcnt lgkmcnt(0)" ::: "memory");
    const int c = lane & 7;
    f32x4 g0 = (f32x4){1.f, 1.f, 1.f, 1.f}, g1 = g0;
    if (gk) { g0 = *(const f32x4*)(gk + k0 + 8 * c); g1 = *(const f32x4*)(gk + k0 + 8 * c + 4); }
#pragma unroll
    for (int j = 0; j < 4; ++j) { const int n = (lane >> 3) + 8 * j; const LAS float* s = scr + (8 * c) * 33 + n;
        v4u o; o.x = pk_bf16(s[0 * 33] * g0[0], s[1 * 33] * g0[1]); o.y = pk_bf16(s[2 * 33] * g0[2], s[3 * 33] * g0[3]); o.z = pk_bf16(s[4 * 33] * g1[0], s[5 * 33] * g1[1]); o.w = pk_bf16(s[6 * 33] * g1[2], s[7 * 33] * g1[3]);
        *(v4u*)(WT + (size_t)(n0 + n) * K + k0 + 8 * c) = o; }
    asm volatile("s_waitcnt lgkmcnt(0)" ::: "memory");
}
__device__ __forceinline__ void gate_rows(const float* W, const float* gk, int ldw, int col0, int ng, bf16* dst, int gtid, int nthr) {
    for (int i = gtid; i < 256 * DM; i += nthr) { const int g = i / DM, k = i % DM; const float v = g < ng ? W[(size_t)k * ldw + col0 + g] * gk[k] : 0.f; dst[i] = f2bf16(v); }
}

__device__ __forceinline__ void row_first(const float* xsrc, bf16* XB, float* R2, int gw, int ngw, int lane) {
    for (int row = gw; row < MTOK; row += ngw) {
        const size_t ro = (size_t)row * DM + 4 * lane; float ss = 0.f;
#pragma unroll
        for (int j = 0; j < 8; ++j) { const f32x4 v = *(const f32x4*)(xsrc + ro + 256 * j); ss += (v.x * v.x + v.y * v.y) + (v.z * v.z + v.w * v.w);
            u32x2 w; w.x = pk_bf16(v.x, v.y); w.y = pk_bf16(v.z, v.w); *(u32x2*)(XB + ro + 256 * j) = w; }
        const float r = rsqrtf(wave_sum(ss) * (1.f / DM) + EPS);
        if (lane == 0) R2[row] = r;
    }
}
template <bool FINAL>
__device__ __forceinline__ void row_upd(bf16* XB, const bf16* hm, const float* ga, float* R2, float* outp, int gw, int ngw, int lane) {
    for (int row = gw; row < MTOK; row += ngw) {
        const size_t ro = (size_t)row * DM + 4 * lane;
        u32x2 xv[8], hv[8]; float ss = 0.f;
#pragma unroll
        for (int j = 0; j < 8; ++j) { xv[j] = *(const u32x2*)(XB + ro + 256 * j); hv[j] = *(const u32x2*)(hm + ro + 256 * j);
            const float a = bflo(hv[j].x), b = bfhi(hv[j].x), c = bflo(hv[j].y), d = bfhi(hv[j].y); ss += (a * a + b * b) + (c * c + d * d); }
        const float r = rsqrtf(wave_sum(ss) * (1.f / DM) + EPS);
        float s2 = 0.f;
#pragma unroll
        for (int j = 0; j < 8; ++j) { const f32x4 g = *(const f32x4*)(ga + 256 * j + 4 * lane); f32x4 v;
            v.x = bflo(xv[j].x) + bflo(hv[j].x) * r * g.x; v.y = bfhi(xv[j].x) + bfhi(hv[j].x) * r * g.y; v.z = bflo(xv[j].y) + bflo(hv[j].y) * r * g.z; v.w = bfhi(xv[j].y) + bfhi(hv[j].y) * r * g.w;
            if (FINAL) { *(f32x4*)(outp + ro + 256 * j) = v; }
            else { s2 += (v.x * v.x + v.y * v.y) + (v.z * v.z + v.w * v.w); u32x2 w; w.x = pk_bf16(v.x, v.y); w.y = pk_bf16(v.z, v.w); *(u32x2*)(XB + ro + 256 * j) = w; } }
        if (!FINAL) { const float r2 = rsqrtf(wave_sum(s2) * (1.f / DM) + EPS); if (lane == 0) R2[row] = r2; }
    }
}

__device__ __forceinline__ void fox_cumsum(LAS unsigned char* lds, const float* G, const float* bfv, float* cum, int wg, int nwg) {
    LAS float* wtot = (LAS float*)lds;
    const int tid = threadIdx.x, lane = tid & 63, wid = tid >> 6;
    for (int u = wg; u < 32; u += nwg) {
        const int b = u >> 4, h = u & 15; const float bias = bfv[h];
        float v[16]; float run = 0.f;
#pragma unroll
        for (int i = 0; i < 16; ++i) { run += log_sigmoid_f(G[((size_t)b * SEQ + tid * 16 + i) * 16 + h] + bias); v[i] = run; }
        float inc = run;
#pragma unroll
        for (int o = 1; o < 64; o <<= 1) { const float t = __shfl_up(inc, o); if (lane >= o) inc += t; }
        __syncthreads();
        if (lane == 63) wtot[wid] = inc;
        __syncthreads();
        float off = inc - run;
        for (int w = 0; w < wid; ++w) off += wtot[w];
        float* o = cum + ((size_t)(b * 16 + h)) * SEQ + tid * 16;
#pragma unroll
        for (int i = 0; i < 16; ++i) o[i] = (off + v[i]) * 1.4426950408889634f;
    }
}


__device__ __forceinline__ void fox_knorm(const bf16* QK, float* KN, int gw, int ngw, int lane) {
    for (int it = gw; it < 2 * 16 * 128; it += ngw) { const int tile = it & 127, h = (it >> 7) & 15, b = it >> 11;
        const bf16* kp = QK + ((size_t)b * SEQ + tile * 64 + lane) * 4096 + 2048 + h * 128; float ss = 0.f;
#pragma unroll
        for (int c = 0; c < 16; ++c) { const v4u v = *(const v4u*)(kp + 8 * c);
            ss += bflo(v.x) * bflo(v.x) + bfhi(v.x) * bfhi(v.x) + bflo(v.y) * bflo(v.y) + bfhi(v.y) * bfhi(v.y) + bflo(v.z) * bflo(v.z) + bfhi(v.z) * bfhi(v.z) + bflo(v.w) * bflo(v.w) + bfhi(v.w) * bfhi(v.w); }
#pragma unroll
        for (int o = 1; o < 64; o <<= 1) ss = fmaxf(ss, __shfl_xor(ss, o));
        if (lane == 0) KN[it] = ss * 1.0001f; }
}

constexpr int AT_KB = 16384, AT_VB = 16384, AT_K0 = 0, AT_V0 = 2 * AT_KB, AT_CS = AT_V0 + 2 * AT_VB, AT_FLAG = AT_CS + 512, AT_PM = AT_FLAG + 64;
__device__ __forceinline__ int crow(int r, int hi) { return (r & 3) + 8 * (r >> 2) + 4 * hi; }

template <int MODE>
__device__ __forceinline__ void attn_unit(LAS unsigned char* lds, const bf16* QK, const bf16* VT, const float* cum, const float* KN, bf16* Y, int b, int h, int qb) {
    const int tid = threadIdx.x, lane = tid & 63, wid = __builtin_amdgcn_readfirstlane(tid >> 6), r32 = lane & 31, hi = lane >> 5;
    const float scale = 0.08838834764831845f;
    const int tq = qb * 256 + wid * 32 + r32;
    const size_t rowq = (size_t)b * SEQ + tq;
    bf16x8 qf[8];
    { const bf16* qp = QK + rowq * 4096 + h * 128 + 8 * hi;
#pragma unroll
      for (int ks = 0; ks < 8; ++ks) qf[ks] = *(const bf16x8*)(qp + 16 * ks); }
    const float* cumh = cum + (size_t)(b * 16 + h) * SEQ;
    float ct = 0.f; if (MODE == 0) ct = cumh[tq];
    f32x16 o[4];
#pragma unroll
    for (int dt = 0; dt < 4; ++dt)
#pragma unroll
        for (int r = 0; r < 16; ++r) o[dt][r] = 0.f;
    float m = 0.f, l = 0.f, R = 0.f;
    const int jmax = 4 * qb + 3, jw = 4 * qb + (wid >> 1);
    bool wdone = false;
    const bf16* kbase = QK + ((size_t)b * SEQ) * 4096 + 2048 + h * 128;
    const bf16* vbase = VT + ((size_t)h * 128) * MTOK + (size_t)b * SEQ;
#define AT_DMA(jj, buf) do { _Pragma("unroll") for (int i_ = 0; i_ < 2; ++i_) { const int pc_ = wid + 8 * i_; \
            const int row_ = 4 * pc_ + (lane >> 4), p_ = lane & 15; \
            __builtin_amdgcn_global_load_lds((const unsigned*)(kbase + (size_t)(64 * (jj) + row_) * 4096 + ((p_ ^ (row_ & 15)) << 3)), (LAS unsigned*)(lds + AT_K0 + (buf) * AT_KB + pc_ * 1024), 16, 0, 0); \
            const int d_ = 8 * pc_ + (lane >> 3), pv_ = lane & 7; \
            __builtin_amdgcn_global_load_lds((const unsigned*)(vbase + (size_t)d_ * MTOK + 64 * (jj) + ((pv_ ^ ((d_ >> 1) & 7)) << 3)), (LAS unsigned*)(lds + AT_V0 + (buf) * AT_VB + pc_ * 1024), 16, 0, 0); } \
        if (MODE == 0 && wid == 0) __builtin_amdgcn_global_load_lds((const unsigned*)(cumh + 64 * (jj) + lane), (LAS unsigned*)(lds + AT_CS + (buf) * 256), 4, 0, 0); } while (0)
    float qn = 0.f;
    if (MODE == 0) {
#pragma unroll
        for (int ks = 0; ks < 8; ++ks)
#pragma unroll
            for (int e = 0; e < 8; ++e) { const float v = bf2f((unsigned short)qf[ks][e]); qn += v * v; }
        qn += __shfl_xor(qn, 32); qn = __builtin_amdgcn_sqrtf(qn) * (scale * 1.4426950408889634f);
        if (wid == 0) { const float* kn = KN + (size_t)(b * 16 + h) * 128; float a0 = kn[lane], a1 = kn[64 + lane];
#pragma unroll
            for (int o_ = 1; o_ < 64; o_ <<= 1) { const float t0 = __shfl_up(a0, o_), t1 = __shfl_up(a1, o_); if (lane >= o_) { a0 = fmaxf(a0, t0); a1 = fmaxf(a1, t1); } }
            a1 = fmaxf(a1, __shfl(a0, 63));
            ((LAS float*)(lds + AT_PM))[lane] = __builtin_amdgcn_sqrtf(a0); ((LAS float*)(lds + AT_PM))[64 + lane] = __builtin_amdgcn_sqrtf(a1); }
    }
    AT_DMA(jmax, 0);
    asm volatile("s_waitcnt vmcnt(0)" ::: "memory");
    __syncthreads();
    for (int j = jmax; j >= 0; --j) {
        const int cur = (jmax - j) & 1;
        if (j > 0) AT_DMA(j - 1, cur ^ 1);
        if (j <= jw && !wdone) {
            const LAS unsigned char* kb = lds + AT_K0 + cur * AT_KB;
            const LAS unsigned char* vb = lds + AT_V0 + cur * AT_VB;
            const LAS float* csb = (const LAS float*)(lds + AT_CS + cur * 256);
            const int dsub = (wid & 1);
#pragma unroll
            for (int sub = 1; sub >= 0; --sub) {
                if (j == jw && sub > dsub) continue;
                const bool diag = (j == jw && sub == dsub);
                f32x16 s;
#pragma unroll
                for (int r = 0; r < 16; ++r) s[r] = 0.f;
                __builtin_amdgcn_s_setprio(1);
#pragma unroll
                for (int ks = 0; ks < 8; ++ks) {
                    const bf16x8 kf = *(const LAS bf16x8*)(kb + (32 * sub + r32) * 256 + (((2 * ks + hi) ^ (r32 & 15)) << 4));
                    s = MFMA32(kf, qf[ks], s);
                }
                __builtin_amdgcn_s_setprio(0);
                float p[16];
                if (MODE == 0) {
                    const float cm = ct - m; float mx = -1e30f;
#pragma unroll
                    for (int g = 0; g < 4; ++g) { const f32x4 cs = *(const LAS f32x4*)(csb + 32 * sub + 8 * g + 4 * hi);
#pragma unroll
                        for (int i = 0; i < 4; ++i) { const int r = 4 * g + i; float lg = s[r] * (scale * 1.4426950408889634f) + (cm - cs[i]);
                            if (diag && (8 * g + 4 * hi + i) > r32) lg = -1e30f;
                            p[r] = lg; mx = fmaxf(mx, lg); } }
                    mx = fmaxf(mx, __shfl_xor(mx, 32));
                    if (__any(mx > 0.f)) {
                        const float d = fmaxf(mx, 0.f), alpha = __builtin_amdgcn_exp2f(-d);
                        l *= alpha; m += d;
#pragma unroll
                        for (int r = 0; r < 16; ++r) p[r] -= d;
#pragma unroll
                        for (int dt = 0; dt < 4; ++dt)
#pragma unroll
                            for (int r = 0; r < 16; ++r) o[dt][r] *= alpha;
                    }
                    float ps = 0.f;
#pragma unroll
                    for (int r = 0; r < 16; ++r) { p[r] = __builtin_amdgcn_exp2f(p[r]); ps += p[r]; }
                    l += ps;
                } else {
                    float L1[16], G[4], Go[4];
#pragma unroll
                    for (int g = 0; g < 4; ++g) { float gs = 0.f;
#pragma unroll
                        for (int i = 0; i < 4; ++i) { const int r = 4 * g + i; const float zz = s[r] * scale;
                            const bool valid = !diag || (8 * g + 4 * hi + i) < r32;
                            const float sp = fmaxf(zz, 0.f) + __logf(1.f + __expf(-fabsf(zz)));
                            L1[r] = valid ? -sp : 0.f; p[r] = zz - sp; gs += L1[r]; }
                        G[g] = gs; }
#pragma unroll
                    for (int g = 0; g < 4; ++g) Go[g] = __shfl_xor(G[g], 32);
                    float T = 0.f;
#pragma unroll
                    for (int g = 3; g >= 0; --g) {
                        const float base = R + T + (hi == 0 ? Go[g] : 0.f);
                        float suf = 0.f;
#pragma unroll
                        for (int i = 3; i >= 0; --i) { const int r = 4 * g + i;
                            const bool valid = !diag || (8 * g + 4 * hi + i) < r32;
                            const float a = __expf(p[r] + base + suf);
                            p[r] = valid ? a : 0.f; suf += L1[r]; }
                        T += G[g] + Go[g];
                    }
                    R += T;
                }
#pragma unroll
                for (int st = 0; st < 2; ++st) {
                    v4u pw; pw.x = pk_bf16(p[8 * st + 0], p[8 * st + 1]); pw.y = pk_bf16(p[8 * st + 2], p[8 * st + 3]); pw.z = pk_bf16(p[8 * st + 4], p[8 * st + 5]); pw.w = pk_bf16(p[8 * st + 6], p[8 * st + 7]);
                    const bf16x8 pf = __builtin_bit_cast(bf16x8, pw);
#pragma unroll
                    for (int dt = 0; dt < 4; ++dt) {
                        const int dv_ = 32 * dt + r32, sw_ = (dv_ >> 1) & 7, c0_ = 4 * sub + 2 * st;
                        const LAS unsigned char* vrow = vb + dv_ * 128 + 8 * hi;
                        const u32x2 lo = *(const LAS u32x2*)(vrow + ((c0_ ^ sw_) << 4)), hh = *(const LAS u32x2*)(vrow + (((c0_ + 1) ^ sw_) << 4));
                        const v4u vw = (v4u){lo.x, lo.y, hh.x, hh.y};
                        o[dt] = MFMA32(__builtin_bit_cast(bf16x8, vw), pf, o[dt]);
                    }
                }
            }
            if (MODE == 1) wdone = __all(R < -104.f);
            if (MODE == 0 && j > 0) { const float bound = qn * ((const LAS float*)(lds + AT_PM))[j - 1] + (ct - csb[0]) - m; wdone = __all(bound < -150.1f); }
        }
        if (lane == 0) ((LAS unsigned*)(lds + AT_FLAG))[cur * 8 + wid] = wdone ? 1u : 0u;
        asm volatile("s_waitcnt vmcnt(0)" ::: "memory");
        __syncthreads();
        {
            const LAS unsigned* fl = (const LAS unsigned*)(lds + AT_FLAG) + cur * 8;
            unsigned all = 1u;
#pragma unroll
            for (int w = 0; w < 8; ++w) all &= fl[w];
            if (all) break;
        }
    }
    float inv = 1.f;
    if (MODE == 0) { const float lt = l + __shfl_xor(l, 32); inv = 1.f / lt; }
    bf16* yp = Y + rowq * DM + h * 128 + 4 * hi;
#pragma unroll
    for (int dt = 0; dt < 4; ++dt)
#pragma unroll
        for (int g = 0; g < 4; ++g) { u32x2 w; w.x = pk_bf16(o[dt][4 * g] * inv, o[dt][4 * g + 1] * inv); w.y = pk_bf16(o[dt][4 * g + 2] * inv, o[dt][4 * g + 3] * inv);
            *(u32x2*)(yp + 32 * dt + 8 * g) = w; }
    __syncthreads();
}

template <int MODE>
__device__ __forceinline__ void attn_phase(LAS unsigned char* lds, const bf16* QK, const bf16* VT, const float* cum, const float* KN, bf16* Y, unsigned* counter) {
    LAS unsigned* slot = (LAS unsigned*)(lds + AT_PM + 512);
#pragma unroll 1
    for (;;) {
        if (threadIdx.x == 0) *slot = __hip_atomic_fetch_add(counter, 1u, __ATOMIC_RELAXED, __HIP_MEMORY_SCOPE_AGENT);
        __syncthreads();
        const unsigned u = *slot;
        __syncthreads();
        if (u >= 1024u) break;
        const int bh = u & 31, qb = 31 - (int)(u >> 5);
        attn_unit<MODE>(lds, QK, VT, cum, KN, Y, bh >> 4, bh & 15, qb);
    }
}

constexpr int L2_WT = 0, L2_U = 118272, L2_XCH = L2_U + 21504, L2_CAR = L2_XCH + 5632, L2_CW = L2_CAR + 2816, L2_CH = L2_CW + 3360, L2_END = L2_CH + 2112;
static_assert(L2_END <= LDSCTL_OFF, "LRU v2 LDS map");
constexpr size_t LRU_SEG = (size_t)2 * 8 * LRU_W;

__device__ __forceinline__ void lru_wgt_prep(const float* w_r, const float* w_i, bf16* WGT, int gtid, int nthr) {
    for (int i = gtid; i < 16 * 352 * LRU_BD; i += nthr) { const int d = i % LRU_BD, e = (i / LRU_BD) % 352, n = i / (LRU_BD * 352); float v = 0.f;
        if (e < 168) v = w_r[((size_t)n * LRU_BD + d) * LRU_BD + e]; else if (e >= 176 && e < 344) v = w_i[((size_t)n * LRU_BD + d) * LRU_BD + (e - 176)];
        WGT[i] = f2bf16(v); }
}
__device__ __forceinline__ void lru_carry(float* SEG, int gtid, int nthr) {
    for (int i = gtid; i < 2 * LRU_W; i += nthr) { const int b = i / LRU_W, ch = i % LRU_W; float carry = 0.f;
#pragma unroll
        for (int sg = 0; sg < 8; ++sg) { const size_t o = ((size_t)b * 8 + sg) * LRU_W + ch; SEG[2 * LRU_SEG + o] = carry; carry = SEG[o] * carry + SEG[LRU_SEG + o]; } }
}
__device__ __forceinline__ float expm1_neg(float x) { const float p = x * (1.f + x * (0.5f + x * (1.f / 6.f))), e = __expf(x) - 1.f; return (x > -0.02f) ? p : e; }
__device__ __forceinline__ float fast_rcp(float x) { return __builtin_amdgcn_rcpf(x); }
__device__ __forceinline__ float fast_gelu_tanh(float x) { const float u2 = (-2.f * 0.7978845608028654f * 1.4426950408889634f) * x * (1.f + 0.044715f * x * x); return x * fast_rcp(1.f + __builtin_amdgcn_exp2f(u2)); }

template <int PASS>
__device__ __forceinline__ void lru2_pass(LAS unsigned char* lds, const bf16* PROJ, const bf16* WGT, const float* conv_w, const float* conv_b, const float* b_r, const float* b_i,
                                          const float* lam, float* SEG, bf16* YB, v4u* AB, int wg, int nwg) {
    const int tid = threadIdx.x, lane = tid & 63, wid = __builtin_amdgcn_readfirstlane(tid >> 6), fr = lane & 15, fq = lane >> 4, rt = wid & 3, half = wid >> 2;
    LAS float* XCH = (LAS float*)(lds + L2_XCH);
    LAS float* CAR = (LAS float*)(lds + L2_CAR);
#pragma unroll 1
    for (int unit = wg; unit < 256; unit += nwg) {
        const int n = unit & 15, b = (unit >> 4) >> 3, seg = (unit >> 4) & 7;
        __syncthreads();
        { const v4u* src = (const v4u*)(WGT + (size_t)n * 352 * LRU_BD);
          for (int i = tid; i < 118272 / 16; i += 512) *(LAS v4u*)(lds + L2_WT + i * 16) = src[i]; }
        const int ch8 = tid % 21, rg = tid / 21;
        LAS float* CWL = (LAS float*)(lds + L2_CW);
        LAS float* CHL = (LAS float*)(lds + L2_CH);
        for (int i = tid; i < 5 * LRU_BD; i += 512) { const int j = i / LRU_BD, d = i % LRU_BD; CWL[i] = (j < 4) ? conv_w[(size_t)j * LRU_W + n * LRU_BD + d] : conv_b[n * LRU_BD + d]; }
        if (tid < 176) { const bool ok = tid < LRU_BD; const int gi = n * LRU_BD + (ok ? tid : 0); CHL[tid] = b_r[gi]; CHL[176 + tid] = b_i[gi]; CHL[352 + tid] = 8.f * 1.4426950408889634f * log_sigmoid_f(lam[gi]); }
        if (tid < 176) { float cin = 0.f;
            if (PASS == 3 && tid < LRU_BD) { for (int sg = 0; sg < seg; ++sg) { const size_t o = ((size_t)b * 8 + sg) * LRU_W + n * LRU_BD + tid; cin = SEG[o] * cin + SEG[LRU_SEG + o]; } }
            CAR[tid] = 1.f; CAR[176 + tid] = cin; }
        const bf16* ubase = PROJ + ((size_t)b * SEQ) * 5376 + LRU_W + n * LRU_BD + ch8 * 8;
        const bf16* gbase = PROJ + ((size_t)b * SEQ) * 5376 + n * LRU_BD;
        v4u raw[7];
#define L2_LOAD(t0_) do { _Pragma("unroll") for (int j_ = 0; j_ < 7; ++j_) { const int tt_ = (t0_) + 4 * rg - 3 + j_; \
            raw[j_] = (v4u){0u, 0u, 0u, 0u}; if (tid < 336 && tt_ >= 0) raw[j_] = *(const v4u*)(ubase + (size_t)tt_ * 5376); } } while (0)
        L2_LOAD(seg * 1024);
        __syncthreads();
#pragma unroll 1
        for (int st = 0; st < 16; ++st) {
            const int t0 = seg * 1024 + st * 64, par = st & 1;
            if (tid < 336) {
                f32x4 cwv[5][2];
#pragma unroll
                for (int j = 0; j < 5; ++j) { cwv[j][0] = *(const LAS f32x4*)(CWL + j * LRU_BD + ch8 * 8); cwv[j][1] = *(const LAS f32x4*)(CWL + j * LRU_BD + ch8 * 8 + 4); }
#pragma unroll
                for (int it = 0; it < 4; ++it) { float acc[8];
#pragma unroll
                    for (int e = 0; e < 8; ++e) acc[e] = cwv[4][e >> 2][e & 3];
#pragma unroll
                    for (int j = 0; j < 4; ++j) { const v4u rv = raw[it + j];
                        acc[0] += cwv[j][0][0] * bflo(rv.x); acc[1] += cwv[j][0][1] * bfhi(rv.x); acc[2] += cwv[j][0][2] * bflo(rv.y); acc[3] += cwv[j][0][3] * bfhi(rv.y);
                        acc[4] += cwv[j][1][0] * bflo(rv.z); acc[5] += cwv[j][1][1] * bfhi(rv.z); acc[6] += cwv[j][1][2] * bflo(rv.w); acc[7] += cwv[j][1][3] * bfhi(rv.w); }
                    v4u o; o.x = pk_bf16(acc[0], acc[1]); o.y = pk_bf16(acc[2], acc[3]); o.z = pk_bf16(acc[4], acc[5]); o.w = pk_bf16(acc[6], acc[7]);
                    *(LAS v4u*)(lds + L2_U + (4 * rg + it) * 336 + ch8 * 16) = o; } }
            if (st + 1 < 16) L2_LOAD(t0 + 64);
            __syncthreads();
            bf16x8 af[6];
#pragma unroll
            for (int ks = 0; ks < 6; ++ks) { v4u w = *(const LAS v4u*)(lds + L2_U + (16 * rt + fr) * 336 + ks * 64 + (ks < 5 ? fq * 16 : 0));
                if (ks == 5 && fq != 0) w = (v4u){0u, 0u, 0u, 0u}; af[ks] = __builtin_bit_cast(bf16x8, w); }
            float av[6][4], bv[6][4], Aex[6], Bex[6];
#pragma unroll
            for (int k = 0; k < 6; ++k) {
                const int ct = 6 * half + k; const int ch = 16 * ct + fr;
                f32x4 racc = (f32x4){0.f, 0.f, 0.f, 0.f}, iacc = (f32x4){0.f, 0.f, 0.f, 0.f};
                if (ct < 11) {
#pragma unroll
                    for (int ks = 0; ks < 6; ++ks) {
                        v4u wr = *(const LAS v4u*)(lds + L2_WT + (16 * ct + fr) * 336 + ks * 64 + (ks < 5 ? fq * 16 : 0));
                        v4u wi = *(const LAS v4u*)(lds + L2_WT + (176 + 16 * ct + fr) * 336 + ks * 64 + (ks < 5 ? fq * 16 : 0));
                        if (ks == 5 && fq != 0) { wr = (v4u){0u, 0u, 0u, 0u}; wi = (v4u){0u, 0u, 0u, 0u}; }
                        racc = MFMA16(af[ks], __builtin_bit_cast(bf16x8, wr), racc); iacc = MFMA16(af[ks], __builtin_bit_cast(bf16x8, wi), iacc); }
                }
                const int chs = (ch < LRU_BD) ? ch : 0; const int chc = (ch < 176) ? ch : 0; const float cbr = CHL[chc], cbi = CHL[176 + chc], cls = CHL[352 + chc];
                float A4 = 1.f, B4 = 0.f; float la2[4], bq[4];
#pragma unroll
                for (int r = 0; r < 4; ++r) { const float uu = bf2f(*(const LAS bf16*)(lds + L2_U + (16 * rt + 4 * fq + r) * 336 + chs * 2));
                    const float rgt = fast_rcp(1.f + __builtin_amdgcn_exp2f(-1.4426950408889634f * (racc[r] + cbr))), ig = fast_rcp(1.f + __builtin_amdgcn_exp2f(-1.4426950408889634f * (iacc[r] + cbi)));
                    la2[r] = rgt * cls; bq[r] = ig * uu; }
                v4u pkd; pkd.x = pk_bf16(la2[0], la2[1]); pkd.y = pk_bf16(la2[2], la2[3]);
                const float lr[4] = {bflo(pkd.x), bfhi(pkd.x), bflo(pkd.y), bfhi(pkd.y)}; float bbv[4];
#pragma unroll
                for (int r = 0; r < 4; ++r) { const float a = __builtin_amdgcn_exp2f(lr[r]); av[k][r] = a; bbv[r] = __builtin_amdgcn_sqrtf(fmaxf(1.f - a * a, 0.f)) * bq[r]; }
                pkd.z = pk_bf16(bbv[0], bbv[1]); pkd.w = pk_bf16(bbv[2], bbv[3]);
                const float br[4] = {bflo(pkd.z), bfhi(pkd.z), bflo(pkd.w), bfhi(pkd.w)};
#pragma unroll
                for (int r = 0; r < 4; ++r) { bv[k][r] = br[r]; B4 = av[k][r] * B4 + br[r]; A4 = av[k][r] * A4; }
                if (PASS == 1 && ct < 11) AB[((((size_t)unit * 16 + st) * 8 + wid) * 6 + k) * 64 + lane] = pkd;
#pragma unroll
                for (int off = 16; off < 64; off <<= 1) { const float Ap = __shfl_up(A4, off), Bp = __shfl_up(B4, off); if (lane >= off) { B4 = A4 * Bp + B4; A4 = A4 * Ap; } }
                float ae = __shfl_up(A4, 16), be = __shfl_up(B4, 16); if (fq == 0) { ae = 1.f; be = 0.f; }
                Aex[k] = ae; Bex[k] = be;
                if (fq == 3 && ct < 11) { XCH[(rt * 176 + ch) * 2] = A4; XCH[(rt * 176 + ch) * 2 + 1] = B4; }
            }
            __syncthreads();
            v4u greg[3];
            if (PASS == 3) {
#pragma unroll
                for (int k = 0; k < 3; ++k) { const int c3 = tid + 512 * k; greg[k] = (v4u){0u, 0u, 0u, 0u}; if (c3 < 64 * 21) greg[k] = *(const v4u*)(gbase + (size_t)(t0 + c3 / 21) * 5376 + (c3 % 21) * 8); } }
#pragma unroll
            for (int k = 0; k < 6; ++k) {
                const int ct = 6 * half + k; const int ch = 16 * ct + fr;
                if (ct < 11) {
                    float hin = CAR[par * 352 + 176 + ch], ain = CAR[par * 352 + ch];
#pragma unroll
                    for (int q = 0; q < 3; ++q) if (q < rt) { const float a2 = XCH[(q * 176 + ch) * 2], b2 = XCH[(q * 176 + ch) * 2 + 1]; hin = a2 * hin + b2; ain *= a2; }
                    if (PASS == 3) {
                        float hh = Aex[k] * hin + Bex[k];
#pragma unroll
                        for (int r = 0; r < 4; ++r) { hh = av[k][r] * hh + bv[k][r]; if (ch < LRU_BD) *(LAS bf16*)(lds + L2_U + (16 * rt + 4 * fq + r) * 336 + ch * 2) = f2bf16(hh); }
                        if (rt == 3 && fq == 3) CAR[(par ^ 1) * 352 + 176 + ch] = hh;
                    } else {
                        if (rt == 3 && fq == 3) { const float a3 = XCH[(3 * 176 + ch) * 2], b3 = XCH[(3 * 176 + ch) * 2 + 1];
                            CAR[(par ^ 1) * 352 + 176 + ch] = a3 * hin + b3; CAR[(par ^ 1) * 352 + ch] = ain * a3; }
                    }
                }
            }
            __syncthreads();
            if (PASS == 3) {
#pragma unroll
                for (int k = 0; k < 3; ++k) { const int c3 = tid + 512 * k;
                    if (c3 < 64 * 21) { const int t = c3 / 21, cc = c3 % 21; const v4u hv = *(const LAS v4u*)(lds + L2_U + t * 336 + cc * 16); const v4u gv = greg[k];
                        v4u o; o.x = pk_bf16(bflo(hv.x) * fast_gelu_tanh(bflo(gv.x)), bfhi(hv.x) * fast_gelu_tanh(bfhi(gv.x))); o.y = pk_bf16(bflo(hv.y) * fast_gelu_tanh(bflo(gv.y)), bfhi(hv.y) * fast_gelu_tanh(bfhi(gv.y)));
                        o.z = pk_bf16(bflo(hv.z) * fast_gelu_tanh(bflo(gv.z)), bfhi(hv.z) * fast_gelu_tanh(bfhi(gv.z))); o.w = pk_bf16(bflo(hv.w) * fast_gelu_tanh(bflo(gv.w)), bfhi(hv.w) * fast_gelu_tanh(bfhi(gv.w)));
                        *(v4u*)(YB + ((size_t)b * SEQ + t0 + t) * LRU_W + n * LRU_BD + cc * 8) = o; } }
                __syncthreads();
            }
        }
#undef L2_LOAD
        if (PASS == 1 && tid < LRU_BD) { const size_t o = ((size_t)b * 8 + seg) * LRU_W + n * LRU_BD + tid; SEG[o] = CAR[tid]; SEG[LRU_SEG + o] = CAR[176 + tid]; }
    }
}

__device__ __forceinline__ void lru3_pass(LAS unsigned char* lds, const bf16* PROJ, const float* SEG, bf16* YB, const v4u* AB, int wg, int nwg) {
    const int tid = threadIdx.x, lane = tid & 63, wid = __builtin_amdgcn_readfirstlane(tid >> 6), fr = lane & 15, fq = lane >> 4, rt = wid & 3, half = wid >> 2;
    LAS float* XCH = (LAS float*)(lds + L2_XCH);
    LAS float* CAR = (LAS float*)(lds + L2_CAR);
#pragma unroll 1
    for (int unit = wg; unit < 256; unit += nwg) {
        const int n = unit & 15, b = (unit >> 4) >> 3, seg = (unit >> 4) & 7;
        __syncthreads();
        if (tid < 176) { float cin = 0.f;
            if (tid < LRU_BD) { for (int sg = 0; sg < seg; ++sg) { const size_t o = ((size_t)b * 8 + sg) * LRU_W + n * LRU_BD + tid; cin = SEG[o] * cin + SEG[LRU_SEG + o]; } }
            CAR[tid] = cin; }
        const bf16* gbase = PROJ + ((size_t)b * SEQ) * 5376 + n * LRU_BD;
        const v4u* abase = AB + (((size_t)unit * 16) * 8 + wid) * 6 * 64 + lane;
        v4u abr[6];
#pragma unroll
        for (int k = 0; k < 6; ++k) abr[k] = (6 * half + k < 11) ? abase[k * 64] : (v4u){0u, 0u, 0u, 0u};
        __syncthreads();
#pragma unroll 1
        for (int st = 0; st < 16; ++st) {
            const int t0 = seg * 1024 + st * 64, par = st & 1;
            v4u greg[3];
#pragma unroll
            for (int k = 0; k < 3; ++k) { const int c3 = tid + 512 * k; greg[k] = (v4u){0u, 0u, 0u, 0u}; if (c3 < 64 * 21) greg[k] = *(const v4u*)(gbase + (size_t)(t0 + c3 / 21) * 5376 + (c3 % 21) * 8); }
            float av[6][4], bv[6][4], Aex[6], Bex[6];
#pragma unroll
            for (int k = 0; k < 6; ++k) { const int ct = 6 * half + k; const int ch = 16 * ct + fr; const v4u w = abr[k];
                const float lr[4] = {bflo(w.x), bfhi(w.x), bflo(w.y), bfhi(w.y)}, br[4] = {bflo(w.z), bfhi(w.z), bflo(w.w), bfhi(w.w)};
                float A4 = 1.f, B4 = 0.f;
#pragma unroll
                for (int r = 0; r < 4; ++r) { const float a = __builtin_amdgcn_exp2f(lr[r]); av[k][r] = a; bv[k][r] = br[r]; B4 = a * B4 + br[r]; A4 = a * A4; }
#pragma unroll
                for (int off = 16; off < 64; off <<= 1) { const float Ap = __shfl_up(A4, off), Bp = __shfl_up(B4, off); if (lane >= off) { B4 = A4 * Bp + B4; A4 = A4 * Ap; } }
                float ae = __shfl_up(A4, 16), be = __shfl_up(B4, 16); if (fq == 0) { ae = 1.f; be = 0.f; }
                Aex[k] = ae; Bex[k] = be;
                if (fq == 3 && ct < 11) { XCH[(rt * 176 + ch) * 2] = A4; XCH[(rt * 176 + ch) * 2 + 1] = B4; } }
            if (st + 1 < 16) {
#pragma unroll
                for (int k = 0; k < 6; ++k) abr[k] = (6 * half + k < 11) ? abase[(size_t)(st + 1) * 8 * 6 * 64 + k * 64] : (v4u){0u, 0u, 0u, 0u}; }
            __syncthreads();
#pragma unroll
            for (int k = 0; k < 6; ++k) { const int ct = 6 * half + k; const int ch = 16 * ct + fr;
                if (ct < 11) {
                    float hin = CAR[par * 176 + ch];
#pragma unroll
                    for (int q = 0; q < 3; ++q) if (q < rt) { const float a2 = XCH[(q * 176 + ch) * 2], b2 = XCH[(q * 176 + ch) * 2 + 1]; hin = a2 * hin + b2; }
                    float hh = Aex[k] * hin + Bex[k];
#pragma unroll
                    for (int r = 0; r < 4; ++r) { hh = av[k][r] * hh + bv[k][r]; if (ch < LRU_BD) *(LAS bf16*)(lds + L2_U + (16 * rt + 4 * fq + r) * 336 + ch * 2) = f2bf16(hh); }
                    if (rt == 3 && fq == 3) CAR[(par ^ 1) * 176 + ch] = hh;
                } }
            __syncthreads();
#pragma unroll
            for (int k = 0; k < 3; ++k) { const int c3 = tid + 512 * k;
                if (c3 < 64 * 21) { const int t = c3 / 21, cc = c3 % 21; const v4u hv = *(const LAS v4u*)(lds + L2_U + t * 336 + cc * 16); const v4u gv = greg[k];
                    v4u o; o.x = pk_bf16(bflo(hv.x) * fast_gelu_tanh(bflo(gv.x)), bfhi(hv.x) * fast_gelu_tanh(bfhi(gv.x))); o.y = pk_bf16(bflo(hv.y) * fast_gelu_tanh(bflo(gv.y)), bfhi(hv.y) * fast_gelu_tanh(bfhi(gv.y)));
                    o.z = pk_bf16(bflo(hv.z) * fast_gelu_tanh(bflo(gv.z)), bfhi(hv.z) * fast_gelu_tanh(bfhi(gv.z))); o.w = pk_bf16(bflo(hv.w) * fast_gelu_tanh(bflo(gv.w)), bfhi(hv.w) * fast_gelu_tanh(bfhi(gv.w)));
                    *(v4u*)(YB + ((size_t)b * SEQ + t0 + t) * LRU_W + n * LRU_BD + cc * 8) = o; } }
        }
    }
}

constexpr size_t ML_ARR = (size_t)8 * SEQ;
__device__ __forceinline__ void mlstm_pre(LAS unsigned char* lds, const float* G, const float* bif, float* MLS, int wg, int nwg) {
    const int tid = threadIdx.x, lane = tid & 63, wid = tid >> 6;
    LAS float* GG = (LAS float*)lds; LAS float* PP = GG + 128; LAS float* MP = PP + 128;
    float* ALPHA = MLS; float* BETA = MLS + ML_ARR; float* WI = MLS + 2 * ML_ARR; float* EMv = MLS + 3 * ML_ARR; float* WK = MLS + 4 * ML_ARR; float* DEC = MLS + 5 * ML_ARR;
    for (int u = wg; u < 8; u += nwg) {
        const int b = u >> 2, h = u & 3; const float bi = bif[h], bfg = bif[4 + h];
        float btv[16], bev[16], Pv[16];
#pragma unroll
        for (int i = 0; i < 16; ++i) { const size_t row = (size_t)b * SEQ + (wid * 16 + i) * 64 + lane; bev[i] = G[row * 16 + h] + bi; btv[i] = G[row * 16 + 4 + h] + bfg; }
        __syncthreads();
#pragma unroll
        for (int i = 0; i < 16; ++i) {
            float bt = log_sigmoid_f(btv[i]);
#pragma unroll
            for (int o = 1; o < 64; o <<= 1) { const float v = __shfl_up(bt, o); if (lane >= o) bt += v; }
            const float beta = bev[i] - bt; float P = beta;
#pragma unroll
            for (int o = 1; o < 64; o <<= 1) { const float v = __shfl_up(P, o); if (lane >= o) P = fmaxf(P, v); }
            btv[i] = bt; bev[i] = beta; Pv[i] = P;
            if (lane == 63) { GG[wid * 16 + i] = bt; PP[wid * 16 + i] = P; }
        }
        __syncthreads();
        if (tid == 0) { float m = -1e30f; for (int c = 0; c < 128; ++c) { MP[c] = m; m = GG[c] + fmaxf(m, PP[c]); } }
        __syncthreads();
#pragma unroll
        for (int i = 0; i < 16; ++i) { const int c = wid * 16 + i; const float m_prev = MP[c], g = GG[c], P63 = PP[c];
            const float bt = btv[i], beta = bev[i], mt = bt + fmaxf(m_prev, Pv[i]), m_new = g + fmaxf(m_prev, P63);
            const size_t o = (size_t)u * SEQ + c * 64 + lane;
            ALPHA[o] = bt - mt; BETA[o] = beta; WI[o] = expf(bt + m_prev - mt); EMv[o] = expf(-mt); { const float wkv = expf(g - m_new + beta) * 0.0625f; WK[o] = wkv; ((bf16*)(MLS + 6 * ML_ARR))[o] = f2bf16(wkv); }
            if (lane == 0) DEC[u * 128 + c] = expf(g + m_prev - m_new); }
    }
}

__device__ __forceinline__ void mlstm_post(const bf16* HB, const bf16* PROJ, const float* head_g, bf16* YB, int gw, int ngw, int lane) {
    for (int it = gw; it < MTOK * 4; it += ngw) {
        const int row = it >> 2, hh = it & 3;
        const v4u hv = *(const v4u*)(HB + (size_t)row * DM + hh * 512 + lane * 8);
        const v4u ov = *(const v4u*)(PROJ + (size_t)row * 4096 + 2048 + hh * 512 + lane * 8);
        float hf[8] = {bflo(hv.x), bfhi(hv.x), bflo(hv.y), bfhi(hv.y), bflo(hv.z), bfhi(hv.z), bflo(hv.w), bfhi(hv.w)};
        const float of[8] = {bflo(ov.x), bfhi(ov.x), bflo(ov.y), bfhi(ov.y), bflo(ov.z), bfhi(ov.z), bflo(ov.w), bfhi(ov.w)};
        float ss = 0.f;
#pragma unroll
        for (int e = 0; e < 8; ++e) ss += hf[e] * hf[e];
        const float r = rsqrtf(wave_sum(ss) * (1.f / 512.f) + EPS);
        const f32x4 g0 = *(const f32x4*)(head_g + hh * 512 + lane * 8), g1 = *(const f32x4*)(head_g + hh * 512 + lane * 8 + 4);
        const float gg[8] = {g0.x, g0.y, g0.z, g0.w, g1.x, g1.y, g1.z, g1.w};
#pragma unroll
        for (int e = 0; e < 8; ++e) hf[e] = sigmoid_f(of[e]) * (hf[e] * r * gg[e]);
        v4u w; w.x = pk_bf16(hf[0], hf[1]); w.y = pk_bf16(hf[2], hf[3]); w.z = pk_bf16(hf[4], hf[5]); w.w = pk_bf16(hf[6], hf[7]);
        *(v4u*)(YB + (size_t)row * DM + hh * 512 + lane * 8) = w;
    }
}

constexpr int MI_QT = 0, MI_KK = 33792, MI_VT = 67584, MI_ST = MI_VT + 528 * 144, MI_SC = MI_ST + 9216, MI_END = MI_SC + 512;
static_assert(MI_END <= LDSCTL_OFF, "mLSTM intra LDS map");
__device__ __forceinline__ void mlstm_intra(LAS unsigned char* lds, const bf16* PROJ, const bf16* VTM, const float* MLS, bf16* NUMI, bf16* KT, int wg, int nwg) {
    const int tid = threadIdx.x, lane = tid & 63, wid = __builtin_amdgcn_readfirstlane(tid >> 6), fr = lane & 15, fq = lane >> 4;
    LAS float* SC = (LAS float*)(lds + MI_SC);
    __syncthreads();
    for (int i = tid; i < 16 * 72; i += 512) { const int r = 512 + i / 72, c = i % 72; *(LAS bf16*)(lds + MI_VT + r * 144 + c * 2) = (r == 512) ? (bf16)0x3F80 : (bf16)0; }
#pragma unroll 1
    for (int u = wg; u < 1024; u += nwg) {
        const int bh = u >> 7, c = u & 127, b = bh >> 2, h = bh & 3, t0 = c * 64;
        const bf16* qbase = PROJ + ((size_t)b * SEQ + t0) * 4096 + h * 256;
        const bf16* vbase = VTM + ((size_t)h * 512) * MTOK + (size_t)b * SEQ + t0;
#pragma unroll
        for (int i = 0; i < 4; ++i) { const int cc = tid + 512 * i; const int row = cc >> 5, ch = cc & 31;
            const v4u qv = *(const v4u*)(qbase + (size_t)row * 4096 + ch * 8), kv = *(const v4u*)(qbase + 1024 + (size_t)row * 4096 + ch * 8);
            *(LAS v4u*)(lds + MI_QT + row * 528 + ch * 16) = qv; *(LAS v4u*)(lds + MI_KK + row * 528 + ch * 16) = kv; }
#pragma unroll
        for (int i = 0; i < 8; ++i) { const int cc = tid + 512 * i; const int e = cc >> 3, ch = cc & 7;
            *(LAS v4u*)(lds + MI_VT + e * 144 + ch * 16) = *(const v4u*)(vbase + (size_t)e * MTOK + ch * 8); }
        if (tid < 128) SC[tid] = MLS[(size_t)(tid >> 6) * ML_ARR + (size_t)bh * SEQ + t0 + (tid & 63)];
        __syncthreads();
#pragma unroll
        for (int i = 0; i < 4; ++i) { const int item = tid + 512 * i; const int sg = item & 7, d = item >> 3; unsigned short e[8];
#pragma unroll
            for (int q = 0; q < 8; ++q) e[q] = *(const LAS bf16*)(lds + MI_KK + (8 * sg + q) * 528 + d * 2);
            v4u o; o.x = (unsigned)e[0] | ((unsigned)e[1] << 16); o.y = (unsigned)e[2] | ((unsigned)e[3] << 16); o.z = (unsigned)e[4] | ((unsigned)e[5] << 16); o.w = (unsigned)e[6] | ((unsigned)e[7] << 16);
            *(v4u*)(KT + ((size_t)h * 256 + d) * MTOK + (size_t)b * SEQ + t0 + 8 * sg) = o; }
        { const int tt = wid >> 1;
#pragma unroll
          for (int si = 0; si < 2; ++si) { const int stl = 2 * (wid & 1) + si;
              u32x2 w = (u32x2){0u, 0u};
              if (stl <= tt) {
                  f32x4 acc = (f32x4){0.f, 0.f, 0.f, 0.f};
#pragma unroll
                  for (int ks = 0; ks < 8; ++ks) { const bf16x8 af = *(const LAS bf16x8*)(lds + MI_KK + (16 * stl + fr) * 528 + ks * 64 + fq * 16);
                      const bf16x8 bfr = *(const LAS bf16x8*)(lds + MI_QT + (16 * tt + fr) * 528 + ks * 64 + fq * 16); acc = MFMA16(af, bfr, acc); }
                  const int t = 16 * tt + fr; const float al = SC[t]; const f32x4 be = *(const LAS f32x4*)(SC + 64 + 16 * stl + 4 * fq);
                  float sv[4];
#pragma unroll
                  for (int r = 0; r < 4; ++r) { const int s = 16 * stl + 4 * fq + r; sv[r] = (s <= t) ? acc[r] * 0.0625f * __expf(al + be[r]) : 0.f; }
                  w.x = pk_bf16(sv[0], sv[1]); w.y = pk_bf16(sv[2], sv[3]);
              }
              *(LAS u32x2*)(lds + MI_ST + (16 * tt + fr) * 144 + (16 * stl + 4 * fq) * 2) = w; } }
        __syncthreads();
        { const int tt = wid >> 1;
          const bf16x8 b0 = *(const LAS bf16x8*)(lds + MI_ST + (16 * tt + fr) * 144 + fq * 16), b1 = *(const LAS bf16x8*)(lds + MI_ST + (16 * tt + fr) * 144 + 64 + fq * 16);
          bf16* op = NUMI + (((size_t)b * SEQ + t0 + 16 * tt + fr) * 4 + h) * 528 + 4 * fq;
#pragma unroll 3
          for (int et = (wid & 1); et < 33; et += 2) {
              const bf16x8 a0 = *(const LAS bf16x8*)(lds + MI_VT + (16 * et + fr) * 144 + fq * 16), a1 = *(const LAS bf16x8*)(lds + MI_VT + (16 * et + fr) * 144 + 64 + fq * 16);
              f32x4 acc = (f32x4){0.f, 0.f, 0.f, 0.f};
              acc = MFMA16(a0, b0, acc); acc = MFMA16(a1, b1, acc);
              u32x2 w; w.x = pk_bf16(acc[0], acc[1]); w.y = pk_bf16(acc[2], acc[3]);
              *(u32x2*)(op + 16 * et) = w; } }
        __syncthreads();
    }
}

constexpr int M2_QT = 0, M2_KT = 33792, M2_CET = M2_KT + 36864, M2_VEW = M2_CET + 2 * 33792, M2_NST = M2_VEW + 9216, M2_SC = M2_NST + 2048, M2_END = M2_SC + 1024;
static_assert(M2_END <= LDSCTL_OFF, "mLSTM inter LDS map");
constexpr size_t ML_CS_FLOATS = (size_t)8 * 4 * 256 * 512, ML_NS_FLOATS = (size_t)8 * 4 * 256;
template <int PASS>
__device__ __forceinline__ void mlstm_walk(LAS unsigned char* lds, const bf16* PROJ, const bf16* KT, const bf16* VTM, const float* MLS, const bf16* NUMI, float* CLOC, float* CSt, float* NLOC, float* NSt, bf16* HB, int wg, int nwg) {
    const int tid = threadIdx.x, lane = tid & 63, wid = __builtin_amdgcn_readfirstlane(tid >> 6), fr = lane & 15, fq = lane >> 4;
    const float* DEC = MLS + 5 * ML_ARR;
    LAS float* SC = (LAS float*)(lds + M2_SC);
#pragma unroll 1
    for (int unit = wg; unit < 256; unit += nwg) {
        const int bh = unit >> 5, sl = (unit >> 2) & 7, seg = unit & 3, b = bh >> 2, h = bh & 3, e0 = sl * 64, c_lo = seg * 32;
        __syncthreads();
        f32x4 cst[2][4];
        const size_t csoff = (((size_t)bh * 4 + seg) * 256) * 512;
        if (PASS == 3) {
            float dsg[3];
#pragma unroll
            for (int sg = 0; sg < 3; ++sg) { float p = 1.f;
#pragma unroll 1
                for (int c = 0; c < 32; ++c) p *= ld_agent_f32(DEC + bh * 128 + sg * 32 + c);
                dsg[sg] = p; }
#pragma unroll
            for (int i = 0; i < 2; ++i)
#pragma unroll
                for (int j = 0; j < 4; ++j)
#pragma unroll
                    for (int r = 0; r < 4; ++r) { float st = 0.f;
#pragma unroll
                        for (int sg = 0; sg < 3; ++sg) if (sg < seg) st = st * dsg[sg] + CLOC[(((size_t)bh * 4 + sg) * 256 + 16 * (2 * wid + i) + 4 * fq + r) * 512 + e0 + 16 * j + fr];
                        cst[i][j][r] = st; }
            if (tid < 256) { float st = 0.f;
#pragma unroll
                for (int sg = 0; sg < 3; ++sg) if (sg < seg) st = st * dsg[sg] + NLOC[((size_t)bh * 4 + sg) * 256 + tid];
                ((LAS float*)(lds + M2_NST))[tid] = st; }
#pragma unroll
            for (int i = 0; i < 2; ++i)
#pragma unroll
                for (int j = 0; j < 4; ++j) { u32x2 w; w.x = pk_bf16(cst[i][j][0], cst[i][j][1]); w.y = pk_bf16(cst[i][j][2], cst[i][j][3]);
                    *(LAS u32x2*)(lds + M2_CET + (16 * j + fr) * 528 + (16 * (2 * wid + i) + 4 * fq) * 2) = w; }
        } else {
#pragma unroll
            for (int i = 0; i < 2; ++i)
#pragma unroll
                for (int j = 0; j < 4; ++j) cst[i][j] = (f32x4){0.f, 0.f, 0.f, 0.f};
            if (tid < 256) ((LAS float*)(lds + M2_NST))[tid] = 0.f;
        }
        const bf16* qbase = PROJ + ((size_t)b * SEQ) * 4096 + h * 256;
        const bf16* ktbase = KT + ((size_t)h * 256) * MTOK + (size_t)b * SEQ;
        const bf16* vbase = VTM + ((size_t)h * 512 + e0) * MTOK + (size_t)b * SEQ;
        const size_t sbase = (size_t)bh * SEQ;
        const int tt = wid >> 1, eh = wid & 1;
        const bf16* nbase = NUMI + (((size_t)b * SEQ + 16 * tt + fr) * 4 + h) * 528;
        v4u qreg[4], ktreg[4], vreg, wkb; float screg = 0.f; u32x2 nreg[2]; unsigned short dreg = 0;
#define M2_LOAD(t0_) do { _Pragma("unroll") for (int i_ = 0; i_ < 4; ++i_) { const int c_ = tid + 512 * i_; const int row_ = c_ >> 5, ch_ = c_ & 31; \
            if (PASS == 3) qreg[i_] = *(const v4u*)(qbase + (size_t)((t0_) + row_) * 4096 + ch_ * 8); \
            const int d_ = c_ >> 3, kc_ = c_ & 7; ktreg[i_] = *(const v4u*)(ktbase + (size_t)d_ * MTOK + (t0_) + kc_ * 8); } \
        { const int e_ = tid >> 3, ch_ = tid & 7; vreg = *(const v4u*)(vbase + (size_t)e_ * MTOK + (t0_) + ch_ * 8); \
            wkb = *(const v4u*)((const bf16*)(MLS + 6 * ML_ARR) + sbase + (t0_) + ch_ * 8); } \
        if (tid < 192) { const int a_ = 2 + (tid >> 6), s_ = tid & 63; screg = MLS[(size_t)a_ * ML_ARR + sbase + (t0_) + s_]; } \
        if (PASS == 3) { _Pragma("unroll") for (int jj_ = 0; jj_ < 2; ++jj_) nreg[jj_] = *(const u32x2*)(nbase + (size_t)(t0_) * 4 * 528 + e0 + 16 * (2 * eh + jj_) + 4 * fq); dreg = nbase[(size_t)(t0_) * 4 * 528 + 512]; } } while (0)
        M2_LOAD(c_lo * 64);
#pragma unroll 1
        for (int c = c_lo; c < c_lo + 32; ++c) {
            const int t0 = c * 64, par = c & 1;
            const LAS unsigned char* cet_rd = lds + M2_CET + par * 33792; LAS unsigned char* cet_wr = lds + M2_CET + (par ^ 1) * 33792;
            const LAS float* nst_rd = (const LAS float*)(lds + M2_NST) + par * 256; LAS float* nst_wr = (LAS float*)(lds + M2_NST) + (par ^ 1) * 256;
#pragma unroll
            for (int i = 0; i < 4; ++i) { const int cc = tid + 512 * i; const int row = cc >> 5, ch = cc & 31;
                if (PASS == 3) *(LAS v4u*)(lds + M2_QT + row * 528 + ch * 16) = qreg[i];
                const int d = cc >> 3, kc = cc & 7; *(LAS v4u*)(lds + M2_KT + d * 144 + kc * 16) = ktreg[i]; }
            { const int e = tid >> 3, ch = tid & 7; v4u o;
                o.x = pk_bf16(bflo(vreg.x) * bflo(wkb.x), bfhi(vreg.x) * bfhi(wkb.x)); o.y = pk_bf16(bflo(vreg.y) * bflo(wkb.y), bfhi(vreg.y) * bfhi(wkb.y));
                o.z = pk_bf16(bflo(vreg.z) * bflo(wkb.z), bfhi(vreg.z) * bfhi(wkb.z)); o.w = pk_bf16(bflo(vreg.w) * bflo(wkb.w), bfhi(vreg.w) * bfhi(wkb.w));
                *(LAS v4u*)(lds + M2_VEW + e * 144 + ch * 16) = o; }
            if (tid < 192) SC[tid] = screg;
            const u32x2 numi0 = nreg[0], numi1 = nreg[1]; const float deni = bf2f(dreg);
            const float dec = ld_agent_f32(DEC + bh * 128 + c);
            __syncthreads();
            if (c + 1 < c_lo + 32) M2_LOAD(t0 + 64);
            if (PASS == 3) {
                float dot = 0.f;
#pragma unroll
                for (int i = 0; i < 8; ++i) { const v4u qv = *(const LAS v4u*)(lds + M2_QT + (16 * tt + fr) * 528 + fq * 128 + i * 16); const LAS float* np = nst_rd + fq * 64 + i * 8;
                    const f32x4 n0 = *(const LAS f32x4*)np, n1 = *(const LAS f32x4*)(np + 4);
                    dot += bflo(qv.x) * n0[0] + bfhi(qv.x) * n0[1] + bflo(qv.y) * n0[2] + bfhi(qv.y) * n0[3] + bflo(qv.z) * n1[0] + bfhi(qv.z) * n1[1] + bflo(qv.w) * n1[2] + bfhi(qv.w) * n1[3]; }
                dot += __shfl_xor(dot, 16); dot += __shfl_xor(dot, 32);
                f32x4 acc0 = (f32x4){0.f, 0.f, 0.f, 0.f}, acc1 = acc0;
#pragma unroll
                for (int ks = 0; ks < 8; ++ks) { const bf16x8 bfr = *(const LAS bf16x8*)(lds + M2_QT + (16 * tt + fr) * 528 + ks * 64 + fq * 16);
                    const bf16x8 a0 = *(const LAS bf16x8*)(cet_rd + (16 * (2 * eh) + fr) * 528 + ks * 64 + fq * 16), a1 = *(const LAS bf16x8*)(cet_rd + (16 * (2 * eh + 1) + fr) * 528 + ks * 64 + fq * 16);
                    acc0 = MFMA16(a0, bfr, acc0); acc1 = MFMA16(a1, bfr, acc1); }
                const int t = 16 * tt + fr; const float wi = SC[t], em = SC[64 + t], den = wi * dot + deni; const float inv = __builtin_amdgcn_rcpf(fmaxf(fabsf(den), em));
                bf16* hp = HB + ((size_t)b * SEQ + t0 + t) * DM + h * 512 + e0 + 32 * eh + 4 * fq;
                { u32x2 w; w.x = pk_bf16((acc0[0] * wi + bflo(numi0.x)) * inv, (acc0[1] * wi + bfhi(numi0.x)) * inv); w.y = pk_bf16((acc0[2] * wi + bflo(numi0.y)) * inv, (acc0[3] * wi + bfhi(numi0.y)) * inv); *(u32x2*)hp = w; }
                { u32x2 w; w.x = pk_bf16((acc1[0] * wi + bflo(numi1.x)) * inv, (acc1[1] * wi + bfhi(numi1.x)) * inv); w.y = pk_bf16((acc1[2] * wi + bflo(numi1.y)) * inv, (acc1[3] * wi + bfhi(numi1.y)) * inv); *(u32x2*)(hp + 16) = w; }
            }
#pragma unroll
            for (int i = 0; i < 2; ++i) {
                const bf16x8 af0 = *(const LAS bf16x8*)(lds + M2_KT + (16 * (2 * wid + i) + fr) * 144 + fq * 16), af1 = *(const LAS bf16x8*)(lds + M2_KT + (16 * (2 * wid + i) + fr) * 144 + 64 + fq * 16);
#pragma unroll
                for (int j = 0; j < 4; ++j) {
#pragma unroll
                    for (int r = 0; r < 4; ++r) cst[i][j][r] *= dec;
                    const bf16x8 b0 = *(const LAS bf16x8*)(lds + M2_VEW + (16 * j + fr) * 144 + fq * 16), b1 = *(const LAS bf16x8*)(lds + M2_VEW + (16 * j + fr) * 144 + 64 + fq * 16);
                    cst[i][j] = MFMA16(af0, b0, cst[i][j]); cst[i][j] = MFMA16(af1, b1, cst[i][j]);
                    if (PASS == 3) { u32x2 w; w.x = pk_bf16(cst[i][j][0], cst[i][j][1]); w.y = pk_bf16(cst[i][j][2], cst[i][j][3]);
                        *(LAS u32x2*)(cet_wr + (16 * j + fr) * 528 + (16 * (2 * wid + i) + 4 * fq) * 2) = w; } } }
            if (tid < 256) { float a = nst_rd[tid] * dec;
#pragma unroll
                for (int i = 0; i < 8; ++i) { const v4u kv = *(const LAS v4u*)(lds + M2_KT + tid * 144 + i * 16); const f32x4 w0 = *(const LAS f32x4*)(SC + 128 + 8 * i), w1 = *(const LAS f32x4*)(SC + 128 + 8 * i + 4);
                    a += bflo(kv.x) * w0[0] + bfhi(kv.x) * w0[1] + bflo(kv.y) * w0[2] + bfhi(kv.y) * w0[3] + bflo(kv.z) * w1[0] + bfhi(kv.z) * w1[1] + bflo(kv.w) * w1[2] + bfhi(kv.w) * w1[3]; }
                nst_wr[tid] = a; }
            __syncthreads();
        }
#undef M2_LOAD
        if (PASS == 1) {
#pragma unroll
            for (int i = 0; i < 2; ++i)
#pragma unroll
                for (int j = 0; j < 4; ++j)
#pragma unroll
                    for (int r = 0; r < 4; ++r) CLOC[csoff + (size_t)(16 * (2 * wid + i) + 4 * fq + r) * 512 + e0 + 16 * j + fr] = cst[i][j][r];
            if (sl == 0 && tid < 256) NLOC[((size_t)bh * 4 + seg) * 256 + tid] = ((const LAS float*)(lds + M2_NST))[tid];
        }
    }
}

struct Args { const float* in[22]; float* out; unsigned char* ws; TrJob jobs[NJOBS]; int grp_job_lo[7]; int grp_items[6]; int ph_lo, ph_hi; int pad; };
enum PhaseId { PH_P0, PH_FOX_IN, PH_FOX_CUM, PH_FOX_ATT, PH_FOX_OUT, PH_L0_MID, PH_L0_UP, PH_L0_DOWN, PH_L0_UPB, PH_L0_DOWNB, PH_L0_END, PH_LRU_IN, PH_LRU_P1, PH_LRU_P3, PH_LRU_OUT, PH_L1_MID, PH_L1_UP, PH_L1_DOWN, PH_L1_UPB, PH_L1_DOWNB, PH_L1_END, PH_SB_IN, PH_SB_ATT, PH_SB_OUT, PH_L2_MID, PH_L2_UP, PH_L2_DOWN, PH_L2_UPB, PH_L2_DOWNB, PH_L2_END, PH_ML_IN, PH_ML_PRE, PH_ML_INTRA, PH_ML_W1, PH_ML_W3, PH_ML_POST, PH_ML_OUT, PH_L3_MID, PH_L3_UP, PH_L3_DOWN, PH_L3_UPB, PH_L3_DOWNB, PH_L3_END, NPH };

#define GEMM_CALL(ACT_, Aptr, Bptr, Mv, Nv, Kv, Optr, ldc_, gcol_, Gptr, ng_, rs_, cs_) do { \
        pg8::Gemm g_{(const pg8::bf16_t*)(Aptr), (const pg8::bf16_t*)(Bptr), (Mv), (Nv), (Kv)}; pg8::StaticOrder S_; S_.init((Mv), (Nv), (int)gridDim.x, (int)blockIdx.x); \
        pg8::EpiStore<ACT_> E_{(pg8::bf16_t*)(Optr), (ldc_), (gcol_), (Gptr), (ng_), (rs_), (cs_)}; \
        pg8::gemm_phase<pg8::EpiStore<ACT_>, pg8::StaticOrder, true, true>(lds, g_, S_, E_); } while (0)

#define CONVERT_GROUP(g_, first_wg_) do { if (wg >= (first_wg_)) { LAS float* scr_ = (LAS float*)(lds + wave * 8704); const int jlo_ = args.grp_job_lo[g_], jhi_ = args.grp_job_lo[(g_) + 1]; \
        for (int it_ = (wg - (first_wg_)) * NWAVES + wave; it_ < args.grp_items[g_]; it_ += (G - (first_wg_)) * NWAVES) { int j_ = jlo_; \
            _Pragma("unroll 1") for (int q_ = jlo_ + 1; q_ < jhi_; ++q_) if (it_ >= args.jobs[q_].item0) j_ = q_; \
            const TrJob jb_ = args.jobs[j_]; tr_item(jb_.src, jb_.gk, jb_.ldw, jb_.ncols, jb_.K, jb_.dst, scr_, it_ - jb_.item0, lane); } } } while (0)

__global__ void __launch_bounds__(NWAVES * 64, 2) fwd_kernel(Args args) {
    extern __shared__ __attribute__((aligned(16))) unsigned char lds_raw[];
    LAS unsigned char* lds = (LAS unsigned char*)lds_raw;
    volatile LAS unsigned* MISC = (volatile LAS unsigned*)(lds + LDSCTL_OFF);
    const int tid = threadIdx.x, lane = tid & 63, wave = __builtin_amdgcn_readfirstlane(tid >> 6);
    const int G = gridDim.x, wg = blockIdx.x;
    const int gw = wg * NWAVES + wave, ngw = G * NWAVES;
    for (int u = tid; u < 64; u += NWAVES * 64) MISC[u] = 0u;
    __syncthreads();
    const int lo = args.ph_lo, hi = args.ph_hi;
    const int SLOT_WG = (G == 256) ? 64 : 0;
    const bool use_bar = (hi - lo) > 1;
    XcdBarrier bar; bar.bar = (unsigned*)(args.ws + WS_CTL) + 4096; bar.x = 0; bar.st = nullptr;
    if (use_bar) bar = xcd_barrier_post((unsigned*)(args.ws + WS_CTL) + 4096, MISC + 8);
#ifdef ONLY_PHASE
#define IN(k) ((k) == ONLY_PHASE && lo <= (k) && (k) < hi)
#else
#define IN(k) (lo <= (k) && (k) < hi)
#endif
#define SEAM(k) do { if (IN((k) + 1)) xcd_barrier(bar); } while (0)
#ifndef PROBE_MASK
#define PROBE_MASK 0ull
#endif
#define NREP(k) ((((unsigned long long)(PROBE_MASK) >> (k)) & 1ull) ? 2 : 1)
#define PHASE(k, ...) if (IN(k)) { _Pragma("unroll 1") for (int rep_ = 0; rep_ < NREP(k); ++rep_) { __VA_ARGS__; if (rep_ + 1 < NREP(k)) xcd_barrier(bar); } SEAM(k); }

#define x_in (args.in[0])
#define norm_g (args.in[1])
#define out (args.out)
#define WSP(T, off) ((T*)(args.ws + (off)))
#define W_FOXIN WSP(bf16, WS_W_FOXIN)
#define W_FOXOUT WSP(bf16, WS_W_FOXOUT)
#define W_LRUIN WSP(bf16, WS_W_LRUIN)
#define W_LRUOUT WSP(bf16, WS_W_LRUOUT)
#define W_SBIN WSP(bf16, WS_W_SBIN)
#define W_SBOUT WSP(bf16, WS_W_SBOUT)
#define W_MLIN WSP(bf16, WS_W_MLIN)
#define W_MLOUT WSP(bf16, WS_W_MLOUT)
#define W1 WSP(bf16, WS_W1)
#define W2 WSP(bf16, WS_W2)
#define H WSP(bf16, WS_H)
#define HM WSP(bf16, WS_HM)
#define PROJ WSP(bf16, WS_PROJ)
#define VT WSP(bf16, WS_PROJ + WS_VT_OFF)
#define Y WSP(bf16, WS_Y)
#define HID WSP(bf16, WS_HID)
#define KT WSP(bf16, WS_KT)
#define GATES WSP(float, WS_GATES)
#define CUM WSP(float, WS_CUM)
#define MLS WSP(float, WS_MLS)
#define KNORM WSP(float, WS_KN)
#define R2V WSP(float, WS_R2)
#define ML_NUMI WSP(bf16, WS_Y)
#define ML_CLOC WSP(float, WS_MLST)
#define ML_CS WSP(float, WS_MLST + 16 * MiB)
#define ML_NLOC WSP(float, WS_MLST + 32 * MiB)
#define ML_NS WSP(float, WS_MLST + 32 * MiB + 65536)
#define LRU_SEGS WSP(float, WS_LRU_SEG)
#define LRU_WGT WSP(bf16, WS_LRU_WGT)
#define LRU_AB WSP(v4u, WS_MLST)

    PHASE(PH_P0,
        CONVERT_GROUP(0, 0);
        gate_rows(args.in[4], norm_g, 6160, 6144, 16, W_FOXIN + (size_t)4096 * DM, wg * 512 + tid, G * 512);
        gate_rows(args.in[18], norm_g + 12 * DM, 6152, 6144, 8, W_MLIN + (size_t)4096 * DM, wg * 512 + tid, G * 512);
        lru_wgt_prep(args.in[10], args.in[12], LRU_WGT, wg * 512 + tid, G * 512);
        row_first(x_in, H, R2V, gw, ngw, lane))
    PHASE(PH_FOX_IN, GEMM_CALL(0, H, W_FOXIN, MTOK, 4352, DM, PROJ, 4096, 4096, GATES, 16, R2V, nullptr);
             GEMM_CALL(0, W_FOXIN + (size_t)4352 * DM, H, 2048, MTOK, DM, VT, MTOK, INT_MAX, nullptr, 0, nullptr, R2V); CONVERT_GROUP(1, SLOT_WG))
    PHASE(PH_FOX_CUM, fox_cumsum(lds, GATES, args.in[5], CUM, wg, G); fox_knorm(PROJ, KNORM, gw, ngw, lane); __syncthreads(); CONVERT_GROUP(4, (G == 256) ? 32 : 0))
    PHASE(PH_FOX_ATT, attn_phase<0>(lds, PROJ, VT, CUM, KNORM, Y, (unsigned*)(args.ws + WS_CTL) + 1024))
    PHASE(PH_FOX_OUT, GEMM_CALL(0, Y, W_FOXOUT, MTOK, DM, DM, HM, DM, INT_MAX, nullptr, 0, nullptr, nullptr))
    PHASE(PH_L0_MID, row_upd<false>(H, HM, norm_g + 1 * DM, R2V, nullptr, gw, ngw, lane))
    PHASE(PH_L0_UP, GEMM_CALL(2, H, W1, MTOK / 2, DFF, DM, HID, DFF, INT_MAX, nullptr, 0, R2V, nullptr))
    PHASE(PH_L0_DOWN, GEMM_CALL(0, HID, W2, MTOK / 2, DM, DFF, HM, DM, INT_MAX, nullptr, 0, nullptr, nullptr))
    PHASE(PH_L0_UPB, GEMM_CALL(2, H + (size_t)(MTOK / 2) * DM, W1, MTOK / 2, DFF, DM, HID, DFF, INT_MAX, nullptr, 0, R2V + MTOK / 2, nullptr))
    PHASE(PH_L0_DOWNB, GEMM_CALL(0, HID, W2, MTOK / 2, DM, DFF, HM + (size_t)(MTOK / 2) * DM, DM, INT_MAX, nullptr, 0, nullptr, nullptr))
    PHASE(PH_L0_END, row_upd<false>(H, HM, norm_g + 3 * DM, R2V, nullptr, gw, ngw, lane))
    PHASE(PH_LRU_IN, GEMM_CALL(0, H, W_LRUIN, MTOK, 5376, DM, PROJ, 5376, INT_MAX, nullptr, 0, R2V, nullptr); CONVERT_GROUP(2, SLOT_WG))
    PHASE(PH_LRU_P1, lru2_pass<1>(lds, PROJ, LRU_WGT, args.in[8], args.in[9], args.in[11], args.in[13], args.in[14], LRU_SEGS, Y, LRU_AB, wg, G))
    PHASE(PH_LRU_P3, lru3_pass(lds, PROJ, LRU_SEGS, Y, LRU_AB, wg, G))
    PHASE(PH_LRU_OUT, GEMM_CALL(0, Y, W_LRUOUT, MTOK, DM, LRU_W, HM, DM, INT_MAX, nullptr, 0, nullptr, nullptr))
    PHASE(PH_L1_MID, row_upd<false>(H, HM, norm_g + 5 * DM, R2V, nullptr, gw, ngw, lane))
    PHASE(PH_L1_UP, GEMM_CALL(2, H, W1 + (size_t)1 * DFF * DM, MTOK / 2, DFF, DM, HID, DFF, INT_MAX, nullptr, 0, R2V, nullptr))
    PHASE(PH_L1_DOWN, GEMM_CALL(0, HID, W2 + (size_t)1 * DFF * DM, MTOK / 2, DM, DFF, HM, DM, INT_MAX, nullptr, 0, nullptr, nullptr))
    PHASE(PH_L1_UPB, GEMM_CALL(2, H + (size_t)(MTOK / 2) * DM, W1 + (size_t)1 * DFF * DM, MTOK / 2, DFF, DM, HID, DFF, INT_MAX, nullptr, 0, R2V + MTOK / 2, nullptr))
    PHASE(PH_L1_DOWNB, GEMM_CALL(0, HID, W2 + (size_t)1 * DFF * DM, MTOK / 2, DM, DFF, HM + (size_t)(MTOK / 2) * DM, DM, INT_MAX, nullptr, 0, nullptr, nullptr))
    PHASE(PH_L1_END, row_upd<false>(H, HM, norm_g + 7 * DM, R2V, nullptr, gw, ngw, lane))
    PHASE(PH_SB_IN, GEMM_CALL(0, H, W_SBIN, MTOK, 4096, DM, PROJ, 4096, INT_MAX, nullptr, 0, R2V, nullptr);
              GEMM_CALL(0, W_SBIN + (size_t)4096 * DM, H, 2048, MTOK, DM, VT, MTOK, INT_MAX, nullptr, 0, nullptr, R2V))
    PHASE(PH_SB_ATT, attn_phase<1>(lds, PROJ, VT, CUM, KNORM, Y, (unsigned*)(args.ws + WS_CTL) + 1088))
    PHASE(PH_SB_OUT, GEMM_CALL(0, Y, W_SBOUT, MTOK, DM, DM, HM, DM, INT_MAX, nullptr, 0, nullptr, nullptr))
    PHASE(PH_L2_MID, row_upd<false>(H, HM, norm_g + 9 * DM, R2V, nullptr, gw, ngw, lane))
    PHASE(PH_L2_UP, GEMM_CALL(2, H, W1 + (size_t)2 * DFF * DM, MTOK / 2, DFF, DM, HID, DFF, INT_MAX, nullptr, 0, R2V, nullptr))
    PHASE(PH_L2_DOWN, GEMM_CALL(0, HID, W2 + (size_t)2 * DFF * DM, MTOK / 2, DM, DFF, HM, DM, INT_MAX, nullptr, 0, nullptr, nullptr))
    PHASE(PH_L2_UPB, GEMM_CALL(2, H + (size_t)(MTOK / 2) * DM, W1 + (size_t)2 * DFF * DM, MTOK / 2, DFF, DM, HID, DFF, INT_MAX, nullptr, 0, R2V + MTOK / 2, nullptr))
    PHASE(PH_L2_DOWNB, GEMM_CALL(0, HID, W2 + (size_t)2 * DFF * DM, MTOK / 2, DM, DFF, HM + (size_t)(MTOK / 2) * DM, DM, INT_MAX, nullptr, 0, nullptr, nullptr))
    PHASE(PH_L2_END, row_upd<false>(H, HM, norm_g + 11 * DM, R2V, nullptr, gw, ngw, lane))
    PHASE(PH_ML_IN, GEMM_CALL(0, H, W_MLIN, MTOK, 4352, DM, PROJ, 4096, 4096, GATES, 8, R2V, nullptr);
              GEMM_CALL(0, W_MLIN + (size_t)4352 * DM, H, 2048, MTOK, DM, VT, MTOK, INT_MAX, nullptr, 0, nullptr, R2V); CONVERT_GROUP(3, SLOT_WG))
    PHASE(PH_ML_PRE, mlstm_pre(lds, GATES, args.in[19], MLS, wg, G); __syncthreads(); CONVERT_GROUP(5, (G == 256) ? 8 : 0))
    PHASE(PH_ML_INTRA, mlstm_intra(lds, PROJ, VT, MLS, ML_NUMI, KT, wg, G))
    PHASE(PH_ML_W1, mlstm_walk<1>(lds, PROJ, KT, VT, MLS, ML_NUMI, ML_CLOC, ML_CS, ML_NLOC, ML_NS, HM, wg, G))
    PHASE(PH_ML_W3, mlstm_walk<3>(lds, PROJ, KT, VT, MLS, ML_NUMI, ML_CLOC, ML_CS, ML_NLOC, ML_NS, HM, wg, G))
    PHASE(PH_ML_POST, mlstm_post(HM, PROJ, args.in[20], Y, gw, ngw, lane))
    PHASE(PH_ML_OUT, GEMM_CALL(0, Y, W_MLOUT, MTOK, DM, DM, HM, DM, INT_MAX, nullptr, 0, nullptr, nullptr))
    PHASE(PH_L3_MID, row_upd<false>(H, HM, norm_g + 13 * DM, R2V, nullptr, gw, ngw, lane))
    PHASE(PH_L3_UP, GEMM_CALL(2, H, W1 + (size_t)3 * DFF * DM, MTOK / 2, DFF, DM, HID, DFF, INT_MAX, nullptr, 0, R2V, nullptr))
    PHASE(PH_L3_DOWN, GEMM_CALL(0, HID, W2 + (size_t)3 * DFF * DM, MTOK / 2, DM, DFF, HM, DM, INT_MAX, nullptr, 0, nullptr, nullptr))
    PHASE(PH_L3_UPB, GEMM_CALL(2, H + (size_t)(MTOK / 2) * DM, W1 + (size_t)3 * DFF * DM, MTOK / 2, DFF, DM, HID, DFF, INT_MAX, nullptr, 0, R2V + MTOK / 2, nullptr))
    PHASE(PH_L3_DOWNB, GEMM_CALL(0, HID, W2 + (size_t)3 * DFF * DM, MTOK / 2, DM, DFF, HM + (size_t)(MTOK / 2) * DM, DM, INT_MAX, nullptr, 0, nullptr, nullptr))
    if (IN(PH_L3_END)) { row_upd<true>(H, HM, norm_g + 15 * DM, nullptr, out, gw, ngw, lane); }
#undef IN
#undef SEAM
}
#undef x_in
#undef norm_g
#undef out
#undef WSP
#undef W_FOXIN
#undef W_FOXOUT
#undef W_LRUIN
#undef W_LRUOUT
#undef W_SBIN
#undef W_SBOUT
#undef W_MLIN
#undef W_MLOUT
#undef W1
#undef W2
#undef H
#undef HM
#undef PROJ
#undef VT
#undef Y
#undef HID
#undef KT
#undef GATES
#undef CUM
#undef MLS
#undef KNORM
#undef R2V
#undef ML_NUMI
#undef ML_CLOC
#undef ML_CS
#undef ML_NLOC
#undef ML_NS
#undef LRU_SEGS
#undef LRU_WGT
#undef LRU_AB

#ifndef N_LAUNCH_SPLIT
#define N_LAUNCH_SPLIT 0
#endif
extern "C" void kernel_launch(void* const* d_in, const int* in_sizes, int n_in, void* d_out, int out_size, void* d_ws, size_t ws_size, hipStream_t stream) {
    static int grid = 0;
    if (grid == 0) {
        if (n_in != 22 || out_size != MTOK * DM || ws_size < WS_END) { fprintf(stderr, "kernel_launch: unexpected shapes (n_in %d, out %d, ws %zu)\n", n_in, out_size, ws_size); grid = -1; return; }
        int dev = 0, cus = 0, per_cu = 0;
        if (hipGetDevice(&dev) != hipSuccess || hipDeviceGetAttribute(&cus, hipDeviceAttributeMultiprocessorCount, dev) != hipSuccess) { grid = -1; return; }
        if (hipFuncSetAttribute((const void*)fwd_kernel, hipFuncAttributeMaxDynamicSharedMemorySize, LDS_BYTES) != hipSuccess) { fprintf(stderr, "kernel_launch: hipFuncSetAttribute failed\n"); grid = -1; return; }
        if (hipOccupancyMaxActiveBlocksPerMultiprocessor(&per_cu, (const void*)fwd_kernel, NWAVES * 64, LDS_BYTES) != hipSuccess || per_cu < 1) { fprintf(stderr, "kernel_launch: occupancy query says %d\n", per_cu); per_cu = 1; }
        (void)hipGetLastError();
        grid = cus;
    }
    if (grid < 0) return;
    unsigned char* ws = (unsigned char*)d_ws;
    Args a{};
    for (int i = 0; i < 22; ++i) a.in[i] = (const float*)d_in[i];
    a.out = (float*)d_out; a.ws = ws;
    {
        int nj = 0, items = 0;
        auto add = [&](const float* src, int ldw, int ncols, int K, size_t dst_off, const float* gk) { a.jobs[nj].src = src; a.jobs[nj].gk = gk; a.jobs[nj].dst = (bf16*)(ws + dst_off); a.jobs[nj].ldw = ldw; a.jobs[nj].ncols = ncols; a.jobs[nj].K = K; a.jobs[nj].item0 = items; items += (K / 64) * (ncols / 32); ++nj; };
        const float* fox_in = a.in[4]; const float* ml_in = a.in[18]; const float* ng0 = a.in[1];
        auto w1 = [&](int l) { add(a.in[2] + (size_t)l * DM * DFF, DFF, DFF, DM, WS_W1 + (size_t)l * DFF * DM * 2, ng0 + (size_t)(4 * l + 2) * DM); };
        auto w2 = [&](int l) { add(a.in[3] + (size_t)l * DFF * DM, DM, DM, DFF, WS_W2 + (size_t)l * DFF * DM * 2, nullptr); };
        a.grp_job_lo[0] = nj; items = 0;
        add(fox_in, 6160, 4096, DM, WS_W_FOXIN, ng0);
        add(fox_in + 4096, 6160, 2048, DM, WS_W_FOXIN + (size_t)4352 * DM * 2, ng0);
        add(a.in[7], 5376, 5376, DM, WS_W_LRUIN, ng0 + 4 * DM);
        add(a.in[16], 6144, 6144, DM, WS_W_SBIN, ng0 + 8 * DM);
        add(a.in[17], DM, DM, DM, WS_W_SBOUT, nullptr);
        add(ml_in, 6152, 2048, DM, WS_W_MLIN, ng0 + 12 * DM);
        add(ml_in + 4096, 6152, 2048, DM, WS_W_MLIN + (size_t)2048 * DM * 2, ng0 + 12 * DM);
        add(ml_in + 2048, 6152, 2048, DM, WS_W_MLIN + (size_t)4352 * DM * 2, ng0 + 12 * DM);
        w1(2); w2(2);
        a.grp_items[0] = items;
        a.grp_job_lo[1] = nj; items = 0;
        add(a.in[6], DM, DM, DM, WS_W_FOXOUT, nullptr); w1(0);
        a.grp_items[1] = items;
        a.grp_job_lo[2] = nj; items = 0;
        add(a.in[15], DM, DM, LRU_W, WS_W_LRUOUT, nullptr); w1(1); w2(1);
        a.grp_items[2] = items;
        a.grp_job_lo[3] = nj; items = 0;
        add(a.in[21], DM, DM, DM, WS_W_MLOUT, nullptr); w1(3);
        a.grp_items[3] = items;
        a.grp_job_lo[4] = nj; items = 0; w2(0); a.grp_items[4] = items;
        a.grp_job_lo[5] = nj; items = 0; w2(3); a.grp_items[5] = items;
        a.grp_job_lo[6] = nj;
    }
    if (hipMemsetAsync(ws + WS_CTL, 0, CTL_ZERO_BYTES, stream) != hipSuccess) { fprintf(stderr, "kernel_launch: memset failed\n"); return; }
#if N_LAUNCH_SPLIT
    for (int p = 0; p < NPH; ++p) { a.ph_lo = p; a.ph_hi = p + 1; hipLaunchKernelGGL(fwd_kernel, dim3(grid), dim3(NWAVES * 64), LDS_BYTES, stream, a); }
#else
    a.ph_lo = 0; a.ph_hi = NPH;
    hipLaunchKernelGGL(fwd_kernel, dim3(grid), dim3(NWAVES * 64), LDS_BYTES, stream, a);
#endif
    const hipError_t le = hipPeekAtLastError();
    if (le != hipSuccess) fprintf(stderr, "kernel_launch: launch failed: %s\n", hipGetErrorName(le));
}
```

```cpp
#include <hip/hip_runtime.h>
#include <cstdio>
#include <cstdint>
#include <climits>
namespace pg8 {
#define PG8_LAS __attribute__((address_space(3)))
typedef unsigned short bf16_t;
typedef short bf16x8 __attribute__((ext_vector_type(8)));
typedef float f32x4 __attribute__((ext_vector_type(4)));
typedef unsigned u32x4 __attribute__((ext_vector_type(4)));
constexpr int BM = 256, BK = 64, HALF = 128, HTB = HALF * BK * 2  , STAGE_BYTES = 8 * HTB, NXCD = 8, WGM = 8;

__host__ __device__ __forceinline__ int lds_byte(int r, int c) { const int st = (r >> 4) * 2 + (c >> 5), rr = r & 15, cc = c & 31, ob = rr * 64 + cc * 2; return st * 1024 + (ob ^ (((ob >> 9) & 1) << 5)); }
__host__ __device__ __forceinline__ void stage_rc(int b, int& R, int& C) { const int st = b / 1024, sb = b % 1024, swz = sb ^ (((sb >> 9) & 1) << 5); R = (st >> 1) * 16 + swz / 64; C = (st & 1) * 32 + (swz % 64) / 2; }
__host__ __device__ __forceinline__ int perm32(int rho) { const int n = rho >> 4, i = rho & 15; return 8 * (i >> 2) + 4 * n + (i & 3); }

struct Unit { int pm, pn; };
struct Gemm { const bf16_t* A; const bf16_t* Bt; int M, N, K; };

struct StaticOrder {
    int nM, nN, nwg, G, c;
    __host__ __device__ void init(int M, int N, int G_, int c_) { nM = M / BM; nN = N / BM; nwg = nM * nN; G = G_; c = c_; }
    __host__ __device__ bool next(int i, Unit& u) const {
        const long L = (long)i * G + c; if (L >= nwg) return false;
        int wgid = (int)L; { const int q = nwg / NXCD, r = nwg % NXCD, xcd = wgid % NXCD, off = wgid / NXCD; wgid = (xcd < r ? xcd * (q + 1) : r * (q + 1) + (xcd - r) * q) + off; }
        const int nig = WGM * nN, gid = wgid / nig, fm = gid * WGM, gsz = (nM - fm) < WGM ? (nM - fm) : WGM;
        u.pm = fm + ((wgid % nig) % gsz); u.pn = (wgid % nig) / gsz; return true;
    }
    __device__ __forceinline__ void a_ready(const Unit&) const {}
    __device__ __forceinline__ void done(const Unit&) const {}
};
__device__ __forceinline__ unsigned pk_bf16(float lo, float hi) {
    typedef __bf16 bf2_t __attribute__((ext_vector_type(2))); typedef float f2_t __attribute__((ext_vector_type(2)));
    const bf2_t r = __builtin_convertvector((f2_t){lo, hi}, bf2_t); return __builtin_bit_cast(unsigned, r); }
template <int ACT  > struct EpiStore {
    static constexpr bool PERM = true, AFTER_DRAIN = false;
    bf16_t* O; int ldc; int gate_col0; float* G; int ng; const float* rs; const float* cs;
    __device__ __forceinline__ void operator()(const f32x4 (&acc)[2][2][4][2], const Unit& u, int wr, int wc, int fr, int fq) const {
        const int row0 = u.pm * BM + wr * 64 + fr; const int colt = u.pn * BM;
        if (colt >= gate_col0) {
            if (wc == 0) {
#pragma unroll
                for (int ai = 0; ai < 2; ++ai)
#pragma unroll
                    for (int m = 0; m < 4; ++m) { const int rr = row0 + ai * HALF + m * 16; float* gp = G + (size_t)rr * 16; const float sc = rs ? rs[rr] : 1.f;
#pragma unroll
                        for (int n = 0; n < 2; ++n) { const int c = 8 * fq + 4 * n; if (c < ng) *(f32x4*)(gp + c) = acc[ai][0][m][n] * sc; } }
            }
            return;
        }
        const int col0 = colt + wc * 32 + 8 * fq;
        f32x4 c0[2], c1[2];
#pragma unroll
        for (int bj = 0; bj < 2; ++bj) { c0[bj] = cs ? *(const f32x4*)(cs + col0 + bj * HALF) : (f32x4){1.f, 1.f, 1.f, 1.f}; c1[bj] = cs ? *(const f32x4*)(cs + col0 + bj * HALF + 4) : (f32x4){1.f, 1.f, 1.f, 1.f}; }
#pragma unroll
        for (int ai = 0; ai < 2; ++ai)
#pragma unroll
            for (int m = 0; m < 4; ++m) { const int rr = row0 + ai * HALF + m * 16; bf16_t* rowp = O + (size_t)rr * ldc + col0; const float sc = rs ? rs[rr] : 1.f;
#pragma unroll
                for (int bj = 0; bj < 2; ++bj) { f32x4 v0 = acc[ai][bj][m][0] * sc * c0[bj], v1 = acc[ai][bj][m][1] * sc * c1[bj];
                    if (ACT == 2) {
#pragma unroll
                        for (int e = 0; e < 4; ++e) { const float a = fmaxf(v0[e], 0.f), b = fmaxf(v1[e], 0.f); v0[e] = a * a; v1[e] = b * b; } }
                    u32x4 w; w.x = pk_bf16(v0[0], v0[1]); w.y = pk_bf16(v0[2], v0[3]); w.z = pk_bf16(v1[0], v1[1]); w.w = pk_bf16(v1[2], v1[3]);
                    *(u32x4*)(rowp + bj * HALF) = w; } }
    }
};
template <class Epi, class Sched, bool ALIGN_EPI = false, bool SP2 = false>
__device__ __forceinline__ void gemm_phase(PG8_LAS unsigned char* lds, const Gemm g, const Sched& S, const Epi& E) {
    const int tid = threadIdx.x, wid = __builtin_amdgcn_readfirstlane(tid >> 6), lane = tid & 63, wr = wid >> 2, wc = wid & 3, fr = lane & 15, fq = lane >> 4;
    const int K = g.K, nt = K / BK;
    unsigned voffA[2], voffB[2];
#pragma unroll
    for (int i = 0; i < 2; ++i) { int R, C; stage_rc(tid * 16 + i * 8192, R, C); const int Rb = Epi::PERM ? ((R & ~31) + perm32(R & 31)) : R;
        voffA[i] = (unsigned)(R * K + C) * 2u; voffB[i] = (unsigned)(Rb * K + C) * 2u; }
    const size_t kstep = (size_t)(BK * 2);
    const size_t hstep = (size_t)HALF * K * 2;
    const size_t tstep = 2 * hstep;
    const unsigned ldsw = (unsigned)wid * 1024u;
    const int aoff = lds_byte(wr * 64 + fr, fq * 8), boff = lds_byte(wc * 32 + fr, fq * 8);
#define PG8_SA(b, h) (((b) * 2 + (h)) * HTB)
#define PG8_SB(b, h) ((4 + (b) * 2 + (h)) * HTB)
#define PG8_STAGE(bufoff, gbase, voff) do { _Pragma("unroll") for (int _i = 0; _i < 2; ++_i) \
        __builtin_amdgcn_global_load_lds((const unsigned*)((const char*)(gbase) + (voff)[_i]), (PG8_LAS unsigned*)(lds + (bufoff) + ldsw + _i * 8192), 16, 0, 0); } while (0)
#define PG8_LDA(dst, b, h) do { _Pragma("unroll") for (int m = 0; m < 4; ++m) _Pragma("unroll") for (int k = 0; k < 2; ++k) dst[m][k] = *(const PG8_LAS bf16x8*)(lds + PG8_SA(b, h) + aoff + m * 2048 + k * 1024); } while (0)
#define PG8_LDB(dst, b, h) do { _Pragma("unroll") for (int n = 0; n < 2; ++n) _Pragma("unroll") for (int k = 0; k < 2; ++k) dst[n][k] = *(const PG8_LAS bf16x8*)(lds + PG8_SB(b, h) + boff + n * 2048 + k * 1024); } while (0)
#define PG8_MMA(ai, bj, At, Bt) do { __builtin_amdgcn_s_setprio(1); _Pragma("unroll") for (int m = 0; m < 4; ++m) _Pragma("unroll") for (int n = 0; n < 2; ++n) _Pragma("unroll") for (int k = 0; k < 2; ++k) \
        acc[ai][bj][m][n] = __builtin_amdgcn_mfma_f32_16x16x32_bf16(Bt[n][k], At[m][k], acc[ai][bj][m][n], 0, 0, 0); __builtin_amdgcn_s_setprio(0); } while (0)
#define PG8_WAIT_V(n) asm volatile("s_waitcnt vmcnt(" #n ")" ::: "memory")
#define PG8_WAIT_L(n) asm volatile("s_waitcnt lgkmcnt(" #n ")" ::: "memory")
#define PG8_BAR __builtin_amdgcn_s_barrier()
#define PG8_SCHED __builtin_amdgcn_sched_barrier(0)
    Unit cur, nxt; int ui = 0;
    if (!S.next(0, cur)) return;
    f32x4 acc[2][2][4][2];
#pragma unroll
    for (int a = 0; a < 2; ++a)
#pragma unroll
        for (int b = 0; b < 2; ++b)
#pragma unroll
            for (int m = 0; m < 4; ++m)
#pragma unroll
                for (int n = 0; n < 2; ++n) acc[a][b][m][n] = (f32x4){0.f, 0.f, 0.f, 0.f};
    bf16x8 At[4][2], B0[2][2], B1[2][2];
    const char* cA = (const char*)g.A + (size_t)cur.pm * tstep; const char* cB = (const char*)g.Bt + (size_t)cur.pn * tstep;
    S.a_ready(cur);
    if constexpr (SP2) {
        PG8_STAGE(PG8_SB(0, 0), cB, voffB); PG8_STAGE(PG8_SB(0, 1), cB + hstep, voffB); PG8_STAGE(PG8_SA(0, 0), cA, voffA); PG8_STAGE(PG8_SA(0, 1), cA + hstep, voffA);
        if (wr == 1) PG8_BAR;
        PG8_WAIT_V(2); PG8_BAR;
        PG8_STAGE(PG8_SB(1, 0), cB + kstep, voffB); PG8_STAGE(PG8_SA(1, 0), cA + kstep, voffA); PG8_STAGE(PG8_SB(1, 1), cB + hstep + kstep, voffB);
        PG8_WAIT_V(6); PG8_BAR;
    } else {
        PG8_STAGE(PG8_SB(0, 0), cB, voffB); PG8_STAGE(PG8_SA(0, 0), cA, voffA); PG8_STAGE(PG8_SB(0, 1), cB + hstep, voffB); PG8_STAGE(PG8_SA(0, 1), cA + hstep, voffA);
        if (wr == 1) PG8_BAR;
        PG8_WAIT_V(4); PG8_BAR;
        PG8_STAGE(PG8_SB(1, 0), cB + kstep, voffB); PG8_STAGE(PG8_SA(1, 0), cA + kstep, voffA); PG8_STAGE(PG8_SB(1, 1), cB + hstep + kstep, voffB);
        PG8_WAIT_V(6); PG8_BAR;
    }
    for (;;) {
        const bool has_next = S.next(ui + 1, nxt);
        const char* nA = has_next ? (const char*)g.A + (size_t)nxt.pm * tstep : cA; const char* nB = has_next ? (const char*)g.Bt + (size_t)nxt.pn * tstep : cB;
        for (int t = 0; t < nt; t += 2) {
            const bool last = (t == nt - 2);
            const char* a1 = cA + (size_t)(t + 1) * kstep;
            const char* a2 = last ? nA : cA + (size_t)(t + 2) * kstep; const char* b2 = last ? nB : cB + (size_t)(t + 2) * kstep;
            const char* a3 = a2 + kstep; const char* b3 = b2 + kstep;
            if (last && has_next) S.a_ready(nxt);
            if constexpr (SP2) {
            PG8_LDB(B0, 0, 0); PG8_LDB(B1, 0, 1); PG8_SCHED; PG8_LDA(At, 0, 0); PG8_STAGE(PG8_SA(1, 1), a1 + hstep, voffA);
            PG8_WAIT_V(8); PG8_WAIT_L(0); PG8_BAR; PG8_MMA(0, 0, At, B0); PG8_MMA(0, 1, At, B1); PG8_BAR; PG8_SCHED;
            PG8_LDA(At, 0, 1); PG8_STAGE(PG8_SB(0, 0), b2, voffB); PG8_STAGE(PG8_SB(0, 1), b2 + hstep, voffB); PG8_STAGE(PG8_SA(0, 0), a2, voffA);
            PG8_WAIT_V(8); PG8_WAIT_L(0); PG8_BAR; PG8_MMA(1, 0, At, B0); PG8_MMA(1, 1, At, B1); PG8_BAR; PG8_SCHED;
            PG8_LDB(B0, 1, 0); PG8_LDB(B1, 1, 1); PG8_SCHED; PG8_LDA(At, 1, 0); PG8_STAGE(PG8_SA(0, 1), a2 + hstep, voffA);
            PG8_WAIT_V(8); PG8_WAIT_L(0); PG8_BAR; PG8_MMA(0, 0, At, B0); PG8_MMA(0, 1, At, B1); PG8_BAR; PG8_SCHED;
            PG8_LDA(At, 1, 1); PG8_STAGE(PG8_SB(1, 0), b3, voffB); PG8_STAGE(PG8_SB(1, 1), b3 + hstep, voffB); PG8_STAGE(PG8_SA(1, 0), a3, voffA);
            PG8_WAIT_V(8); PG8_WAIT_L(0); PG8_BAR; PG8_MMA(1, 0, At, B0); PG8_MMA(1, 1, At, B1); PG8_BAR; PG8_SCHED;
            } else {
            PG8_LDB(B0, 0, 0); PG8_SCHED; PG8_LDA(At, 0, 0); PG8_STAGE(PG8_SA(1, 1), a1 + hstep, voffA);
            PG8_WAIT_L(8); PG8_BAR; PG8_WAIT_L(0); PG8_MMA(0, 0, At, B0); PG8_BAR; PG8_SCHED;
            PG8_LDB(B1, 0, 1); PG8_STAGE(PG8_SB(0, 0), b2, voffB);
            PG8_BAR; PG8_WAIT_L(0); PG8_MMA(0, 1, At, B1); PG8_BAR;
            PG8_LDA(At, 0, 1); PG8_STAGE(PG8_SA(0, 0), a2, voffA);
            PG8_BAR; PG8_WAIT_L(0); PG8_MMA(1, 0, At, B0); PG8_BAR; PG8_SCHED;
            PG8_STAGE(PG8_SB(0, 1), b2 + hstep, voffB);
            PG8_WAIT_V(6); PG8_BAR; PG8_MMA(1, 1, At, B1); PG8_BAR;
            PG8_LDB(B0, 1, 0); PG8_SCHED; PG8_LDA(At, 1, 0); PG8_STAGE(PG8_SA(0, 1), a2 + hstep, voffA);
            PG8_WAIT_L(8); PG8_BAR; PG8_WAIT_L(0); PG8_MMA(0, 0, At, B0); PG8_BAR; PG8_SCHED;
            PG8_LDB(B1, 1, 1); PG8_STAGE(PG8_SB(1, 0), b3, voffB);
            PG8_BAR; PG8_WAIT_L(0); PG8_MMA(0, 1, At, B1); PG8_BAR;
            PG8_LDA(At, 1, 1); PG8_STAGE(PG8_SA(1, 0), a3, voffA);
            PG8_BAR; PG8_WAIT_L(0); PG8_MMA(1, 0, At, B0); PG8_BAR; PG8_SCHED;
            PG8_STAGE(PG8_SB(1, 1), b3 + hstep, voffB);
            PG8_WAIT_V(6); PG8_BAR; PG8_MMA(1, 1, At, B1); PG8_BAR;
            }
        }
        if constexpr (ALIGN_EPI) { if (wr == 0) PG8_BAR; }
        if constexpr (!Epi::AFTER_DRAIN) { E(acc, cur, wr, wc, fr, fq); S.done(cur); }
        if (!has_next) break;
#pragma unroll
        for (int a = 0; a < 2; ++a)
#pragma unroll
            for (int b = 0; b < 2; ++b)
#pragma unroll
                for (int m = 0; m < 4; ++m)
#pragma unroll
                    for (int n = 0; n < 2; ++n) acc[a][b][m][n] = (f32x4){0.f, 0.f, 0.f, 0.f};
        cur = nxt; cA = nA; cB = nB; ++ui;
        if constexpr (ALIGN_EPI) { if (wr == 1) PG8_BAR; }
    }
    PG8_WAIT_V(0);
    if constexpr (!ALIGN_EPI) { if (wr == 0) PG8_BAR; }
    PG8_BAR;
    if constexpr (Epi::AFTER_DRAIN) { E.fused(acc, cur, wr, wc, fr, fq, lds, wid, lane); S.done(cur); }
#undef PG8_SA
#undef PG8_SB
#undef PG8_STAGE
#undef PG8_LDA
#undef PG8_LDB
#undef PG8_MMA
#undef PG8_WAIT_V
#undef PG8_WAIT_L
#undef PG8_BAR
#undef PG8_SCHED
}
}
#define GAS __attribute__((address_space(1)))
#define LAS __attribute__((address_space(3)))
typedef unsigned short bf16;
typedef unsigned v4u __attribute__((ext_vector_type(4)));
typedef float f32x4 __attribute__((ext_vector_type(4)));
typedef short bf16x8 __attribute__((ext_vector_type(8)));
typedef GAS unsigned gu32;
typedef GAS unsigned long long gu64;
#define RLX_AGENT __ATOMIC_RELAXED, __HIP_MEMORY_SCOPE_AGENT
#define LDS_WAIT() asm volatile("s_waitcnt lgkmcnt(0)" ::: "memory")
#define VM_WAIT() asm volatile("s_waitcnt vmcnt(0)" ::: "memory")
__device__ __forceinline__ unsigned long long rt() { return __builtin_amdgcn_s_memrealtime(); }
__device__ __forceinline__ unsigned f2bf(float f) { unsigned u = __builtin_bit_cast(unsigned, f); return (u + 0x7fffu + ((u >> 16) & 1u)) >> 16; }
__device__ __forceinline__ unsigned pk2(float lo, float hi) { return f2bf(lo) | (f2bf(hi) << 16); }

#define XB_TMO      128
#define XB_XCNT(j)  (256  + 64 * (j))
#define XB_XSUB(j)  (1280 + 64 * (j))
#define XB_XGEN(j)  (2304 + 64 * (j))
#define XB_TOP      3328
#define XB_TOPGEN   3392
#define XCD_BAR_WORDS 3456
#define XB_SPIN_CAP (1u << 18)

__device__ __forceinline__ unsigned xb_ld(unsigned* p)              { return __hip_atomic_load(p, __ATOMIC_RELAXED, __HIP_MEMORY_SCOPE_AGENT); }
__device__ __forceinline__ unsigned xb_add(unsigned* p, unsigned v) { return __hip_atomic_fetch_add(p, v, __ATOMIC_RELAXED, __HIP_MEMORY_SCOPE_AGENT); }
__device__ __forceinline__ unsigned xb_xcc_id() { return (unsigned)__builtin_amdgcn_s_getreg((3 << 11) | 20) & 0xFu; }
#define XB_SPIN(cond, bar) do { unsigned _sp = 0; while (cond) { __builtin_amdgcn_s_sleep(1); \
    if ((++_sp & 255u) == 0u) { if (xb_ld(&(bar)[XB_TMO])) break; if (_sp > XB_SPIN_CAP) { atomicAdd(&(bar)[XB_TMO], 1u); break; } } } } while (0)

struct XcdBarrier {
    unsigned* bar; unsigned x;
    volatile LAS unsigned* st;
};

__device__ __forceinline__ XcdBarrier xcd_barrier_post(unsigned* bar, volatile LAS unsigned* st) {
    XcdBarrier b; b.bar = bar; b.x = xb_xcc_id(); b.st = st;
    if (threadIdx.x == 0) (void)xb_add(&bar[XB_XCNT(b.x)], 1u);
    return b;
}
__device__ __forceinline__ void xcd_barrier_complete(unsigned* bar, unsigned x, unsigned& nloc, unsigned& nx) {
    const unsigned G = gridDim.x * gridDim.y * gridDim.z;
    unsigned sum, cnt, mine, sp = 0u;
    for (;;) {
        sum = 0u; cnt = 0u; mine = 0u;
#pragma unroll
        for (unsigned j = 0; j < 16; ++j) { const unsigned c = xb_ld(&bar[XB_XCNT(j)]); sum += c; cnt += (c > 0u) ? 1u : 0u; mine = (j == x) ? c : mine; }
        if (sum == G) break;
        __builtin_amdgcn_s_sleep(1);
        if ((++sp & 255u) == 0u) { if (xb_ld(&bar[XB_TMO])) break; if (sp > XB_SPIN_CAP) { atomicAdd(&bar[XB_TMO], 1u); break; } }
    }
    nloc = mine > 0u ? mine : 1u; nx = cnt > 0u ? cnt : 1u;
}

__device__ __forceinline__ void xcd_barrier(const XcdBarrier& b) {
    asm volatile("s_waitcnt vmcnt(0)" ::: "memory");
    __syncthreads();
    if (threadIdx.x == 0) {
        unsigned* bar = b.bar;
        __builtin_amdgcn_s_waitcnt(0);
        unsigned nloc = b.st[0], nx = b.st[1];
        if (nloc == 0u) { xcd_barrier_complete(bar, b.x, nloc, nx); b.st[0] = nloc; b.st[1] = nx; }
        const unsigned old = xb_add(&bar[XB_XSUB(b.x)], 1u);
        const unsigned gen = old / nloc;
        if (old + 1u == (gen + 1u) * nloc) {
            __builtin_amdgcn_fence(__ATOMIC_RELEASE, "agent");
            asm volatile("s_waitcnt vmcnt(0)" ::: "memory");
            const unsigned og = xb_add(&bar[XB_TOP], 1u);
            const unsigned tg = og / nx;
            if (og + 1u == (tg + 1u) * nx) xb_add(&bar[XB_TOPGEN], 1u);
            else XB_SPIN(xb_ld(&bar[XB_TOPGEN]) == tg, bar);
            __builtin_amdgcn_fence(__ATOMIC_ACQUIRE, "agent");
            xb_add(&bar[XB_XGEN(b.x)], 1u);
            asm volatile("s_waitcnt vmcnt(0)" ::: "memory");
        } else {
            XB_SPIN(xb_ld(&bar[XB_XGEN(b.x)]) == gen, bar);
            __builtin_amdgcn_fence(__ATOMIC_ACQUIRE, "agent");
            asm volatile("s_waitcnt vmcnt(0)" ::: "memory");
        }
    }
    __syncthreads();
}

constexpr int DM = 2048, BATCH = 2, SEQ = 8192, MTOK = BATCH * SEQ, DFF = 8192, DEPTH = 4;
constexpr int LRU_W = 2688, LRU_BD = 168;
constexpr float EPS = 1e-6f;
constexpr int NWAVES = 8;
typedef unsigned short bf16;
typedef float f32x16 __attribute__((ext_vector_type(16)));
typedef unsigned u32x2 __attribute__((ext_vector_type(2)));
using pg8::pk_bf16;

constexpr size_t MiB = 1u << 20;
constexpr size_t WS_CTL = 0, CTL_ZERO_BYTES = 1 * MiB;
constexpr size_t WS_GATES = 1 * MiB;
constexpr size_t WS_CUM = 2 * MiB;
constexpr size_t WS_MLS = 3 * MiB;
constexpr size_t WS_R2 = 4 * MiB + 768 * 1024;
constexpr size_t WS_KN = 4 * MiB + 512 * 1024;
constexpr size_t WS_LRU_SEG = 5 * MiB, WS_LRU_WGT = 6 * MiB;
constexpr size_t WS_W_FOXIN = 8 * MiB, WS_W_FOXOUT = 33 * MiB, WS_W_LRUIN = 41 * MiB, WS_W_LRUOUT = 62 * MiB, WS_W_SBIN = 73 * MiB, WS_W_SBOUT = 97 * MiB,
                 WS_W_MLIN = 105 * MiB, WS_W_MLOUT = 130 * MiB, WS_W1 = 138 * MiB, WS_W2 = 266 * MiB;
constexpr size_t WS_H = 394 * MiB;
constexpr size_t WS_HM = 458 * MiB;
constexpr size_t WS_PROJ = 522 * MiB;
constexpr size_t WS_Y = 714 * MiB;
constexpr size_t WS_HID = 522 * MiB;
constexpr size_t WS_KT = 798 * MiB;
constexpr size_t WS_MLST = 830 * MiB;
constexpr size_t WS_END = 1024 * MiB;
constexpr size_t WS_VT_OFF = 128 * MiB;

constexpr int LDS_BYTES = 163840;
constexpr int LDSCTL_OFF = 163840 - 256;

#define LAS __attribute__((address_space(3)))
typedef short bf16x8 __attribute__((ext_vector_type(8)));
typedef short s16x4 __attribute__((ext_vector_type(4)));
typedef float f32x4 __attribute__((ext_vector_type(4)));
typedef unsigned v4u __attribute__((ext_vector_type(4)));
#define MFMA32(a, b, c) __builtin_amdgcn_mfma_f32_32x32x16_bf16((a), (b), (c), 0, 0, 0)
#define MFMA16(a, b, c) __builtin_amdgcn_mfma_f32_16x16x32_bf16((a), (b), (c), 0, 0, 0)

__device__ __forceinline__ float bf2f(unsigned short b) { return __uint_as_float((unsigned)b << 16); }
__device__ __forceinline__ float bflo(unsigned w) { return __uint_as_float(w << 16); }
__device__ __forceinline__ float bfhi(unsigned w) { return __uint_as_float(w & 0xffff0000u); }
__device__ __forceinline__ unsigned short f2bf16(float f) { return (unsigned short)(pk_bf16(f, 0.f) & 0xffffu); }
__device__ __forceinline__ float wave_sum(float v) {
#pragma unroll
    for (int o = 1; o < 64; o <<= 1) v += __shfl_xor(v, o);
    return v;
}
__device__ __forceinline__ float log_sigmoid_f(float x) { return fminf(x, 0.f) - log1pf(expf(-fabsf(x))); }
__device__ __forceinline__ float sigmoid_f(float x) { return 1.f / (1.f + expf(-x)); }
__device__ __forceinline__ float gelu_tanh_f(float x) { const float u = 0.7978845608028654f * (x + 0.044715f * x * x * x); const float t = 1.f - 2.f / (1.f + expf(2.f * u)); return 0.5f * x * (1.f + t); }
__device__ __forceinline__ float ld_agent_f32(const float* p) { return __uint_as_float(__hip_atomic_load((const unsigned*)p, __ATOMIC_RELAXED, __HIP_MEMORY_SCOPE_AGENT)); }

struct TrJob { const float* src; bf16* dst; const float* gk; int ldw, ncols, K, item0; };
constexpr int NJOBS = 19;
__device__ __forceinline__ void tr_item(const float* W, const float* gk, int ldw, int ncols, int K, bf16* WT, LAS float* scr, int item, int lane) {
    const int nblk = ncols / 32, kb = item / nblk, nb = item % nblk, k0 = 64 * kb, n0 = 32 * nb;
#pragma unroll 8
    for (int i = 0; i < 32; ++i) { const int kk = 2 * i + (lane >> 5); scr[kk * 33 + (lane & 31)] = W[(size_t)(k0 + kk) * ldw + n0 + (lane & 31)]; }
    asm volatile("s_waitcnt lgkmcnt(0)" ::: "memory");
    const int c = lane & 7;
    f32x4 g0 = (f32x4){1.f, 1.f, 1.f, 1.f}, g1 = g0;
    if (gk) { g0 = *(const f32x4*)(gk + k0 + 8 * c); g1 = *(const f32x4*)(gk + k0 + 8 * c + 4); }
#pragma unroll
    for (int j = 0; j < 4; ++j) { const int n = (lane >> 3) + 8 * j; const LAS float* s = scr + (8 * c) * 33 + n;
        v4u o; o.x = pk_bf16(s[0 * 33] * g0[0], s[1 * 33] * g0[1]); o.y = pk_bf16(s[2 * 33] * g0[2], s[3 * 33] * g0[3]); o.z = pk_bf16(s[4 * 33] * g1[0], s[5 * 33] * g1[1]); o.w = pk_bf16(s[6 * 33] * g1[2], s[7 * 33] * g1[3]);
        *(v4u*)(WT + (size_t)(n0 + n) * K + k0 + 8 * c) = o; }
    asm volatile("s_waitcnt lgkmcnt(0)" ::: "memory");
}
__device__ __forceinline__ void gate_rows(const float* W, const float* gk, int ldw, int col0, int ng, bf16* dst, int gtid, int nthr) {
    for (int i = gtid; i < 256 * DM; i += nthr) { const int g = i / DM, k = i % DM; const float v = g < ng ? W[(size_t)k * ldw + col0 + g] * gk[k] : 0.f; dst[i] = f2bf16(v); }
}

__device__ __forceinline__ void row_first(const float* xsrc, bf16* XB, float* R2, int gw, int ngw, int lane) {
    for (int row = gw; row < MTOK; row += ngw) {
        const size_t ro = (size_t)row * DM + 4 * lane; float ss = 0.f;
#pragma unroll
        for (int j = 0; j < 8; ++j) { const f32x4 v = *(const f32x4*)(xsrc + ro + 256 * j); ss += (v.x * v.x + v.y * v.y) + (v.z * v.z + v.w * v.w);
            u32x2 w; w.x = pk_bf16(v.x, v.y); w.y = pk_bf16(v.z, v.w); *(u32x2*)(XB + ro + 256 * j) = w; }
        const float r = rsqrtf(wave_sum(ss) * (1.f / DM) + EPS);
        if (lane == 0) R2[row] = r;
    }
}
template <bool FINAL>
__device__ __forceinline__ void row_upd(bf16* XB, const bf16* hm, const float* ga, float* R2, float* outp, int gw, int ngw, int lane) {
    for (int row = gw; row < MTOK; row += ngw) {
        const size_t ro = (size_t)row * DM + 4 * lane;
        u32x2 xv[8], hv[8]; float ss = 0.f;
#pragma unroll
        for (int j = 0; j < 8; ++j) { xv[j] = *(const u32x2*)(XB + ro + 256 * j); hv[j] = *(const u32x2*)(hm + ro + 256 * j);
            const float a = bflo(hv[j].x), b = bfhi(hv[j].x), c = bflo(hv[j].y), d = bfhi(hv[j].y); ss += (a * a + b * b) + (c * c + d * d); }
        const float r = rsqrtf(wave_sum(ss) * (1.f / DM) + EPS);
        float s2 = 0.f;
#pragma unroll
        for (int j = 0; j < 8; ++j) { const f32x4 g = *(const f32x4*)(ga + 256 * j + 4 * lane); f32x4 v;
            v.x = bflo(xv[j].x) + bflo(hv[j].x) * r * g.x; v.y = bfhi(xv[j].x) + bfhi(hv[j].x) * r * g.y; v.z = bflo(xv[j].y) + bflo(hv[j].y) * r * g.z; v.w = bfhi(xv[j].y) + bfhi(hv[j].y) * r * g.w;
            if (FINAL) { *(f32x4*)(outp + ro + 256 * j) = v; }
            else { s2 += (v.x * v.x + v.y * v.y) + (v.z * v.z + v.w * v.w); u32x2 w; w.x = pk_bf16(v.x, v.y); w.y = pk_bf16(v.z, v.w); *(u32x2*)(XB + ro + 256 * j) = w; } }
        if (!FINAL) { const float r2 = rsqrtf(wave_sum(s2) * (1.f / DM) + EPS); if (lane == 0) R2[row] = r2; }
    }
}

__device__ __forceinline__ void fox_cumsum(LAS unsigned char* lds, const float* G, const float* bfv, float* cum, int wg, int nwg) {
    LAS float* wtot = (LAS float*)lds;
    const int tid = threadIdx.x, lane = tid & 63, wid = tid >> 6;
    for (int u = wg; u < 32; u += nwg) {
        const int b = u >> 4, h = u & 15; const float bias = bfv[h];
        float v[16]; float run = 0.f;
#pragma unroll
        for (int i = 0; i < 16; ++i) { run += log_sigmoid_f(G[((size_t)b * SEQ + tid * 16 + i) * 16 + h] + bias); v[i] = run; }
        float inc = run;
#pragma unroll
        for (int o = 1; o < 64; o <<= 1) { const float t = __shfl_up(inc, o); if (lane >= o) inc += t; }
        __syncthreads();
        if (lane == 63) wtot[wid] = inc;
        __syncthreads();
        float off = inc - run;
        for (int w = 0; w < wid; ++w) off += wtot[w];
        float* o = cum + ((size_t)(b * 16 + h)) * SEQ + tid * 16;
#pragma unroll
        for (int i = 0; i < 16; ++i) o[i] = (off + v[i]) * 1.4426950408889634f;
    }
}


__device__ __forceinline__ void fox_knorm(const bf16* QK, float* KN, int gw, int ngw, int lane) {
    for (int it = gw; it < 2 * 16 * 128; it += ngw) { const int tile = it & 127, h = (it >> 7) & 15, b = it >> 11;
        const bf16* kp = QK + ((size_t)b * SEQ + tile * 64 + lane) * 4096 + 2048 + h * 128; float ss = 0.f;
#pragma unroll
        for (int c = 0; c < 16; ++c) { const v4u v = *(const v4u*)(kp + 8 * c);
            ss += bflo(v.x) * bflo(v.x) + bfhi(v.x) * bfhi(v.x) + bflo(v.y) * bflo(v.y) + bfhi(v.y) * bfhi(v.y) + bflo(v.z) * bflo(v.z) + bfhi(v.z) * bfhi(v.z) + bflo(v.w) * bflo(v.w) + bfhi(v.w) * bfhi(v.w); }
#pragma unroll
        for (int o = 1; o < 64; o <<= 1) ss = fmaxf(ss, __shfl_xor(ss, o));
        if (lane == 0) KN[it] = ss * 1.0001f; }
}

constexpr int AT_KB = 16384, AT_VB = 16384, AT_K0 = 0, AT_V0 = 2 * AT_KB, AT_CS = AT_V0 + 2 * AT_VB, AT_FLAG = AT_CS + 512, AT_PM = AT_FLAG + 64;
__device__ __forceinline__ int crow(int r, int hi) { return (r & 3) + 8 * (r >> 2) + 4 * hi; }

template <int MODE>
__device__ __forceinline__ void attn_unit(LAS unsigned char* lds, const bf16* QK, const bf16* VT, const float* cum, const float* KN, bf16* Y, int b, int h, int qb) {
    const int tid = threadIdx.x, lane = tid & 63, wid = __builtin_amdgcn_readfirstlane(tid >> 6), r32 = lane & 31, hi = lane >> 5;
    const float scale = 0.08838834764831845f;
    const int tq = qb * 256 + wid * 32 + r32;
    const size_t rowq = (size_t)b * SEQ + tq;
    bf16x8 qf[8];
    { const bf16* qp = QK + rowq * 4096 + h * 128 + 8 * hi;
#pragma unroll
      for (int ks = 0; ks < 8; ++ks) qf[ks] = *(const bf16x8*)(qp + 16 * ks); }
    const float* cumh = cum + (size_t)(b * 16 + h) * SEQ;
    float ct = 0.f; if (MODE == 0) ct = cumh[tq];
    f32x16 o[4];
#pragma unroll
    for (int dt = 0; dt < 4; ++dt)
#pragma unroll
        for (int r = 0; r < 16; ++r) o[dt][r] = 0.f;
    float m = 0.f, l = 0.f, R = 0.f;
    const int jmax = 4 * qb + 3, jw = 4 * qb + (wid >> 1);
    bool wdone = false;
    const bf16* kbase = QK + ((size_t)b * SEQ) * 4096 + 2048 + h * 128;
    const bf16* vbase = VT + ((size_t)h * 128) * MTOK + (size_t)b * SEQ;
#define AT_DMA(jj, buf) do { _Pragma("unroll") for (int i_ = 0; i_ < 2; ++i_) { const int pc_ = wid + 8 * i_; \
            const int row_ = 4 * pc_ + (lane >> 4), p_ = lane & 15; \
            __builtin_amdgcn_global_load_lds((const unsigned*)(kbase + (size_t)(64 * (jj) + row_) * 4096 + ((p_ ^ (row_ & 15)) << 3)), (LAS unsigned*)(lds + AT_K0 + (buf) * AT_KB + pc_ * 1024), 16, 0, 0); \
            const int d_ = 8 * pc_ + (lane >> 3), pv_ = lane & 7; \
            __builtin_amdgcn_global_load_lds((const unsigned*)(vbase + (size_t)d_ * MTOK + 64 * (jj) + ((pv_ ^ ((d_ >> 1) & 7)) << 3)), (LAS unsigned*)(lds + AT_V0 + (buf) * AT_VB + pc_ * 1024), 16, 0, 0); } \
        if (MODE == 0 && wid == 0) __builtin_amdgcn_global_load_lds((const unsigned*)(cumh + 64 * (jj) + lane), (LAS unsigned*)(lds + AT_CS + (buf) * 256), 4, 0, 0); } while (0)
    float qn = 0.f;
    if (MODE == 0) {
#pragma unroll
        for (int ks = 0; ks < 8; ++ks)
#pragma unroll
            for (int e = 0; e < 8; ++e) { const float v = bf2f((unsigned short)qf[ks][e]); qn += v * v; }
        qn += __shfl_xor(qn, 32); qn = __builtin_amdgcn_sqrtf(qn) * (scale * 1.4426950408889634f);
        if (wid == 0) { const float* kn = KN + (size_t)(b * 16 + h) * 128; float a0 = kn[lane], a1 = kn[64 + lane];
#pragma unroll
            for (int o_ = 1; o_ < 64; o_ <<= 1) { const float t0 = __shfl_up(a0, o_), t1 = __shfl_up(a1, o_); if (lane >= o_) { a0 = fmaxf(a0, t0); a1 = fmaxf(a1, t1); } }
            a1 = fmaxf(a1, __shfl(a0, 63));
            ((LAS float*)(lds + AT_PM))[lane] = __builtin_amdgcn_sqrtf(a0); ((LAS float*)(lds + AT_PM))[64 + lane] = __builtin_amdgcn_sqrtf(a1); }
    }
    AT_DMA(jmax, 0);
    asm volatile("s_waitcnt vmcnt(0)" ::: "memory");
    __syncthreads();
    for (int j = jmax; j >= 0; --j) {
        const int cur = (jmax - j) & 1;
        if (j > 0) AT_DMA(j - 1, cur ^ 1);
        if (j <= jw && !wdone) {
            const LAS unsigned char* kb = lds + AT_K0 + cur * AT_KB;
            const LAS unsigned char* vb = lds + AT_V0 + cur * AT_VB;
            const LAS float* csb = (const LAS float*)(lds + AT_CS + cur * 256);
            const int dsub = (wid & 1);
            if (MODE == 0) {
                f32x16 s0, s1;
#pragma unroll
                for (int r = 0; r < 16; ++r) { s0[r] = 0.f; s1[r] = 0.f; }
                __builtin_amdgcn_s_setprio(1);
#pragma unroll
                for (int ks = 0; ks < 8; ++ks) {
                    const bf16x8 k0 = *(const LAS bf16x8*)(kb + r32 * 256 + (((2 * ks + hi) ^ (r32 & 15)) << 4));
                    const bf16x8 k1 = *(const LAS bf16x8*)(kb + (32 + r32) * 256 + (((2 * ks + hi) ^ (r32 & 15)) << 4));
                    s0 = MFMA32(k0, qf[ks], s0); s1 = MFMA32(k1, qf[ks], s1);
                }
                __builtin_amdgcn_s_setprio(0);
                const bool dj = (j == jw); const int q64 = 32 * dsub + r32;
                const float cm = ct - m; float mx = -1e30f;
#pragma unroll
                for (int g = 0; g < 4; ++g) { const f32x4 ca = *(const LAS f32x4*)(csb + 8 * g + 4 * hi), cb = *(const LAS f32x4*)(csb + 32 + 8 * g + 4 * hi);
#pragma unroll
                    for (int i = 0; i < 4; ++i) { const int r = 4 * g + i; const int kk = 8 * g + 4 * hi + i;
                        float la = s0[r] * (scale * 1.4426950408889634f) + (cm - ca[i]), lb = s1[r] * (scale * 1.4426950408889634f) + (cm - cb[i]);
                        if (dj) { if (kk > q64) la = -1e30f; if (32 + kk > q64) lb = -1e30f; }
                        s0[r] = la; s1[r] = lb; mx = fmaxf(mx, fmaxf(la, lb)); } }
                mx = fmaxf(mx, __shfl_xor(mx, 32));
                if (__any(mx > 0.f)) {
                    const float d = fmaxf(mx, 0.f), alpha = __builtin_amdgcn_exp2f(-d);
                    l *= alpha; m += d;
#pragma unroll
                    for (int r = 0; r < 16; ++r) { s0[r] -= d; s1[r] -= d; }
#pragma unroll
                    for (int dt = 0; dt < 4; ++dt)
#pragma unroll
                        for (int r = 0; r < 16; ++r) o[dt][r] *= alpha;
                }
                float ps = 0.f;
#pragma unroll
                for (int r = 0; r < 16; ++r) { s0[r] = __builtin_amdgcn_exp2f(s0[r]); s1[r] = __builtin_amdgcn_exp2f(s1[r]); ps += s0[r] + s1[r]; }
                l += ps;
                __builtin_amdgcn_s_setprio(1);
#pragma unroll
                for (int sub = 0; sub < 2; ++sub)
#pragma unroll
                    for (int st = 0; st < 2; ++st) {
                        v4u pw;
                        if (sub == 0) { pw.x = pk_bf16(s0[8 * st + 0], s0[8 * st + 1]); pw.y = pk_bf16(s0[8 * st + 2], s0[8 * st + 3]); pw.z = pk_bf16(s0[8 * st + 4], s0[8 * st + 5]); pw.w = pk_bf16(s0[8 * st + 6], s0[8 * st + 7]); }
                        else { pw.x = pk_bf16(s1[8 * st + 0], s1[8 * st + 1]); pw.y = pk_bf16(s1[8 * st + 2], s1[8 * st + 3]); pw.z = pk_bf16(s1[8 * st + 4], s1[8 * st + 5]); pw.w = pk_bf16(s1[8 * st + 6], s1[8 * st + 7]); }
                        const bf16x8 pf = __builtin_bit_cast(bf16x8, pw);
#pragma unroll
                        for (int dt = 0; dt < 4; ++dt) {
                            const int dv_ = 32 * dt + r32, sw_ = (dv_ >> 1) & 7, c0_ = 4 * sub + 2 * st;
                            const LAS unsigned char* vrow = vb + dv_ * 128 + 8 * hi;
                            const u32x2 lo = *(const LAS u32x2*)(vrow + ((c0_ ^ sw_) << 4)), hh = *(const LAS u32x2*)(vrow + (((c0_ + 1) ^ sw_) << 4));
                            const v4u vw = (v4u){lo.x, lo.y, hh.x, hh.y};
                            o[dt] = MFMA32(__builtin_bit_cast(bf16x8, vw), pf, o[dt]);
                        }
                    }
                __builtin_amdgcn_s_setprio(0);
            } else
#pragma unroll
            for (int sub = 1; sub >= 0; --sub) {
                if (j == jw && sub > dsub) continue;
                const bool diag = (j == jw && sub == dsub);
                f32x16 s;
#pragma unroll
                for (int r = 0; r < 16; ++r) s[r] = 0.f;
                __builtin_amdgcn_s_setprio(1);
#pragma unroll
                for (int ks = 0; ks < 8; ++ks) {
                    const bf16x8 kf = *(const LAS bf16x8*)(kb + (32 * sub + r32) * 256 + (((2 * ks + hi) ^ (r32 & 15)) << 4));
                    s = MFMA32(kf, qf[ks], s);
                }
                __builtin_amdgcn_s_setprio(0);
                float p[16];
                if (MODE == 0) {
                    const float cm = ct - m; float mx = -1e30f;
#pragma unroll
                    for (int g = 0; g < 4; ++g) { const f32x4 cs = *(const LAS f32x4*)(csb + 32 * sub + 8 * g + 4 * hi);
#pragma unroll
                        for (int i = 0; i < 4; ++i) { const int r = 4 * g + i; float lg = s[r] * (scale * 1.4426950408889634f) + (cm - cs[i]);
                            if (diag && (8 * g + 4 * hi + i) > r32) lg = -1e30f;
                            p[r] = lg; mx = fmaxf(mx, lg); } }
                    mx = fmaxf(mx, __shfl_xor(mx, 32));
                    if (__any(mx > 0.f)) {
                        const float d = fmaxf(mx, 0.f), alpha = __builtin_amdgcn_exp2f(-d);
                        l *= alpha; m += d;
#pragma unroll
                        for (int r = 0; r < 16; ++r) p[r] -= d;
#pragma unroll
                        for (int dt = 0; dt < 4; ++dt)
#pragma unroll
                            for (int r = 0; r < 16; ++r) o[dt][r] *= alpha;
                    }
                    float ps = 0.f;
#pragma unroll
                    for (int r = 0; r < 16; ++r) { p[r] = __builtin_amdgcn_exp2f(p[r]); ps += p[r]; }
                    l += ps;
                } else {
                    float L1[16], G[4], Go[4];
#pragma unroll
                    for (int g = 0; g < 4; ++g) { float gs = 0.f;
#pragma unroll
                        for (int i = 0; i < 4; ++i) { const int r = 4 * g + i; const float zz = s[r] * scale;
                            const bool valid = !diag || (8 * g + 4 * hi + i) < r32;
                            const float sp = fmaxf(zz, 0.f) + __logf(1.f + __expf(-fabsf(zz)));
                            L1[r] = valid ? -sp : 0.f; p[r] = zz - sp; gs += L1[r]; }
                        G[g] = gs; }
#pragma unroll
                    for (int g = 0; g < 4; ++g) Go[g] = __shfl_xor(G[g], 32);
                    float T = 0.f;
#pragma unroll
                    for (int g = 3; g >= 0; --g) {
                        const float base = R + T + (hi == 0 ? Go[g] : 0.f);
                        float suf = 0.f;
#pragma unroll
                        for (int i = 3; i >= 0; --i) { const int r = 4 * g + i;
                            const bool valid = !diag || (8 * g + 4 * hi + i) < r32;
                            const float a = __expf(p[r] + base + suf);
                            p[r] = valid ? a : 0.f; suf += L1[r]; }
                        T += G[g] + Go[g];
                    }
                    R += T;
                }
#pragma unroll
                for (int st = 0; st < 2; ++st) {
                    v4u pw; pw.x = pk_bf16(p[8 * st + 0], p[8 * st + 1]); pw.y = pk_bf16(p[8 * st + 2], p[8 * st + 3]); pw.z = pk_bf16(p[8 * st + 4], p[8 * st + 5]); pw.w = pk_bf16(p[8 * st + 6], p[8 * st + 7]);
                    const bf16x8 pf = __builtin_bit_cast(bf16x8, pw);
#pragma unroll
                    for (int dt = 0; dt < 4; ++dt) {
                        const int dv_ = 32 * dt + r32, sw_ = (dv_ >> 1) & 7, c0_ = 4 * sub + 2 * st;
                        const LAS unsigned char* vrow = vb + dv_ * 128 + 8 * hi;
                        const u32x2 lo = *(const LAS u32x2*)(vrow + ((c0_ ^ sw_) << 4)), hh = *(const LAS u32x2*)(vrow + (((c0_ + 1) ^ sw_) << 4));
                        const v4u vw = (v4u){lo.x, lo.y, hh.x, hh.y};
                        o[dt] = MFMA32(__builtin_bit_cast(bf16x8, vw), pf, o[dt]);
                    }
                }
            }
            if (MODE == 1) wdone = __all(R < -104.f);
            if (MODE == 0 && j > 0) { const float bound = qn * ((const LAS float*)(lds + AT_PM))[j - 1] + (ct - csb[0]) - m; wdone = __all(bound < -150.1f); }
        }
        if (lane == 0) ((LAS unsigned*)(lds + AT_FLAG))[cur * 8 + wid] = wdone ? 1u : 0u;
        asm volatile("s_waitcnt vmcnt(0)" ::: "memory");
        __syncthreads();
        {
            const LAS unsigned* fl = (const LAS unsigned*)(lds + AT_FLAG) + cur * 8;
            unsigned all = 1u;
#pragma unroll
            for (int w = 0; w < 8; ++w) all &= fl[w];
            if (all) break;
        }
    }
    float inv = 1.f;
    if (MODE == 0) { const float lt = l + __shfl_xor(l, 32); inv = 1.f / lt; }
    bf16* yp = Y + rowq * DM + h * 128 + 4 * hi;
#pragma unroll
    for (int dt = 0; dt < 4; ++dt)
#pragma unroll
        for (int g = 0; g < 4; ++g) { u32x2 w; w.x = pk_bf16(o[dt][4 * g] * inv, o[dt][4 * g + 1] * inv); w.y = pk_bf16(o[dt][4 * g + 2] * inv, o[dt][4 * g + 3] * inv);
            *(u32x2*)(yp + 32 * dt + 8 * g) = w; }
    __syncthreads();
}

template <int MODE>
__device__ __forceinline__ void attn_phase(LAS unsigned char* lds, const bf16* QK, const bf16* VT, const float* cum, const float* KN, bf16* Y, unsigned* counter) {
    LAS unsigned* slot = (LAS unsigned*)(lds + AT_PM + 512);
#pragma unroll 1
    for (;;) {
        if (threadIdx.x == 0) *slot = __hip_atomic_fetch_add(counter, 1u, __ATOMIC_RELAXED, __HIP_MEMORY_SCOPE_AGENT);
        __syncthreads();
        const unsigned u = *slot;
        __syncthreads();
        if (u >= 1024u) break;
        const int bh = u & 31, qb = 31 - (int)(u >> 5);
        attn_unit<MODE>(lds, QK, VT, cum, KN, Y, bh >> 4, bh & 15, qb);
    }
}

constexpr int L2_WT = 0, L2_U = 118272, L2_XCH = L2_U + 21504, L2_CAR = L2_XCH + 5632, L2_CW = L2_CAR + 2816, L2_CH = L2_CW + 3360, L2_END = L2_CH + 2112;
static_assert(L2_END <= LDSCTL_OFF, "LRU v2 LDS map");
constexpr size_t LRU_SEG = (size_t)2 * 8 * LRU_W;

__device__ __forceinline__ void lru_wgt_prep(const float* w_r, const float* w_i, bf16* WGT, int gtid, int nthr) {
    for (int i = gtid; i < 16 * 352 * LRU_BD; i += nthr) { const int d = i % LRU_BD, e = (i / LRU_BD) % 352, n = i / (LRU_BD * 352); float v = 0.f;
        if (e < 168) v = w_r[((size_t)n * LRU_BD + d) * LRU_BD + e]; else if (e >= 176 && e < 344) v = w_i[((size_t)n * LRU_BD + d) * LRU_BD + (e - 176)];
        WGT[i] = f2bf16(v); }
}
__device__ __forceinline__ void lru_carry(float* SEG, int gtid, int nthr) {
    for (int i = gtid; i < 2 * LRU_W; i += nthr) { const int b = i / LRU_W, ch = i % LRU_W; float carry = 0.f;
#pragma unroll
        for (int sg = 0; sg < 8; ++sg) { const size_t o = ((size_t)b * 8 + sg) * LRU_W + ch; SEG[2 * LRU_SEG + o] = carry; carry = SEG[o] * carry + SEG[LRU_SEG + o]; } }
}
__device__ __forceinline__ float expm1_neg(float x) { const float p = x * (1.f + x * (0.5f + x * (1.f / 6.f))), e = __expf(x) - 1.f; return (x > -0.02f) ? p : e; }
__device__ __forceinline__ float fast_rcp(float x) { return __builtin_amdgcn_rcpf(x); }
__device__ __forceinline__ float fast_gelu_tanh(float x) { const float u2 = (-2.f * 0.7978845608028654f * 1.4426950408889634f) * x * (1.f + 0.044715f * x * x); return x * fast_rcp(1.f + __builtin_amdgcn_exp2f(u2)); }

template <int PASS>
__device__ __forceinline__ void lru2_pass(LAS unsigned char* lds, const bf16* PROJ, const bf16* WGT, const float* conv_w, const float* conv_b, const float* b_r, const float* b_i,
                                          const float* lam, float* SEG, bf16* YB, v4u* AB, int wg, int nwg) {
    const int tid = threadIdx.x, lane = tid & 63, wid = __builtin_amdgcn_readfirstlane(tid >> 6), fr = lane & 15, fq = lane >> 4, rt = wid & 3, half = wid >> 2;
    LAS float* XCH = (LAS float*)(lds + L2_XCH);
    LAS float* CAR = (LAS float*)(lds + L2_CAR);
#pragma unroll 1
    for (int unit = wg; unit < 256; unit += nwg) {
        const int n = unit & 15, b = (unit >> 4) >> 3, seg = (unit >> 4) & 7;
        __syncthreads();
        { const v4u* src = (const v4u*)(WGT + (size_t)n * 352 * LRU_BD);
          for (int i = tid; i < 118272 / 16; i += 512) *(LAS v4u*)(lds + L2_WT + i * 16) = src[i]; }
        const int ch8 = tid % 21, rg = tid / 21;
        LAS float* CWL = (LAS float*)(lds + L2_CW);
        LAS float* CHL = (LAS float*)(lds + L2_CH);
        for (int i = tid; i < 5 * LRU_BD; i += 512) { const int j = i / LRU_BD, d = i % LRU_BD; CWL[i] = (j < 4) ? conv_w[(size_t)j * LRU_W + n * LRU_BD + d] : conv_b[n * LRU_BD + d]; }
        if (tid < 176) { const bool ok = tid < LRU_BD; const int gi = n * LRU_BD + (ok ? tid : 0); CHL[tid] = b_r[gi]; CHL[176 + tid] = b_i[gi]; CHL[352 + tid] = 8.f * 1.4426950408889634f * log_sigmoid_f(lam[gi]); }
        if (tid < 176) { float cin = 0.f;
            if (PASS == 3 && tid < LRU_BD) { for (int sg = 0; sg < seg; ++sg) { const size_t o = ((size_t)b * 8 + sg) * LRU_W + n * LRU_BD + tid; cin = SEG[o] * cin + SEG[LRU_SEG + o]; } }
            CAR[tid] = 1.f; CAR[176 + tid] = cin; }
        const bf16* ubase = PROJ + ((size_t)b * SEQ) * 5376 + LRU_W + n * LRU_BD + ch8 * 8;
        const bf16* gbase = PROJ + ((size_t)b * SEQ) * 5376 + n * LRU_BD;
        v4u raw[7];
#define L2_LOAD(t0_) do { _Pragma("unroll") for (int j_ = 0; j_ < 7; ++j_) { const int tt_ = (t0_) + 4 * rg - 3 + j_; \
            raw[j_] = (v4u){0u, 0u, 0u, 0u}; if (tid < 336 && tt_ >= 0) raw[j_] = *(const v4u*)(ubase + (size_t)tt_ * 5376); } } while (0)
        L2_LOAD(seg * 1024);
        __syncthreads();
#pragma unroll 1
        for (int st = 0; st < 16; ++st) {
            const int t0 = seg * 1024 + st * 64, par = st & 1;
            if (tid < 336) {
                f32x4 cwv[5][2];
#pragma unroll
                for (int j = 0; j < 5; ++j) { cwv[j][0] = *(const LAS f32x4*)(CWL + j * LRU_BD + ch8 * 8); cwv[j][1] = *(const LAS f32x4*)(CWL + j * LRU_BD + ch8 * 8 + 4); }
#pragma unroll
                for (int it = 0; it < 4; ++it) { float acc[8];
#pragma unroll
                    for (int e = 0; e < 8; ++e) acc[e] = cwv[4][e >> 2][e & 3];
#pragma unroll
                    for (int j = 0; j < 4; ++j) { const v4u rv = raw[it + j];
                        acc[0] += cwv[j][0][0] * bflo(rv.x); acc[1] += cwv[j][0][1] * bfhi(rv.x); acc[2] += cwv[j][0][2] * bflo(rv.y); acc[3] += cwv[j][0][3] * bfhi(rv.y);
                        acc[4] += cwv[j][1][0] * bflo(rv.z); acc[5] += cwv[j][1][1] * bfhi(rv.z); acc[6] += cwv[j][1][2] * bflo(rv.w); acc[7] += cwv[j][1][3] * bfhi(rv.w); }
                    v4u o; o.x = pk_bf16(acc[0], acc[1]); o.y = pk_bf16(acc[2], acc[3]); o.z = pk_bf16(acc[4], acc[5]); o.w = pk_bf16(acc[6], acc[7]);
                    *(LAS v4u*)(lds + L2_U + (4 * rg + it) * 336 + ch8 * 16) = o; } }
            if (st + 1 < 16) L2_LOAD(t0 + 64);
            __syncthreads();
            bf16x8 af[6];
#pragma unroll
            for (int ks = 0; ks < 6; ++ks) { v4u w = *(const LAS v4u*)(lds + L2_U + (16 * rt + fr) * 336 + ks * 64 + (ks < 5 ? fq * 16 : 0));
                if (ks == 5 && fq != 0) w = (v4u){0u, 0u, 0u, 0u}; af[ks] = __builtin_bit_cast(bf16x8, w); }
            float av[6][4], bv[6][4], Aex[6], Bex[6];
#pragma unroll
            for (int k = 0; k < 6; ++k) {
                const int ct = 6 * half + k; const int ch = 16 * ct + fr;
                f32x4 racc = (f32x4){0.f, 0.f, 0.f, 0.f}, iacc = (f32x4){0.f, 0.f, 0.f, 0.f};
                if (ct < 11) {
#pragma unroll
                    for (int ks = 0; ks < 6; ++ks) {
                        v4u wr = *(const LAS v4u*)(lds + L2_WT + (16 * ct + fr) * 336 + ks * 64 + (ks < 5 ? fq * 16 : 0));
                        v4u wi = *(const LAS v4u*)(lds + L2_WT + (176 + 16 * ct + fr) * 336 + ks * 64 + (ks < 5 ? fq * 16 : 0));
                        if (ks == 5 && fq != 0) { wr = (v4u){0u, 0u, 0u, 0u}; wi = (v4u){0u, 0u, 0u, 0u}; }
                        racc = MFMA16(af[ks], __builtin_bit_cast(bf16x8, wr), racc); iacc = MFMA16(af[ks], __builtin_bit_cast(bf16x8, wi), iacc); }
                }
                const int chs = (ch < LRU_BD) ? ch : 0; const int chc = (ch < 176) ? ch : 0; const float cbr = CHL[chc], cbi = CHL[176 + chc], cls = CHL[352 + chc];
                float A4 = 1.f, B4 = 0.f; float la2[4], bq[4];
#pragma unroll
                for (int r = 0; r < 4; ++r) { const float uu = bf2f(*(const LAS bf16*)(lds + L2_U + (16 * rt + 4 * fq + r) * 336 + chs * 2));
                    const float rgt = fast_rcp(1.f + __builtin_amdgcn_exp2f(-1.4426950408889634f * (racc[r] + cbr))), ig = fast_rcp(1.f + __builtin_amdgcn_exp2f(-1.4426950408889634f * (iacc[r] + cbi)));
                    la2[r] = rgt * cls; bq[r] = ig * uu; }
                v4u pkd; pkd.x = pk_bf16(la2[0], la2[1]); pkd.y = pk_bf16(la2[2], la2[3]);
                const float lr[4] = {bflo(pkd.x), bfhi(pkd.x), bflo(pkd.y), bfhi(pkd.y)}; float bbv[4];
#pragma unroll
                for (int r = 0; r < 4; ++r) { const float a = __builtin_amdgcn_exp2f(lr[r]); av[k][r] = a; bbv[r] = __builtin_amdgcn_sqrtf(fmaxf(1.f - a * a, 0.f)) * bq[r]; }
                pkd.z = pk_bf16(bbv[0], bbv[1]); pkd.w = pk_bf16(bbv[2], bbv[3]);
                const float br[4] = {bflo(pkd.z), bfhi(pkd.z), bflo(pkd.w), bfhi(pkd.w)};
#pragma unroll
                for (int r = 0; r < 4; ++r) { bv[k][r] = br[r]; B4 = av[k][r] * B4 + br[r]; A4 = av[k][r] * A4; }
                if (PASS == 1 && ct < 11) AB[((((size_t)unit * 16 + st) * 8 + wid) * 6 + k) * 64 + lane] = pkd;
#pragma unroll
                for (int off = 16; off < 64; off <<= 1) { const float Ap = __shfl_up(A4, off), Bp = __shfl_up(B4, off); if (lane >= off) { B4 = A4 * Bp + B4; A4 = A4 * Ap; } }
                float ae = __shfl_up(A4, 16), be = __shfl_up(B4, 16); if (fq == 0) { ae = 1.f; be = 0.f; }
                Aex[k] = ae; Bex[k] = be;
                if (fq == 3 && ct < 11) { XCH[(rt * 176 + ch) * 2] = A4; XCH[(rt * 176 + ch) * 2 + 1] = B4; }
            }
            __syncthreads();
            v4u greg[3];
            if (PASS == 3) {
#pragma unroll
                for (int k = 0; k < 3; ++k) { const int c3 = tid + 512 * k; greg[k] = (v4u){0u, 0u, 0u, 0u}; if (c3 < 64 * 21) greg[k] = *(const v4u*)(gbase + (size_t)(t0 + c3 / 21) * 5376 + (c3 % 21) * 8); } }
#pragma unroll
            for (int k = 0; k < 6; ++k) {
                const int ct = 6 * half + k; const int ch = 16 * ct + fr;
                if (ct < 11) {
                    float hin = CAR[par * 352 + 176 + ch], ain = CAR[par * 352 + ch];
#pragma unroll
                    for (int q = 0; q < 3; ++q) if (q < rt) { const float a2 = XCH[(q * 176 + ch) * 2], b2 = XCH[(q * 176 + ch) * 2 + 1]; hin = a2 * hin + b2; ain *= a2; }
                    if (PASS == 3) {
                        float hh = Aex[k] * hin + Bex[k];
#pragma unroll
                        for (int r = 0; r < 4; ++r) { hh = av[k][r] * hh + bv[k][r]; if (ch < LRU_BD) *(LAS bf16*)(lds + L2_U + (16 * rt + 4 * fq + r) * 336 + ch * 2) = f2bf16(hh); }
                        if (rt == 3 && fq == 3) CAR[(par ^ 1) * 352 + 176 + ch] = hh;
                    } else {
                        if (rt == 3 && fq == 3) { const float a3 = XCH[(3 * 176 + ch) * 2], b3 = XCH[(3 * 176 + ch) * 2 + 1];
                            CAR[(par ^ 1) * 352 + 176 + ch] = a3 * hin + b3; CAR[(par ^ 1) * 352 + ch] = ain * a3; }
                    }
                }
            }
            __syncthreads();
            if (PASS == 3) {
#pragma unroll
                for (int k = 0; k < 3; ++k) { const int c3 = tid + 512 * k;
                    if (c3 < 64 * 21) { const int t = c3 / 21, cc = c3 % 21; const v4u hv = *(const LAS v4u*)(lds + L2_U + t * 336 + cc * 16); const v4u gv = greg[k];
                        v4u o; o.x = pk_bf16(bflo(hv.x) * fast_gelu_tanh(bflo(gv.x)), bfhi(hv.x) * fast_gelu_tanh(bfhi(gv.x))); o.y = pk_bf16(bflo(hv.y) * fast_gelu_tanh(bflo(gv.y)), bfhi(hv.y) * fast_gelu_tanh(bfhi(gv.y)));
                        o.z = pk_bf16(bflo(hv.z) * fast_gelu_tanh(bflo(gv.z)), bfhi(hv.z) * fast_gelu_tanh(bfhi(gv.z))); o.w = pk_bf16(bflo(hv.w) * fast_gelu_tanh(bflo(gv.w)), bfhi(hv.w) * fast_gelu_tanh(bfhi(gv.w)));
                        *(v4u*)(YB + ((size_t)b * SEQ + t0 + t) * LRU_W + n * LRU_BD + cc * 8) = o; } }
                __syncthreads();
            }
        }
#undef L2_LOAD
        if (PASS == 1 && tid < LRU_BD) { const size_t o = ((size_t)b * 8 + seg) * LRU_W + n * LRU_BD + tid; SEG[o] = CAR[tid]; SEG[LRU_SEG + o] = CAR[176 + tid]; }
    }
}

__device__ __forceinline__ void lru3_pass(LAS unsigned char* lds, const bf16* PROJ, const float* SEG, bf16* YB, const v4u* AB, int wg, int nwg) {
    const int tid = threadIdx.x, lane = tid & 63, wid = __builtin_amdgcn_readfirstlane(tid >> 6), fr = lane & 15, fq = lane >> 4, rt = wid & 3, half = wid >> 2;
    LAS float* XCH = (LAS float*)(lds + L2_XCH);
    LAS float* CAR = (LAS float*)(lds + L2_CAR);
#pragma unroll 1
    for (int unit = wg; unit < 256; unit += nwg) {
        const int n = unit & 15, b = (unit >> 4) >> 3, seg = (unit >> 4) & 7;
        __syncthreads();
        if (tid < 176) { float cin = 0.f;
            if (tid < LRU_BD) { for (int sg = 0; sg < seg; ++sg) { const size_t o = ((size_t)b * 8 + sg) * LRU_W + n * LRU_BD + tid; cin = SEG[o] * cin + SEG[LRU_SEG + o]; } }
            CAR[tid] = cin; }
        const bf16* gbase = PROJ + ((size_t)b * SEQ) * 5376 + n * LRU_BD;
        const v4u* abase = AB + (((size_t)unit * 16) * 8 + wid) * 6 * 64 + lane;
        v4u abr[6];
#pragma unroll
        for (int k = 0; k < 6; ++k) abr[k] = (6 * half + k < 11) ? abase[k * 64] : (v4u){0u, 0u, 0u, 0u};
        __syncthreads();
#pragma unroll 1
        for (int st = 0; st < 16; ++st) {
            const int t0 = seg * 1024 + st * 64, par = st & 1;
            v4u greg[3];
#pragma unroll
            for (int k = 0; k < 3; ++k) { const int c3 = tid + 512 * k; greg[k] = (v4u){0u, 0u, 0u, 0u}; if (c3 < 64 * 21) greg[k] = *(const v4u*)(gbase + (size_t)(t0 + c3 / 21) * 5376 + (c3 % 21) * 8); }
            float av[6][4], bv[6][4], Aex[6], Bex[6];
#pragma unroll
            for (int k = 0; k < 6; ++k) { const int ct = 6 * half + k; const int ch = 16 * ct + fr; const v4u w = abr[k];
                const float lr[4] = {bflo(w.x), bfhi(w.x), bflo(w.y), bfhi(w.y)}, br[4] = {bflo(w.z), bfhi(w.z), bflo(w.w), bfhi(w.w)};
                float A4 = 1.f, B4 = 0.f;
#pragma unroll
                for (int r = 0; r < 4; ++r) { const float a = __builtin_amdgcn_exp2f(lr[r]); av[k][r] = a; bv[k][r] = br[r]; B4 = a * B4 + br[r]; A4 = a * A4; }
#pragma unroll
                for (int off = 16; off < 64; off <<= 1) { const float Ap = __shfl_up(A4, off), Bp = __shfl_up(B4, off); if (lane >= off) { B4 = A4 * Bp + B4; A4 = A4 * Ap; } }
                float ae = __shfl_up(A4, 16), be = __shfl_up(B4, 16); if (fq == 0) { ae = 1.f; be = 0.f; }
                Aex[k] = ae; Bex[k] = be;
                if (fq == 3 && ct < 11) { XCH[(rt * 176 + ch) * 2] = A4; XCH[(rt * 176 + ch) * 2 + 1] = B4; } }
            if (st + 1 < 16) {
#pragma unroll
                for (int k = 0; k < 6; ++k) abr[k] = (6 * half + k < 11) ? abase[(size_t)(st + 1) * 8 * 6 * 64 + k * 64] : (v4u){0u, 0u, 0u, 0u}; }
            __syncthreads();
#pragma unroll
            for (int k = 0; k < 6; ++k) { const int ct = 6 * half + k; const int ch = 16 * ct + fr;
                if (ct < 11) {
                    float hin = CAR[par * 176 + ch];
#pragma unroll
                    for (int q = 0; q < 3; ++q) if (q < rt) { const float a2 = XCH[(q * 176 + ch) * 2], b2 = XCH[(q * 176 + ch) * 2 + 1]; hin = a2 * hin + b2; }
                    float hh = Aex[k] * hin + Bex[k];
#pragma unroll
                    for (int r = 0; r < 4; ++r) { hh = av[k][r] * hh + bv[k][r]; if (ch < LRU_BD) *(LAS bf16*)(lds + L2_U + (16 * rt + 4 * fq + r) * 336 + ch * 2) = f2bf16(hh); }
                    if (rt == 3 && fq == 3) CAR[(par ^ 1) * 176 + ch] = hh;
                } }
            __syncthreads();
#pragma unroll
            for (int k = 0; k < 3; ++k) { const int c3 = tid + 512 * k;
                if (c3 < 64 * 21) { const int t = c3 / 21, cc = c3 % 21; const v4u hv = *(const LAS v4u*)(lds + L2_U + t * 336 + cc * 16); const v4u gv = greg[k];
                    v4u o; o.x = pk_bf16(bflo(hv.x) * fast_gelu_tanh(bflo(gv.x)), bfhi(hv.x) * fast_gelu_tanh(bfhi(gv.x))); o.y = pk_bf16(bflo(hv.y) * fast_gelu_tanh(bflo(gv.y)), bfhi(hv.y) * fast_gelu_tanh(bfhi(gv.y)));
                    o.z = pk_bf16(bflo(hv.z) * fast_gelu_tanh(bflo(gv.z)), bfhi(hv.z) * fast_gelu_tanh(bfhi(gv.z))); o.w = pk_bf16(bflo(hv.w) * fast_gelu_tanh(bflo(gv.w)), bfhi(hv.w) * fast_gelu_tanh(bfhi(gv.w)));
                    *(v4u*)(YB + ((size_t)b * SEQ + t0 + t) * LRU_W + n * LRU_BD + cc * 8) = o; } }
        }
    }
}

constexpr size_t ML_ARR = (size_t)8 * SEQ;
__device__ __forceinline__ void mlstm_pre(LAS unsigned char* lds, const float* G, const float* bif, float* MLS, int wg, int nwg) {
    const int tid = threadIdx.x, lane = tid & 63, wid = tid >> 6;
    LAS float* GG = (LAS float*)lds; LAS float* PP = GG + 128; LAS float* MP = PP + 128;
    float* ALPHA = MLS; float* BETA = MLS + ML_ARR; float* WI = MLS + 2 * ML_ARR; float* EMv = MLS + 3 * ML_ARR; float* WK = MLS + 4 * ML_ARR; float* DEC = MLS + 5 * ML_ARR;
    for (int u = wg; u < 8; u += nwg) {
        const int b = u >> 2, h = u & 3; const float bi = bif[h], bfg = bif[4 + h];
        float btv[16], bev[16], Pv[16];
#pragma unroll
        for (int i = 0; i < 16; ++i) { const size_t row = (size_t)b * SEQ + (wid * 16 + i) * 64 + lane; bev[i] = G[row * 16 + h] + bi; btv[i] = G[row * 16 + 4 + h] + bfg; }
        __syncthreads();
#pragma unroll
        for (int i = 0; i < 16; ++i) {
            float bt = log_sigmoid_f(btv[i]);
#pragma unroll
            for (int o = 1; o < 64; o <<= 1) { const float v = __shfl_up(bt, o); if (lane >= o) bt += v; }
            const float beta = bev[i] - bt; float P = beta;
#pragma unroll
            for (int o = 1; o < 64; o <<= 1) { const float v = __shfl_up(P, o); if (lane >= o) P = fmaxf(P, v); }
            btv[i] = bt; bev[i] = beta; Pv[i] = P;
            if (lane == 63) { GG[wid * 16 + i] = bt; PP[wid * 16 + i] = P; }
        }
        __syncthreads();
        if (tid == 0) { float m = -1e30f; for (int c = 0; c < 128; ++c) { MP[c] = m; m = GG[c] + fmaxf(m, PP[c]); } }
        __syncthreads();
#pragma unroll
        for (int i = 0; i < 16; ++i) { const int c = wid * 16 + i; const float m_prev = MP[c], g = GG[c], P63 = PP[c];
            const float bt = btv[i], beta = bev[i], mt = bt + fmaxf(m_prev, Pv[i]), m_new = g + fmaxf(m_prev, P63);
            const size_t o = (size_t)u * SEQ + c * 64 + lane;
            ALPHA[o] = bt - mt; BETA[o] = beta; WI[o] = expf(bt + m_prev - mt); EMv[o] = expf(-mt); { const float wkv = expf(g - m_new + beta) * 0.0625f; WK[o] = wkv; ((bf16*)(MLS + 6 * ML_ARR))[o] = f2bf16(wkv); }
            if (lane == 0) DEC[u * 128 + c] = expf(g + m_prev - m_new); }
    }
}

__device__ __forceinline__ void mlstm_post(const bf16* HB, const bf16* PROJ, const float* head_g, bf16* YB, int gw, int ngw, int lane) {
    for (int it = gw; it < MTOK * 4; it += ngw) {
        const int row = it >> 2, hh = it & 3;
        const v4u hv = *(const v4u*)(HB + (size_t)row * DM + hh * 512 + lane * 8);
        const v4u ov = *(const v4u*)(PROJ + (size_t)row * 4096 + 2048 + hh * 512 + lane * 8);
        float hf[8] = {bflo(hv.x), bfhi(hv.x), bflo(hv.y), bfhi(hv.y), bflo(hv.z), bfhi(hv.z), bflo(hv.w), bfhi(hv.w)};
        const float of[8] = {bflo(ov.x), bfhi(ov.x), bflo(ov.y), bfhi(ov.y), bflo(ov.z), bfhi(ov.z), bflo(ov.w), bfhi(ov.w)};
        float ss = 0.f;
#pragma unroll
        for (int e = 0; e < 8; ++e) ss += hf[e] * hf[e];
        const float r = rsqrtf(wave_sum(ss) * (1.f / 512.f) + EPS);
        const f32x4 g0 = *(const f32x4*)(head_g + hh * 512 + lane * 8), g1 = *(const f32x4*)(head_g + hh * 512 + lane * 8 + 4);
        const float gg[8] = {g0.x, g0.y, g0.z, g0.w, g1.x, g1.y, g1.z, g1.w};
#pragma unroll
        for (int e = 0; e < 8; ++e) hf[e] = sigmoid_f(of[e]) * (hf[e] * r * gg[e]);
        v4u w; w.x = pk_bf16(hf[0], hf[1]); w.y = pk_bf16(hf[2], hf[3]); w.z = pk_bf16(hf[4], hf[5]); w.w = pk_bf16(hf[6], hf[7]);
        *(v4u*)(YB + (size_t)row * DM + hh * 512 + lane * 8) = w;
    }
}

constexpr int MI_QT = 0, MI_KK = 33792, MI_VT = 67584, MI_ST = MI_VT + 528 * 144, MI_SC = MI_ST + 9216, MI_END = MI_SC + 512;
static_assert(MI_END <= LDSCTL_OFF, "mLSTM intra LDS map");
__device__ __forceinline__ void mlstm_intra(LAS unsigned char* lds, const bf16* PROJ, const bf16* VTM, const float* MLS, bf16* NUMI, bf16* KT, int wg, int nwg) {
    const int tid = threadIdx.x, lane = tid & 63, wid = __builtin_amdgcn_readfirstlane(tid >> 6), fr = lane & 15, fq = lane >> 4;
    LAS float* SC = (LAS float*)(lds + MI_SC);
    __syncthreads();
    for (int i = tid; i < 16 * 72; i += 512) { const int r = 512 + i / 72, c = i % 72; *(LAS bf16*)(lds + MI_VT + r * 144 + c * 2) = (r == 512) ? (bf16)0x3F80 : (bf16)0; }
#pragma unroll 1
    for (int u = wg; u < 1024; u += nwg) {
        const int bh = u >> 7, c = u & 127, b = bh >> 2, h = bh & 3, t0 = c * 64;
        const bf16* qbase = PROJ + ((size_t)b * SEQ + t0) * 4096 + h * 256;
        const bf16* vbase = VTM + ((size_t)h * 512) * MTOK + (size_t)b * SEQ + t0;
#pragma unroll
        for (int i = 0; i < 4; ++i) { const int cc = tid + 512 * i; const int row = cc >> 5, ch = cc & 31;
            const v4u qv = *(const v4u*)(qbase + (size_t)row * 4096 + ch * 8), kv = *(const v4u*)(qbase + 1024 + (size_t)row * 4096 + ch * 8);
            *(LAS v4u*)(lds + MI_QT + row * 528 + ch * 16) = qv; *(LAS v4u*)(lds + MI_KK + row * 528 + ch * 16) = kv; }
#pragma unroll
        for (int i = 0; i < 8; ++i) { const int cc = tid + 512 * i; const int e = cc >> 3, ch = cc & 7;
            *(LAS v4u*)(lds + MI_VT + e * 144 + ch * 16) = *(const v4u*)(vbase + (size_t)e * MTOK + ch * 8); }
        if (tid < 128) SC[tid] = MLS[(size_t)(tid >> 6) * ML_ARR + (size_t)bh * SEQ + t0 + (tid & 63)];
        __syncthreads();
#pragma unroll
        for (int i = 0; i < 4; ++i) { const int item = tid + 512 * i; const int sg = item & 7, d = item >> 3; unsigned short e[8];
#pragma unroll
            for (int q = 0; q < 8; ++q) e[q] = *(const LAS bf16*)(lds + MI_KK + (8 * sg + q) * 528 + d * 2);
            v4u o; o.x = (unsigned)e[0] | ((unsigned)e[1] << 16); o.y = (unsigned)e[2] | ((unsigned)e[3] << 16); o.z = (unsigned)e[4] | ((unsigned)e[5] << 16); o.w = (unsigned)e[6] | ((unsigned)e[7] << 16);
            *(v4u*)(KT + ((size_t)h * 256 + d) * MTOK + (size_t)b * SEQ + t0 + 8 * sg) = o; }
        { const int tt = wid >> 1;
#pragma unroll
          for (int si = 0; si < 2; ++si) { const int stl = 2 * (wid & 1) + si;
              u32x2 w = (u32x2){0u, 0u};
              if (stl <= tt) {
                  f32x4 acc = (f32x4){0.f, 0.f, 0.f, 0.f};
#pragma unroll
                  for (int ks = 0; ks < 8; ++ks) { const bf16x8 af = *(const LAS bf16x8*)(lds + MI_KK + (16 * stl + fr) * 528 + ks * 64 + fq * 16);
                      const bf16x8 bfr = *(const LAS bf16x8*)(lds + MI_QT + (16 * tt + fr) * 528 + ks * 64 + fq * 16); acc = MFMA16(af, bfr, acc); }
                  const int t = 16 * tt + fr; const float al = SC[t]; const f32x4 be = *(const LAS f32x4*)(SC + 64 + 16 * stl + 4 * fq);
                  float sv[4];
#pragma unroll
                  for (int r = 0; r < 4; ++r) { const int s = 16 * stl + 4 * fq + r; sv[r] = (s <= t) ? acc[r] * 0.0625f * __expf(al + be[r]) : 0.f; }
                  w.x = pk_bf16(sv[0], sv[1]); w.y = pk_bf16(sv[2], sv[3]);
              }
              *(LAS u32x2*)(lds + MI_ST + (16 * tt + fr) * 144 + (16 * stl + 4 * fq) * 2) = w; } }
        __syncthreads();
        { const int tt = wid >> 1;
          const bf16x8 b0 = *(const LAS bf16x8*)(lds + MI_ST + (16 * tt + fr) * 144 + fq * 16), b1 = *(const LAS bf16x8*)(lds + MI_ST + (16 * tt + fr) * 144 + 64 + fq * 16);
          bf16* op = NUMI + (((size_t)b * SEQ + t0 + 16 * tt + fr) * 4 + h) * 528 + 4 * fq;
#pragma unroll 3
          for (int et = (wid & 1); et < 33; et += 2) {
              const bf16x8 a0 = *(const LAS bf16x8*)(lds + MI_VT + (16 * et + fr) * 144 + fq * 16), a1 = *(const LAS bf16x8*)(lds + MI_VT + (16 * et + fr) * 144 + 64 + fq * 16);
              f32x4 acc = (f32x4){0.f, 0.f, 0.f, 0.f};
              acc = MFMA16(a0, b0, acc); acc = MFMA16(a1, b1, acc);
              u32x2 w; w.x = pk_bf16(acc[0], acc[1]); w.y = pk_bf16(acc[2], acc[3]);
              *(u32x2*)(op + 16 * et) = w; } }
        __syncthreads();
    }
}

constexpr int M2_QT = 0, M2_KT = 33792, M2_CET = M2_KT + 36864, M2_VEW = M2_CET + 2 * 33792, M2_NST = M2_VEW + 9216, M2_SC = M2_NST + 2048, M2_END = M2_SC + 1024;
static_assert(M2_END <= LDSCTL_OFF, "mLSTM inter LDS map");
constexpr size_t ML_CS_FLOATS = (size_t)8 * 4 * 256 * 512, ML_NS_FLOATS = (size_t)8 * 4 * 256;
template <int PASS>
__device__ __forceinline__ void mlstm_walk(LAS unsigned char* lds, const bf16* PROJ, const bf16* KT, const bf16* VTM, const float* MLS, const bf16* NUMI, float* CLOC, float* CSt, float* NLOC, float* NSt, bf16* HB, int wg, int nwg) {
    const int tid = threadIdx.x, lane = tid & 63, wid = __builtin_amdgcn_readfirstlane(tid >> 6), fr = lane & 15, fq = lane >> 4;
    const float* DEC = MLS + 5 * ML_ARR;
    LAS float* SC = (LAS float*)(lds + M2_SC);
#pragma unroll 1
    for (int unit = wg; unit < 256; unit += nwg) {
        const int bh = unit >> 5, sl = (unit >> 2) & 7, seg = unit & 3, b = bh >> 2, h = bh & 3, e0 = sl * 64, c_lo = seg * 32;
        __syncthreads();
        f32x4 cst[2][4];
        const size_t csoff = (((size_t)bh * 4 + seg) * 256) * 512;
        if (PASS == 3) {
            float dsg[3];
#pragma unroll
            for (int sg = 0; sg < 3; ++sg) { float p = 1.f;
#pragma unroll 1
                for (int c = 0; c < 32; ++c) p *= ld_agent_f32(DEC + bh * 128 + sg * 32 + c);
                dsg[sg] = p; }
#pragma unroll
            for (int i = 0; i < 2; ++i)
#pragma unroll
                for (int j = 0; j < 4; ++j)
#pragma unroll
                    for (int r = 0; r < 4; ++r) { float st = 0.f;
#pragma unroll
                        for (int sg = 0; sg < 3; ++sg) if (sg < seg) st = st * dsg[sg] + CLOC[(((size_t)bh * 4 + sg) * 256 + 16 * (2 * wid + i) + 4 * fq + r) * 512 + e0 + 16 * j + fr];
                        cst[i][j][r] = st; }
            if (tid < 256) { float st = 0.f;
#pragma unroll
                for (int sg = 0; sg < 3; ++sg) if (sg < seg) st = st * dsg[sg] + NLOC[((size_t)bh * 4 + sg) * 256 + tid];
                ((LAS float*)(lds + M2_NST))[tid] = st; }
#pragma unroll
            for (int i = 0; i < 2; ++i)
#pragma unroll
                for (int j = 0; j < 4; ++j) { u32x2 w; w.x = pk_bf16(cst[i][j][0], cst[i][j][1]); w.y = pk_bf16(cst[i][j][2], cst[i][j][3]);
                    *(LAS u32x2*)(lds + M2_CET + (16 * j + fr) * 528 + (16 * (2 * wid + i) + 4 * fq) * 2) = w; }
        } else {
#pragma unroll
            for (int i = 0; i < 2; ++i)
#pragma unroll
                for (int j = 0; j < 4; ++j) cst[i][j] = (f32x4){0.f, 0.f, 0.f, 0.f};
            if (tid < 256) ((LAS float*)(lds + M2_NST))[tid] = 0.f;
        }
        const bf16* qbase = PROJ + ((size_t)b * SEQ) * 4096 + h * 256;
        const bf16* ktbase = KT + ((size_t)h * 256) * MTOK + (size_t)b * SEQ;
        const bf16* vbase = VTM + ((size_t)h * 512 + e0) * MTOK + (size_t)b * SEQ;
        const size_t sbase = (size_t)bh * SEQ;
        const int tt = wid >> 1, eh = wid & 1;
        const bf16* nbase = NUMI + (((size_t)b * SEQ + 16 * tt + fr) * 4 + h) * 528;
        v4u qreg[4], ktreg[4], vreg, wkb; float screg = 0.f; u32x2 nreg[2]; unsigned short dreg = 0;
#define M2_LOAD(t0_) do { _Pragma("unroll") for (int i_ = 0; i_ < 4; ++i_) { const int c_ = tid + 512 * i_; const int row_ = c_ >> 5, ch_ = c_ & 31; \
            if (PASS == 3) qreg[i_] = *(const v4u*)(qbase + (size_t)((t0_) + row_) * 4096 + ch_ * 8); \
            const int d_ = c_ >> 3, kc_ = c_ & 7; ktreg[i_] = *(const v4u*)(ktbase + (size_t)d_ * MTOK + (t0_) + kc_ * 8); } \
        { const int e_ = tid >> 3, ch_ = tid & 7; vreg = *(const v4u*)(vbase + (size_t)e_ * MTOK + (t0_) + ch_ * 8); \
            wkb = *(const v4u*)((const bf16*)(MLS + 6 * ML_ARR) + sbase + (t0_) + ch_ * 8); } \
        if (tid < 192) { const int a_ = 2 + (tid >> 6), s_ = tid & 63; screg = MLS[(size_t)a_ * ML_ARR + sbase + (t0_) + s_]; } \
        if (PASS == 3) { _Pragma("unroll") for (int jj_ = 0; jj_ < 2; ++jj_) nreg[jj_] = *(const u32x2*)(nbase + (size_t)(t0_) * 4 * 528 + e0 + 16 * (2 * eh + jj_) + 4 * fq); dreg = nbase[(size_t)(t0_) * 4 * 528 + 512]; } } while (0)
        M2_LOAD(c_lo * 64);
#pragma unroll 1
        for (int c = c_lo; c < c_lo + 32; ++c) {
            const int t0 = c * 64, par = c & 1;
            const LAS unsigned char* cet_rd = lds + M2_CET + par * 33792; LAS unsigned char* cet_wr = lds + M2_CET + (par ^ 1) * 33792;
            const LAS float* nst_rd = (const LAS float*)(lds + M2_NST) + par * 256; LAS float* nst_wr = (LAS float*)(lds + M2_NST) + (par ^ 1) * 256;
#pragma unroll
            for (int i = 0; i < 4; ++i) { const int cc = tid + 512 * i; const int row = cc >> 5, ch = cc & 31;
                if (PASS == 3) *(LAS v4u*)(lds + M2_QT + row * 528 + ch * 16) = qreg[i];
                const int d = cc >> 3, kc = cc & 7; *(LAS v4u*)(lds + M2_KT + d * 144 + kc * 16) = ktreg[i]; }
            { const int e = tid >> 3, ch = tid & 7; v4u o;
                o.x = pk_bf16(bflo(vreg.x) * bflo(wkb.x), bfhi(vreg.x) * bfhi(wkb.x)); o.y = pk_bf16(bflo(vreg.y) * bflo(wkb.y), bfhi(vreg.y) * bfhi(wkb.y));
                o.z = pk_bf16(bflo(vreg.z) * bflo(wkb.z), bfhi(vreg.z) * bfhi(wkb.z)); o.w = pk_bf16(bflo(vreg.w) * bflo(wkb.w), bfhi(vreg.w) * bfhi(wkb.w));
                *(LAS v4u*)(lds + M2_VEW + e * 144 + ch * 16) = o; }
            if (tid < 192) SC[tid] = screg;
            const u32x2 numi0 = nreg[0], numi1 = nreg[1]; const float deni = bf2f(dreg);
            const float dec = ld_agent_f32(DEC + bh * 128 + c);
            __syncthreads();
            if (c + 1 < c_lo + 32) M2_LOAD(t0 + 64);
            if (PASS == 3) {
                float dot = 0.f;
#pragma unroll
                for (int i = 0; i < 8; ++i) { const v4u qv = *(const LAS v4u*)(lds + M2_QT + (16 * tt + fr) * 528 + fq * 128 + i * 16); const LAS float* np = nst_rd + fq * 64 + i * 8;
                    const f32x4 n0 = *(const LAS f32x4*)np, n1 = *(const LAS f32x4*)(np + 4);
                    dot += bflo(qv.x) * n0[0] + bfhi(qv.x) * n0[1] + bflo(qv.y) * n0[2] + bfhi(qv.y) * n0[3] + bflo(qv.z) * n1[0] + bfhi(qv.z) * n1[1] + bflo(qv.w) * n1[2] + bfhi(qv.w) * n1[3]; }
                dot += __shfl_xor(dot, 16); dot += __shfl_xor(dot, 32);
                f32x4 acc0 = (f32x4){0.f, 0.f, 0.f, 0.f}, acc1 = acc0;
#pragma unroll
                for (int ks = 0; ks < 8; ++ks) { const bf16x8 bfr = *(const LAS bf16x8*)(lds + M2_QT + (16 * tt + fr) * 528 + ks * 64 + fq * 16);
                    const bf16x8 a0 = *(const LAS bf16x8*)(cet_rd + (16 * (2 * eh) + fr) * 528 + ks * 64 + fq * 16), a1 = *(const LAS bf16x8*)(cet_rd + (16 * (2 * eh + 1) + fr) * 528 + ks * 64 + fq * 16);
                    acc0 = MFMA16(a0, bfr, acc0); acc1 = MFMA16(a1, bfr, acc1); }
                const int t = 16 * tt + fr; const float wi = SC[t], em = SC[64 + t], den = wi * dot + deni; const float inv = __builtin_amdgcn_rcpf(fmaxf(fabsf(den), em));
                bf16* hp = HB + ((size_t)b * SEQ + t0 + t) * DM + h * 512 + e0 + 32 * eh + 4 * fq;
                { u32x2 w; w.x = pk_bf16((acc0[0] * wi + bflo(numi0.x)) * inv, (acc0[1] * wi + bfhi(numi0.x)) * inv); w.y = pk_bf16((acc0[2] * wi + bflo(numi0.y)) * inv, (acc0[3] * wi + bfhi(numi0.y)) * inv); *(u32x2*)hp = w; }
                { u32x2 w; w.x = pk_bf16((acc1[0] * wi + bflo(numi1.x)) * inv, (acc1[1] * wi + bfhi(numi1.x)) * inv); w.y = pk_bf16((acc1[2] * wi + bflo(numi1.y)) * inv, (acc1[3] * wi + bfhi(numi1.y)) * inv); *(u32x2*)(hp + 16) = w; }
            }
#pragma unroll
            for (int i = 0; i < 2; ++i) {
                const bf16x8 af0 = *(const LAS bf16x8*)(lds + M2_KT + (16 * (2 * wid + i) + fr) * 144 + fq * 16), af1 = *(const LAS bf16x8*)(lds + M2_KT + (16 * (2 * wid + i) + fr) * 144 + 64 + fq * 16);
#pragma unroll
                for (int j = 0; j < 4; ++j) {
#pragma unroll
                    for (int r = 0; r < 4; ++r) cst[i][j][r] *= dec;
                    const bf16x8 b0 = *(const LAS bf16x8*)(lds + M2_VEW + (16 * j + fr) * 144 + fq * 16), b1 = *(const LAS bf16x8*)(lds + M2_VEW + (16 * j + fr) * 144 + 64 + fq * 16);
                    cst[i][j] = MFMA16(af0, b0, cst[i][j]); cst[i][j] = MFMA16(af1, b1, cst[i][j]);
                    if (PASS == 3) { u32x2 w; w.x = pk_bf16(cst[i][j][0], cst[i][j][1]); w.y = pk_bf16(cst[i][j][2], cst[i][j][3]);
                        *(LAS u32x2*)(cet_wr + (16 * j + fr) * 528 + (16 * (2 * wid + i) + 4 * fq) * 2) = w; } } }
            if (tid < 256) { float a = nst_rd[tid] * dec;
#pragma unroll
                for (int i = 0; i < 8; ++i) { const v4u kv = *(const LAS v4u*)(lds + M2_KT + tid * 144 + i * 16); const f32x4 w0 = *(const LAS f32x4*)(SC + 128 + 8 * i), w1 = *(const LAS f32x4*)(SC + 128 + 8 * i + 4);
                    a += bflo(kv.x) * w0[0] + bfhi(kv.x) * w0[1] + bflo(kv.y) * w0[2] + bfhi(kv.y) * w0[3] + bflo(kv.z) * w1[0] + bfhi(kv.z) * w1[1] + bflo(kv.w) * w1[2] + bfhi(kv.w) * w1[3]; }
                nst_wr[tid] = a; }
            __syncthreads();
        }
#undef M2_LOAD
        if (PASS == 1) {
#pragma unroll
            for (int i = 0; i < 2; ++i)
#pragma unroll
                for (int j = 0; j < 4; ++j)
#pragma unroll
                    for (int r = 0; r < 4; ++r) CLOC[csoff + (size_t)(16 * (2 * wid + i) + 4 * fq + r) * 512 + e0 + 16 * j + fr] = cst[i][j][r];
            if (sl == 0 && tid < 256) NLOC[((size_t)bh * 4 + seg) * 256 + tid] = ((const LAS float*)(lds + M2_NST))[tid];
        }
    }
}

struct Args { const float* in[22]; float* out; unsigned char* ws; TrJob jobs[NJOBS]; int grp_job_lo[7]; int grp_items[6]; int ph_lo, ph_hi; int pad; };
enum PhaseId { PH_P0, PH_FOX_IN, PH_FOX_CUM, PH_FOX_ATT, PH_FOX_OUT, PH_L0_MID, PH_L0_UP, PH_L0_DOWN, PH_L0_UPB, PH_L0_DOWNB, PH_L0_END, PH_LRU_IN, PH_LRU_P1, PH_LRU_P3, PH_LRU_OUT, PH_L1_MID, PH_L1_UP, PH_L1_DOWN, PH_L1_UPB, PH_L1_DOWNB, PH_L1_END, PH_SB_IN, PH_SB_ATT, PH_SB_OUT, PH_L2_MID, PH_L2_UP, PH_L2_DOWN, PH_L2_UPB, PH_L2_DOWNB, PH_L2_END, PH_ML_IN, PH_ML_PRE, PH_ML_INTRA, PH_ML_W1, PH_ML_W3, PH_ML_POST, PH_ML_OUT, PH_L3_MID, PH_L3_UP, PH_L3_DOWN, PH_L3_UPB, PH_L3_DOWNB, PH_L3_END, NPH };

#define GEMM_CALL(ACT_, Aptr, Bptr, Mv, Nv, Kv, Optr, ldc_, gcol_, Gptr, ng_, rs_, cs_) do { \
        pg8::Gemm g_{(const pg8::bf16_t*)(Aptr), (const pg8::bf16_t*)(Bptr), (Mv), (Nv), (Kv)}; pg8::StaticOrder S_; S_.init((Mv), (Nv), (int)gridDim.x, (int)blockIdx.x); \
        pg8::EpiStore<ACT_> E_{(pg8::bf16_t*)(Optr), (ldc_), (gcol_), (Gptr), (ng_), (rs_), (cs_)}; \
        pg8::gemm_phase<pg8::EpiStore<ACT_>, pg8::StaticOrder, true, true>(lds, g_, S_, E_); } while (0)

#define CONVERT_GROUP(g_, first_wg_) do { if (wg >= (first_wg_)) { LAS float* scr_ = (LAS float*)(lds + wave * 8704); const int jlo_ = args.grp_job_lo[g_], jhi_ = args.grp_job_lo[(g_) + 1]; \
        for (int it_ = (wg - (first_wg_)) * NWAVES + wave; it_ < args.grp_items[g_]; it_ += (G - (first_wg_)) * NWAVES) { int j_ = jlo_; \
            _Pragma("unroll 1") for (int q_ = jlo_ + 1; q_ < jhi_; ++q_) if (it_ >= args.jobs[q_].item0) j_ = q_; \
            const TrJob jb_ = args.jobs[j_]; tr_item(jb_.src, jb_.gk, jb_.ldw, jb_.ncols, jb_.K, jb_.dst, scr_, it_ - jb_.item0, lane); } } } while (0)

__global__ void __launch_bounds__(NWAVES * 64, 2) fwd_kernel(Args args) {
    extern __shared__ __attribute__((aligned(16))) unsigned char lds_raw[];
    LAS unsigned char* lds = (LAS unsigned char*)lds_raw;
    volatile LAS unsigned* MISC = (volatile LAS unsigned*)(lds + LDSCTL_OFF);
    const int tid = threadIdx.x, lane = tid & 63, wave = __builtin_amdgcn_readfirstlane(tid >> 6);
    const int G = gridDim.x, wg = blockIdx.x;
    const int gw = wg * NWAVES + wave, ngw = G * NWAVES;
    for (int u = tid; u < 64; u += NWAVES * 64) MISC[u] = 0u;
    __syncthreads();
    const int lo = args.ph_lo, hi = args.ph_hi;
    const int SLOT_WG = (G == 256) ? 64 : 0;
    const bool use_bar = (hi - lo) > 1;
    XcdBarrier bar; bar.bar = (unsigned*)(args.ws + WS_CTL) + 4096; bar.x = 0; bar.st = nullptr;
    if (use_bar) bar = xcd_barrier_post((unsigned*)(args.ws + WS_CTL) + 4096, MISC + 8);
#ifdef ONLY_PHASE
#define IN(k) ((k) == ONLY_PHASE && lo <= (k) && (k) < hi)
#else
#define IN(k) (lo <= (k) && (k) < hi)
#endif
#define SEAM(k) do { if (IN((k) + 1)) xcd_barrier(bar); } while (0)
#ifndef PROBE_MASK
#define PROBE_MASK 0ull
#endif
#define NREP(k) ((((unsigned long long)(PROBE_MASK) >> (k)) & 1ull) ? 2 : 1)
#define PHASE(k, ...) if (IN(k)) { _Pragma("unroll 1") for (int rep_ = 0; rep_ < NREP(k); ++rep_) { __VA_ARGS__; if (rep_ + 1 < NREP(k)) xcd_barrier(bar); } SEAM(k); }

#define x_in (args.in[0])
#define norm_g (args.in[1])
#define out (args.out)
#define WSP(T, off) ((T*)(args.ws + (off)))
#define W_FOXIN WSP(bf16, WS_W_FOXIN)
#define W_FOXOUT WSP(bf16, WS_W_FOXOUT)
#define W_LRUIN WSP(bf16, WS_W_LRUIN)
#define W_LRUOUT WSP(bf16, WS_W_LRUOUT)
#define W_SBIN WSP(bf16, WS_W_SBIN)
#define W_SBOUT WSP(bf16, WS_W_SBOUT)
#define W_MLIN WSP(bf16, WS_W_MLIN)
#define W_MLOUT WSP(bf16, WS_W_MLOUT)
#define W1 WSP(bf16, WS_W1)
#define W2 WSP(bf16, WS_W2)
#define H WSP(bf16, WS_H)
#define HM WSP(bf16, WS_HM)
#define PROJ WSP(bf16, WS_PROJ)
#define VT WSP(bf16, WS_PROJ + WS_VT_OFF)
#define Y WSP(bf16, WS_Y)
#define HID WSP(bf16, WS_HID)
#define KT WSP(bf16, WS_KT)
#define GATES WSP(float, WS_GATES)
#define CUM WSP(float, WS_CUM)
#define MLS WSP(float, WS_MLS)
#define KNORM WSP(float, WS_KN)
#define R2V WSP(float, WS_R2)
#define ML_NUMI WSP(bf16, WS_Y)
#define ML_CLOC WSP(float, WS_MLST)
#define ML_CS WSP(float, WS_MLST + 16 * MiB)
#define ML_NLOC WSP(float, WS_MLST + 32 * MiB)
#define ML_NS WSP(float, WS_MLST + 32 * MiB + 65536)
#define LRU_SEGS WSP(float, WS_LRU_SEG)
#define LRU_WGT WSP(bf16, WS_LRU_WGT)
#define LRU_AB WSP(v4u, WS_MLST)

    PHASE(PH_P0,
        CONVERT_GROUP(0, 0);
        gate_rows(args.in[4], norm_g, 6160, 6144, 16, W_FOXIN + (size_t)4096 * DM, wg * 512 + tid, G * 512);
        gate_rows(args.in[18], norm_g + 12 * DM, 6152, 6144, 8, W_MLIN + (size_t)4096 * DM, wg * 512 + tid, G * 512);
        lru_wgt_prep(args.in[10], args.in[12], LRU_WGT, wg * 512 + tid, G * 512);
        row_first(x_in, H, R2V, gw, ngw, lane))
    PHASE(PH_FOX_IN, GEMM_CALL(0, H, W_FOXIN, MTOK, 4352, DM, PROJ, 4096, 4096, GATES, 16, R2V, nullptr);
             GEMM_CALL(0, W_FOXIN + (size_t)4352 * DM, H, 2048, MTOK, DM, VT, MTOK, INT_MAX, nullptr, 0, nullptr, R2V); CONVERT_GROUP(1, SLOT_WG))
    PHASE(PH_FOX_CUM, fox_cumsum(lds, GATES, args.in[5], CUM, wg, G); fox_knorm(PROJ, KNORM, gw, ngw, lane); __syncthreads(); CONVERT_GROUP(4, (G == 256) ? 32 : 0))
    PHASE(PH_FOX_ATT, attn_phase<0>(lds, PROJ, VT, CUM, KNORM, Y, (unsigned*)(args.ws + WS_CTL) + 1024))
    PHASE(PH_FOX_OUT, GEMM_CALL(0, Y, W_FOXOUT, MTOK, DM, DM, HM, DM, INT_MAX, nullptr, 0, nullptr, nullptr))
    PHASE(PH_L0_MID, row_upd<false>(H, HM, norm_g + 1 * DM, R2V, nullptr, gw, ngw, lane))
    PHASE(PH_L0_UP, GEMM_CALL(2, H, W1, MTOK / 2, DFF, DM, HID, DFF, INT_MAX, nullptr, 0, R2V, nullptr))
    PHASE(PH_L0_DOWN, GEMM_CALL(0, HID, W2, MTOK / 2, DM, DFF, HM, DM, INT_MAX, nullptr, 0, nullptr, nullptr))
    PHASE(PH_L0_UPB, GEMM_CALL(2, H + (size_t)(MTOK / 2) * DM, W1, MTOK / 2, DFF, DM, HID, DFF, INT_MAX, nullptr, 0, R2V + MTOK / 2, nullptr))
    PHASE(PH_L0_DOWNB, GEMM_CALL(0, HID, W2, MTOK / 2, DM, DFF, HM + (size_t)(MTOK / 2) * DM, DM, INT_MAX, nullptr, 0, nullptr, nullptr))
    PHASE(PH_L0_END, row_upd<false>(H, HM, norm_g + 3 * DM, R2V, nullptr, gw, ngw, lane))
    PHASE(PH_LRU_IN, GEMM_CALL(0, H, W_LRUIN, MTOK, 5376, DM, PROJ, 5376, INT_MAX, nullptr, 0, R2V, nullptr); CONVERT_GROUP(2, SLOT_WG))
    PHASE(PH_LRU_P1, lru2_pass<1>(lds, PROJ, LRU_WGT, args.in[8], args.in[9], args.in[11], args.in[13], args.in[14], LRU_SEGS, Y, LRU_AB, wg, G))
    PHASE(PH_LRU_P3, lru3_pass(lds, PROJ, LRU_SEGS, Y, LRU_AB, wg, G))
    PHASE(PH_LRU_OUT, GEMM_CALL(0, Y, W_LRUOUT, MTOK, DM, LRU_W, HM, DM, INT_MAX, nullptr, 0, nullptr, nullptr))
    PHASE(PH_L1_MID, row_upd<false>(H, HM, norm_g + 5 * DM, R2V, nullptr, gw, ngw, lane))
    PHASE(PH_L1_UP, GEMM_CALL(2, H, W1 + (size_t)1 * DFF * DM, MTOK / 2, DFF, DM, HID, DFF, INT_MAX, nullptr, 0, R2V, nullptr))
    PHASE(PH_L1_DOWN, GEMM_CALL(0, HID, W2 + (size_t)1 * DFF * DM, MTOK / 2, DM, DFF, HM, DM, INT_MAX, nullptr, 0, nullptr, nullptr))
    PHASE(PH_L1_UPB, GEMM_CALL(2, H + (size_t)(MTOK / 2) * DM, W1 + (size_t)1 * DFF * DM, MTOK / 2, DFF, DM, HID, DFF, INT_MAX, nullptr, 0, R2V + MTOK / 2, nullptr))
    PHASE(PH_L1_DOWNB, GEMM_CALL(0, HID, W2 + (size_t)1 * DFF * DM, MTOK / 2, DM, DFF, HM + (size_t)(MTOK / 2) * DM, DM, INT_MAX, nullptr, 0, nullptr, nullptr))
    PHASE(PH_L1_END, row_upd<false>(H, HM, norm_g + 7 * DM, R2V, nullptr, gw, ngw, lane))
    PHASE(PH_SB_IN, GEMM_CALL(0, H, W_SBIN, MTOK, 4096, DM, PROJ, 4096, INT_MAX, nullptr, 0, R2V, nullptr);
              GEMM_CALL(0, W_SBIN + (size_t)4096 * DM, H, 2048, MTOK, DM, VT, MTOK, INT_MAX, nullptr, 0, nullptr, R2V))
    PHASE(PH_SB_ATT, attn_phase<1>(lds, PROJ, VT, CUM, KNORM, Y, (unsigned*)(args.ws + WS_CTL) + 1088))
    PHASE(PH_SB_OUT, GEMM_CALL(0, Y, W_SBOUT, MTOK, DM, DM, HM, DM, INT_MAX, nullptr, 0, nullptr, nullptr))
    PHASE(PH_L2_MID, row_upd<false>(H, HM, norm_g + 9 * DM, R2V, nullptr, gw, ngw, lane))
    PHASE(PH_L2_UP, GEMM_CALL(2, H, W1 + (size_t)2 * DFF * DM, MTOK / 2, DFF, DM, HID, DFF, INT_MAX, nullptr, 0, R2V, nullptr))
    PHASE(PH_L2_DOWN, GEMM_CALL(0, HID, W2 + (size_t)2 * DFF * DM, MTOK / 2, DM, DFF, HM, DM, INT_MAX, nullptr, 0, nullptr, nullptr))
    PHASE(PH_L2_UPB, GEMM_CALL(2, H + (size_t)(MTOK / 2) * DM, W1 + (size_t)2 * DFF * DM, MTOK / 2, DFF, DM, HID, DFF, INT_MAX, nullptr, 0, R2V + MTOK / 2, nullptr))
    PHASE(PH_L2_DOWNB, GEMM_CALL(0, HID, W2 + (size_t)2 * DFF * DM, MTOK / 2, DM, DFF, HM + (size_t)(MTOK / 2) * DM, DM, INT_MAX, nullptr, 0, nullptr, nullptr))
    PHASE(PH_L2_END, row_upd<false>(H, HM, norm_g + 11 * DM, R2V, nullptr, gw, ngw, lane))
    PHASE(PH_ML_IN, GEMM_CALL(0, H, W_MLIN, MTOK, 4352, DM, PROJ, 4096, 4096, GATES, 8, R2V, nullptr);
              GEMM_CALL(0, W_MLIN + (size_t)4352 * DM, H, 2048, MTOK, DM, VT, MTOK, INT_MAX, nullptr, 0, nullptr, R2V); CONVERT_GROUP(3, SLOT_WG))
    PHASE(PH_ML_PRE, mlstm_pre(lds, GATES, args.in[19], MLS, wg, G); __syncthreads(); CONVERT_GROUP(5, (G == 256) ? 8 : 0))
    PHASE(PH_ML_INTRA, mlstm_intra(lds, PROJ, VT, MLS, ML_NUMI, KT, wg, G))
    PHASE(PH_ML_W1, mlstm_walk<1>(lds, PROJ, KT, VT, MLS, ML_NUMI, ML_CLOC, ML_CS, ML_NLOC, ML_NS, HM, wg, G))
    PHASE(PH_ML_W3, mlstm_walk<3>(lds, PROJ, KT, VT, MLS, ML_NUMI, ML_CLOC, ML_CS, ML_NLOC, ML_NS, HM, wg, G))
    PHASE(PH_ML_POST, mlstm_post(HM, PROJ, args.in[20], Y, gw, ngw, lane))
    PHASE(PH_ML_OUT, GEMM_CALL(0, Y, W_MLOUT, MTOK, DM, DM, HM, DM, INT_MAX, nullptr, 0, nullptr, nullptr))
    PHASE(PH_L3_MID, row_upd<false>(H, HM, norm_g + 13 * DM, R2V, nullptr, gw, ngw, lane))
    PHASE(PH_L3_UP, GEMM_CALL(2, H, W1 + (size_t)3 * DFF * DM, MTOK / 2, DFF, DM, HID, DFF, INT_MAX, nullptr, 0, R2V, nullptr))
    PHASE(PH_L3_DOWN, GEMM_CALL(0, HID, W2 + (size_t)3 * DFF * DM, MTOK / 2, DM, DFF, HM, DM, INT_MAX, nullptr, 0, nullptr, nullptr))
    PHASE(PH_L3_UPB, GEMM_CALL(2, H + (size_t)(MTOK / 2) * DM, W1 + (size_t)3 * DFF * DM, MTOK / 2, DFF, DM, HID, DFF, INT_MAX, nullptr, 0, R2V + MTOK / 2, nullptr))
    PHASE(PH_L3_DOWNB, GEMM_CALL(0, HID, W2 + (size_t)3 * DFF * DM, MTOK / 2, DM, DFF, HM + (size_t)(MTOK / 2) * DM, DM, INT_MAX, nullptr, 0, nullptr, nullptr))
    if (IN(PH_L3_END)) { row_upd<true>(H, HM, norm_g + 15 * DM, nullptr, out, gw, ngw, lane); }
#undef IN
#undef SEAM
}
#undef x_in
#undef norm_g
#undef out
#undef WSP
#undef W_FOXIN
#undef W_FOXOUT
#undef W_LRUIN
#undef W_LRUOUT
#undef W_SBIN
#undef W_SBOUT
#undef W_MLIN
#undef W_MLOUT
#undef W1
#undef W2
#undef H
#undef HM
#undef PROJ
#undef VT
#undef Y
#undef HID
#undef KT
#undef GATES
#undef CUM
#undef MLS
#undef KNORM
#undef R2V
#undef ML_NUMI
#undef ML_CLOC
#undef ML_CS
#undef ML_NLOC
#undef ML_NS
#undef LRU_SEGS
#undef LRU_WGT
#undef LRU_AB

#ifndef N_LAUNCH_SPLIT
#define N_LAUNCH_SPLIT 0
#endif
extern "C" void kernel_launch(void* const* d_in, const int* in_sizes, int n_in, void* d_out, int out_size, void* d_ws, size_t ws_size, hipStream_t stream) {
    static int grid = 0;
    if (grid == 0) {
        if (n_in != 22 || out_size != MTOK * DM || ws_size < WS_END) { fprintf(stderr, "kernel_launch: unexpected shapes (n_in %d, out %d, ws %zu)\n", n_in, out_size, ws_size); grid = -1; return; }
        int dev = 0, cus = 0, per_cu = 0;
        if (hipGetDevice(&dev) != hipSuccess || hipDeviceGetAttribute(&cus, hipDeviceAttributeMultiprocessorCount, dev) != hipSuccess) { grid = -1; return; }
        if (hipFuncSetAttribute((const void*)fwd_kernel, hipFuncAttributeMaxDynamicSharedMemorySize, LDS_BYTES) != hipSuccess) { fprintf(stderr, "kernel_launch: hipFuncSetAttribute failed\n"); grid = -1; return; }
        if (hipOccupancyMaxActiveBlocksPerMultiprocessor(&per_cu, (const void*)fwd_kernel, NWAVES * 64, LDS_BYTES) != hipSuccess || per_cu < 1) { fprintf(stderr, "kernel_launch: occupancy query says %d\n", per_cu); per_cu = 1; }
        (void)hipGetLastError();
        grid = cus;
    }
    if (grid < 0) return;
    unsigned char* ws = (unsigned char*)d_ws;
    Args a{};
    for (int i = 0; i < 22; ++i) a.in[i] = (const float*)d_in[i];
    a.out = (float*)d_out; a.ws = ws;
    {
        int nj = 0, items = 0;
        auto add = [&](const float* src, int ldw, int ncols, int K, size_t dst_off, const float* gk) { a.jobs[nj].src = src; a.jobs[nj].gk = gk; a.jobs[nj].dst = (bf16*)(ws + dst_off); a.jobs[nj].ldw = ldw; a.jobs[nj].ncols = ncols; a.jobs[nj].K = K; a.jobs[nj].item0 = items; items += (K / 64) * (ncols / 32); ++nj; };
        const float* fox_in = a.in[4]; const float* ml_in = a.in[18]; const float* ng0 = a.in[1];
        auto w1 = [&](int l) { add(a.in[2] + (size_t)l * DM * DFF, DFF, DFF, DM, WS_W1 + (size_t)l * DFF * DM * 2, ng0 + (size_t)(4 * l + 2) * DM); };
        auto w2 = [&](int l) { add(a.in[3] + (size_t)l * DFF * DM, DM, DM, DFF, WS_W2 + (size_t)l * DFF * DM * 2, nullptr); };
        a.grp_job_lo[0] = nj; items = 0;
        add(fox_in, 6160, 4096, DM, WS_W_FOXIN, ng0);
        add(fox_in + 4096, 6160, 2048, DM, WS_W_FOXIN + (size_t)4352 * DM * 2, ng0);
        add(a.in[7], 5376, 5376, DM, WS_W_LRUIN, ng0 + 4 * DM);
        add(a.in[16], 6144, 6144, DM, WS_W_SBIN, ng0 + 8 * DM);
        add(a.in[17], DM, DM, DM, WS_W_SBOUT, nullptr);
        add(ml_in, 6152, 2048, DM, WS_W_MLIN, ng0 + 12 * DM);
        add(ml_in + 4096, 6152, 2048, DM, WS_W_MLIN + (size_t)2048 * DM * 2, ng0 + 12 * DM);
        add(ml_in + 2048, 6152, 2048, DM, WS_W_MLIN + (size_t)4352 * DM * 2, ng0 + 12 * DM);
        w1(2); w2(2);
        a.grp_items[0] = items;
        a.grp_job_lo[1] = nj; items = 0;
        add(a.in[6], DM, DM, DM, WS_W_FOXOUT, nullptr); w1(0);
        a.grp_items[1] = items;
        a.grp_job_lo[2] = nj; items = 0;
        add(a.in[15], DM, DM, LRU_W, WS_W_LRUOUT, nullptr); w1(1); w2(1);
        a.grp_items[2] = items;
        a.grp_job_lo[3] = nj; items = 0;
        add(a.in[21], DM, DM, DM, WS_W_MLOUT, nullptr); w1(3);
        a.grp_items[3] = items;
        a.grp_job_lo[4] = nj; items = 0; w2(0); a.grp_items[4] = items;
        a.grp_job_lo[5] = nj; items = 0; w2(3); a.grp_items[5] = items;
        a.grp_job_lo[6] = nj;
    }
    if (hipMemsetAsync(ws + WS_CTL, 0, CTL_ZERO_BYTES, stream) != hipSuccess) { fprintf(stderr, "kernel_launch: memset failed\n"); return; }
#if N_LAUNCH_SPLIT
    for (int p = 0; p < NPH; ++p) { a.ph_lo = p; a.ph_hi = p + 1; hipLaunchKernelGGL(fwd_kernel, dim3(grid), dim3(NWAVES * 64), LDS_BYTES, stream, a); }
#else
    a.ph_lo = 0; a.ph_hi = NPH;
    hipLaunchKernelGGL(fwd_kernel, dim3(grid), dim3(NWAVES * 64), LDS_BYTES, stream, a);
#endif
    const hipError_t le = hipPeekAtLastError();
    if (le != hipSuccess) fprintf(stderr, "kernel_launch: launch failed: %s\n", hipGetErrorName(le));
}
```
